# Optimizing an MI355X kernel written in HIP

```python
import jax, jax.numpy as jnp
from jax import lax
import numpy as np

D_MODEL = 2048
BATCH = 4
SEQ = 2048
DEPTH = 1
DEC_BATCH = 128
DEC_SEQ = 4
PAST_LEN = 16384
PAGE_SIZE = 128

N_META = 16
CONV_W = 4
D_LRU = D_MODEL
LRU_HEADS = 16
LRU_HEAD_DIM = D_LRU // LRU_HEADS
LRU_C = 8.0
D_SSD = D_MODEL
SSD_HEAD_DIM = 64
SSD_HEADS = D_SSD // SSD_HEAD_DIM
SSD_GROUPS = 4
SSD_STATE = 128
SSD_CHUNK = 128
D_BC = SSD_GROUPS * SSD_STATE
D_CONV_SSD = D_SSD + 2 * D_BC
D_MIX = D_LRU + D_SSD
D_IN_PROJ = 2 * D_LRU + D_SSD + D_CONV_SSD + SSD_HEADS
D_FF = 4 * D_MODEL
EPS = 1e-6

kernel_name = "hymba_rglru_ssd_decoder_step"


def rmsnorm(x, g):
    xf = x.astype(jnp.float32)
    y = xf * lax.rsqrt(jnp.mean(xf * xf, axis=-1, keepdims=True) + EPS)
    return (y * g.astype(jnp.float32)).astype(x.dtype)


def causal_conv(u, w, b, buf):
    L = u.shape[1]
    ext = jnp.concatenate([buf.astype(u.dtype), u], axis=1)
    out = b + ext[:, 0:L] * w[0]
    for k in range(1, CONV_W):
        out = out + ext[:, k:k + L] * w[k]
    return out, ext[:, L:]


def _lin_combine(e1, e2):
    a1, b1 = e1
    a2, b2 = e2
    return a1 * a2, a2 * b1 + b2


def rglru(xc, w_a, b_a, w_x, b_x, lam, h0, reset_first):
    Bn, L, _ = xc.shape
    xf = xc.astype(jnp.float32)
    xh = xf.reshape(Bn, L, LRU_HEADS, LRU_HEAD_DIM)
    r = jax.nn.sigmoid(jnp.einsum('blhi,hij->blhj', xh, w_a.astype(jnp.float32)) + b_a.astype(jnp.float32)).reshape(Bn, L, D_LRU)
    i = jax.nn.sigmoid(jnp.einsum('blhi,hij->blhj', xh, w_x.astype(jnp.float32)) + b_x.astype(jnp.float32)).reshape(Bn, L, D_LRU)
    log_a = -LRU_C * r * jax.nn.softplus(-lam.astype(jnp.float32))
    a = jnp.exp(log_a)
    mult = jnp.sqrt(-jnp.expm1(2.0 * log_a))
    if reset_first:
        mult = mult.at[:, 0].set(1.0)
    bt = mult * i * xf
    bt = bt.at[:, 0].add(a[:, 0] * h0.astype(jnp.float32))
    _, h = lax.associative_scan(_lin_combine, (a, bt), axis=1)
    return h, h[:, -1]


def ssd_chunked(x, dt, A, Bm, Cm, h0, chunk):
    b, L, H, P = x.shape
    G, N = Bm.shape[2], Bm.shape[3]
    R = H // G
    nc = L // chunk
    xr = x.reshape(b, nc, chunk, G, R, P)
    dtc = dt.reshape(b, nc, chunk, H)
    Bc = Bm.reshape(b, nc, chunk, G, N)
    Cc = Cm.reshape(b, nc, chunk, G, N)
    acum = jnp.cumsum(dtc * A, axis=2)
    seg = acum[:, :, :, None, :] - acum[:, :, None, :, :]
    causal = jnp.tril(jnp.ones((chunk, chunk), dtype=bool))
    lmat = jnp.exp(jnp.where(causal[None, None, :, :, None], seg, -jnp.inf))
    lmat = (lmat * dtc[:, :, None, :, :]).reshape(b, nc, chunk, chunk, G, R)
    cb = jnp.einsum('bcign,bcjgn->bcgij', Cc, Bc)
    m = jnp.einsum('bcgij,bcijgr->bcijgr', cb, lmat)
    y_diag = jnp.einsum('bcijgr,bcjgrp->bcigrp', m, xr)
    w_end = (jnp.exp(acum[:, :, -1:, :] - acum) * dtc).reshape(b, nc, chunk, G, R)
    states = jnp.einsum('bcjgn,bcjgrp->bcgrpn', Bc, xr * w_end[..., None]).reshape(b, nc, H, P, N)
    chunk_decay = jnp.exp(acum[:, :, -1, :])

    def step(h, inp):
        st, dec = inp
        return dec[:, :, None, None] * h + st, h

    h_final, h_starts = lax.scan(step, h0.astype(jnp.float32),
                                 (jnp.swapaxes(states, 0, 1), jnp.swapaxes(chunk_decay, 0, 1)))
    h_starts = jnp.swapaxes(h_starts, 0, 1).reshape(b, nc, G, R, P, N)
    y_off = jnp.einsum('bcign,bcgrpn->bcigrp', Cc, h_starts) * jnp.exp(acum).reshape(b, nc, chunk, G, R)[..., None]
    return (y_diag + y_off).reshape(b, L, H, P), h_final


def mixer(h, lru_buf, lru_h0, ssd_buf, ssd_h0, w_in, conv_lru_w, conv_lru_b, lru_wa, lru_ba, lru_wx, lru_bx,
          lru_lambda, g_lru_out, conv_ssd_w, conv_ssd_b, dt_bias, a_log, d_skip, g_ssd_out, w_out,
          reset_first, pad, chunk):
    Bn, L, _ = h.shape
    proj = h @ w_in
    o1 = D_LRU
    o2 = o1 + D_LRU
    o3 = o2 + D_SSD
    o4 = o3 + D_CONV_SSD
    gate_lru, x_lru, z, xbc_raw, dt_raw = proj[..., :o1], proj[..., o1:o2], proj[..., o2:o3], proj[..., o3:o4], proj[..., o4:]
    xl, lru_buf_new = causal_conv(x_lru, conv_lru_w, conv_lru_b, lru_buf)
    hl, lru_h_new = rglru(xl, lru_wa, lru_ba, lru_wx, lru_bx, lru_lambda, lru_h0, reset_first)
    lru_out = rmsnorm(hl * jax.nn.gelu(gate_lru.astype(jnp.float32)), g_lru_out)
    xbc, ssd_buf_new = causal_conv(xbc_raw, conv_ssd_w, conv_ssd_b, ssd_buf)
    xbc = jax.nn.silu(xbc.astype(jnp.float32))
    xs = xbc[..., :D_SSD].reshape(Bn, L, SSD_HEADS, SSD_HEAD_DIM)
    Bm = xbc[..., D_SSD:D_SSD + D_BC].reshape(Bn, L, SSD_GROUPS, SSD_STATE)
    Cm = xbc[..., D_SSD + D_BC:].reshape(Bn, L, SSD_GROUPS, SSD_STATE)
    dt = jax.nn.softplus(dt_raw.astype(jnp.float32) + dt_bias.astype(jnp.float32))
    A = -jnp.exp(a_log.astype(jnp.float32))
    if pad > 0:
        xs_p = jnp.pad(xs, ((0, 0), (pad, 0), (0, 0), (0, 0)))
        dt_p = jnp.pad(dt, ((0, 0), (pad, 0), (0, 0)))
        B_p = jnp.pad(Bm, ((0, 0), (pad, 0), (0, 0), (0, 0)))
        C_p = jnp.pad(Cm, ((0, 0), (pad, 0), (0, 0), (0, 0)))
    else:
        xs_p, dt_p, B_p, C_p = xs, dt, Bm, Cm
    y, ssd_h_new = ssd_chunked(xs_p, dt_p, A, B_p, C_p, ssd_h0, chunk)
    y = y[:, pad:] + d_skip.astype(jnp.float32)[:, None] * xs
    yg = y.reshape(Bn, L, D_SSD) * jax.nn.silu(z.astype(jnp.float32))
    yg = yg.reshape(Bn, L, SSD_GROUPS, D_SSD // SSD_GROUPS)
    yg = yg * lax.rsqrt(jnp.mean(yg * yg, axis=-1, keepdims=True) + EPS)
    ssd_out = (yg.reshape(Bn, L, D_SSD) * g_ssd_out.astype(jnp.float32)).astype(h.dtype)
    mix = jnp.concatenate([lru_out.astype(h.dtype), ssd_out], axis=-1) @ w_out
    return mix, lru_h_new, lru_buf_new, ssd_h_new, ssd_buf_new


def setup_inputs(seed: int = 0) -> dict:
    key = jax.random.key(seed)
    ks = jax.random.split(key, 32)
    f32 = jnp.float32

    def nrm(k, shape, scale):
        return jax.random.normal(k, shape, f32) * scale

    a0 = jax.random.uniform(ks[10], (DEPTH, D_LRU), f32, 0.9, 0.999)
    s = a0 ** (1.0 / LRU_C)
    lru_lambda = jnp.log(s) - jnp.log1p(-s)
    dt0 = jnp.exp(jax.random.uniform(ks[14], (DEPTH, SSD_HEADS), f32, np.log(1e-3), np.log(1e-1)))
    dt_bias = dt0 + jnp.log(-jnp.expm1(-dt0))
    return {
        "x_prompt": nrm(ks[0], (BATCH, SEQ, D_MODEL), 1.0),
        "x_sample": nrm(ks[1], (DEC_BATCH, DEC_SEQ, D_MODEL), 1.0),
        "state_lru_h": nrm(ks[2], (DEPTH, DEC_BATCH, D_LRU), 0.5),
        "state_lru_conv": nrm(ks[3], (DEPTH, DEC_BATCH, CONV_W - 1, D_LRU), 1.0),
        "state_ssd": nrm(ks[4], (DEPTH, DEC_BATCH, SSD_HEADS, SSD_HEAD_DIM, SSD_STATE), 0.1),
        "state_ssd_conv": nrm(ks[5], (DEPTH, DEC_BATCH, CONV_W - 1, D_CONV_SSD), 1.0),
        "meta_tokens": nrm(ks[6], (N_META, D_MODEL), 1.0),
        "g_mix": 1.0 + nrm(ks[7], (DEPTH, D_MODEL), 0.02),
        "w_in": nrm(ks[8], (DEPTH, D_MODEL, D_IN_PROJ), D_MODEL ** -0.5),
        "conv_lru_w": nrm(ks[9], (DEPTH, CONV_W, D_LRU), CONV_W ** -0.5),
        "conv_lru_b": nrm(ks[11], (DEPTH, D_LRU), 0.02),
        "lru_wa": nrm(ks[12], (DEPTH, LRU_HEADS, LRU_HEAD_DIM, LRU_HEAD_DIM), LRU_HEAD_DIM ** -0.5),
        "lru_ba": nrm(ks[13], (DEPTH, LRU_HEADS, LRU_HEAD_DIM), 0.02),
        "lru_wx": nrm(ks[15], (DEPTH, LRU_HEADS, LRU_HEAD_DIM, LRU_HEAD_DIM), LRU_HEAD_DIM ** -0.5),
        "lru_bx": nrm(ks[16], (DEPTH, LRU_HEADS, LRU_HEAD_DIM), 0.02),
        "lru_lambda": lru_lambda,
        "g_lru_out": 1.0 + nrm(ks[17], (DEPTH, D_LRU), 0.02),
        "conv_ssd_w": nrm(ks[18], (DEPTH, CONV_W, D_CONV_SSD), CONV_W ** -0.5),
        "conv_ssd_b": nrm(ks[19], (DEPTH, D_CONV_SSD), 0.02),
        "dt_bias": dt_bias,
        "a_log": jnp.log(jax.random.uniform(ks[20], (DEPTH, SSD_HEADS), f32, 1.0, 16.0)),
        "d_skip": 1.0 + nrm(ks[21], (DEPTH, SSD_HEADS), 0.1),
        "g_ssd_out": 1.0 + nrm(ks[22], (DEPTH, D_SSD), 0.02),
        "w_out": nrm(ks[23], (DEPTH, D_MIX, D_MODEL), D_MIX ** -0.5),
        "g_mlp": 1.0 + nrm(ks[24], (DEPTH, D_MODEL), 0.02),
        "w_up": nrm(ks[25], (DEPTH, D_MODEL, D_FF), D_MODEL ** -0.5),
        "w_down": nrm(ks[26], (DEPTH, D_FF, D_MODEL), D_FF ** -0.5),
        "g_final": 1.0 + nrm(ks[27], (D_MODEL,), 0.02),
    }


def reference(x_prompt, x_sample, state_lru_h, state_lru_conv, state_ssd, state_ssd_conv, meta_tokens,
              g_mix, w_in, conv_lru_w, conv_lru_b, lru_wa, lru_ba, lru_wx, lru_bx, lru_lambda, g_lru_out,
              conv_ssd_w, conv_ssd_b, dt_bias, a_log, d_skip, g_ssd_out, w_out, g_mlp, w_up, w_down, g_final):
    Bp = x_prompt.shape[0]
    xp = jnp.concatenate([jnp.broadcast_to(meta_tokens.astype(x_prompt.dtype)[None], (Bp, N_META, D_MODEL)), x_prompt], axis=1)
    Lp = xp.shape[1]
    pad_p = (-Lp) % SSD_CHUNK
    xs = x_sample
    p_states = ([], [], [], [])
    s_states = ([], [], [], [])
    for l in range(DEPTH):
        w = (w_in[l], conv_lru_w[l], conv_lru_b[l], lru_wa[l], lru_ba[l], lru_wx[l], lru_bx[l], lru_lambda[l],
             g_lru_out[l], conv_ssd_w[l], conv_ssd_b[l], dt_bias[l], a_log[l], d_skip[l], g_ssd_out[l], w_out[l])
        mix_p, lh, lb, sh, sb = mixer(
            rmsnorm(xp, g_mix[l]),
            jnp.zeros((Bp, CONV_W - 1, D_LRU), xp.dtype), jnp.zeros((Bp, D_LRU), jnp.float32),
            jnp.zeros((Bp, CONV_W - 1, D_CONV_SSD), xp.dtype),
            jnp.zeros((Bp, SSD_HEADS, SSD_HEAD_DIM, SSD_STATE), jnp.float32),
            *w, reset_first=True, pad=pad_p, chunk=SSD_CHUNK)
        for lst, v in zip(p_states, (lh, lb, sh, sb)):
            lst.append(v)
        xp = xp + mix_p
        hp = rmsnorm(xp, g_mlp[l])
        xp = xp + jnp.square(jax.nn.relu(hp @ w_up[l])) @ w_down[l]
        mix_s, lh, lb, sh, sb = mixer(
            rmsnorm(xs, g_mix[l]), state_lru_conv[l], state_lru_h[l], state_ssd_conv[l], state_ssd[l],
            *w, reset_first=False, pad=0, chunk=xs.shape[1])
        for lst, v in zip(s_states, (lh, lb, sh, sb)):
            lst.append(v)
        xs = xs + mix_s
        hs = rmsnorm(xs, g_mlp[l])
        xs = xs + jnp.square(jax.nn.relu(hs @ w_up[l])) @ w_down[l]
    y_prompt = rmsnorm(xp, g_final)[:, N_META:]
    y_sample = rmsnorm(xs, g_final)
    dts = (state_lru_h.dtype, state_lru_conv.dtype, state_ssd.dtype, state_ssd_conv.dtype)
    p_lru_h, p_lru_conv, p_ssd, p_ssd_conv = [jnp.stack(v, axis=0).astype(d) for v, d in zip(p_states, dts)]
    s_lru_h, s_lru_conv, s_ssd, s_ssd_conv = [jnp.stack(v, axis=0).astype(d) for v, d in zip(s_states, dts)]
    return (y_prompt, y_sample, p_lru_h, p_lru_conv, p_ssd, p_ssd_conv, s_lru_h, s_lru_conv, s_ssd, s_ssd_conv)
```

```cpp
#include <hip/hip_runtime.h>
#include <hip/hip_cooperative_groups.h>
#include <cstdio>
#include <cstdint>
namespace cg = cooperative_groups;
namespace pg8 {
#define PG8_LAS __attribute__((address_space(3)))
typedef unsigned short bf16_t;
typedef short bf16x8 __attribute__((ext_vector_type(8)));
typedef float f32x4 __attribute__((ext_vector_type(4)));
typedef unsigned u32x4 __attribute__((ext_vector_type(4)));
constexpr int BM = 256, BK = 64, HALF = 128, HTB = HALF * BK * 2  , STAGE_BYTES = 8 * HTB, NXCD = 8, WGM = 8;

__host__ __device__ __forceinline__ int lds_byte(int r, int c) { const int st = (r >> 4) * 2 + (c >> 5), rr = r & 15, cc = c & 31, ob = rr * 64 + cc * 2; return st * 1024 + (ob ^ (((ob >> 9) & 1) << 5)); }
__host__ __device__ __forceinline__ void stage_rc(int b, int& R, int& C) { const int st = b / 1024, sb = b % 1024, swz = sb ^ (((sb >> 9) & 1) << 5); R = (st >> 1) * 16 + swz / 64; C = (st & 1) * 32 + (swz % 64) / 2; }
__host__ __device__ __forceinline__ int perm32(int rho) { const int n = rho >> 4, i = rho & 15; return 8 * (i >> 2) + 4 * n + (i & 3); }

struct Unit { int pm, pn, kt0, nt, slot; };
struct Gemm { const bf16_t* A; const bf16_t* Bt; int M, N, K; };

struct StaticOrder {
    int nM, nN, nwg, G, c, ntk;
    __host__ __device__ __forceinline__ void init(int M, int N, int G_, int c_, int K_) { nM = M / BM; nN = N / BM; nwg = nM * nN; G = G_; c = c_; ntk = K_ / BK; }
    __host__ __device__ __forceinline__ bool next(int i, Unit& u) const {
        const long L = (long)i * G + c; if (L >= nwg) return false;
        int wgid = (int)L; { const int q = nwg / NXCD, r = nwg % NXCD, xcd = wgid % NXCD, off = wgid / NXCD; wgid = (xcd < r ? xcd * (q + 1) : r * (q + 1) + (xcd - r) * q) + off; }
        const int nig = WGM * nN, gid = wgid / nig, fm = gid * WGM, gsz = (nM - fm) < WGM ? (nM - fm) : WGM;
        u.pm = fm + ((wgid % nig) % gsz); u.pn = (wgid % nig) / gsz; u.kt0 = 0; u.nt = ntk; u.slot = -1; return true;
    }
    __device__ __forceinline__ void a_ready(const Unit&) const {}
    __device__ __forceinline__ void done(const Unit&) const {}
};


__host__ __device__ __forceinline__ void split_params(int nwg, int G, int ntk, int& nfull, int& P) {
    nfull = (nwg / G) * G; const int rem = nwg - nfull; P = 1;
    if (rem > 0) { int p = G / rem; p = p >= 8 ? 8 : (p >= 4 ? 4 : (p >= 2 ? 2 : 1)); while (p > 1 && ((ntk / p) < 4 || (ntk % (2 * p)) != 0)) p >>= 1; P = p; }
}
struct SplitOrder {
    int nN, nwg, G, c, ntk, nfull, P, perm;
    __host__ __device__ __forceinline__ void init(int M, int N, int G_, int c_, int K_) { nN = N / BM; nwg = (M / BM) * nN; G = G_; c = c_; ntk = K_ / BK; split_params(nwg, G, ntk, nfull, P);
        perm = (G % NXCD == 0) ? (c % NXCD) * (G / NXCD) + c / NXCD : c; }
    __host__ __device__ __forceinline__ bool next(int i, Unit& u) const {
        const int rounds = nfull / G;
        if (i < rounds) { const int T = i * G + perm; u.pm = T / nN; u.pn = T % nN; u.kt0 = 0; u.nt = ntk; u.slot = -1; return true; }
        int j = (i - rounds) * G + c; const int rem = nwg - nfull;
        if (j >= rem * P) return false;
        const int T = nfull + j / P, pc = j % P; u.pm = T / nN; u.pn = T % nN; u.nt = ntk / P; u.kt0 = pc * u.nt; u.slot = (P > 1) ? pc : -1; return true;
    }
    __device__ __forceinline__ void a_ready(const Unit&) const {}
    __device__ __forceinline__ void done(const Unit&) const {}
};
__device__ __forceinline__ unsigned cvt_pk_bf16(float lo, float hi) { unsigned r; asm volatile("v_cvt_pk_bf16_f32 %0, %1, %2" : "=v"(r) : "v"(lo), "v"(hi)); return r; }
struct EpiF32 {
    static constexpr bool PERM = false, AFTER_DRAIN = false;
    float* C; int ldc;
    __device__ __forceinline__ void operator()(const f32x4 (&acc)[2][2][4][2], const Unit& u, int wr, int wc, int fr, int fq) const {
        const int row0 = u.pm * BM + wr * 64 + fr, col0 = u.pn * BM + wc * 32 + 4 * fq;
#pragma unroll
        for (int ai = 0; ai < 2; ++ai)
#pragma unroll
            for (int m = 0; m < 4; ++m) { float* rowp = C + (size_t)(row0 + ai * HALF + m * 16) * ldc + col0;
#pragma unroll
                for (int bj = 0; bj < 2; ++bj)
#pragma unroll
                    for (int n = 0; n < 2; ++n) *(f32x4*)(rowp + bj * HALF + n * 16) = acc[ai][bj][m][n]; }
    }
};
struct EpiProj {
    static constexpr bool PERM = true, AFTER_DRAIN = false;
    bf16_t *PG, *PXL, *PZ, *PXBC;
    __device__ __forceinline__ void operator()(const f32x4 (&acc)[2][2][4][2], const Unit& u, int wr, int wc, int fr, int fq) const {
        const int row0 = u.pm * BM + wr * 64 + fr;
        bf16_t* base; int ldc, colt;
        if (u.pn < 8) { base = PG; ldc = 2048; colt = u.pn * 256; }
        else if (u.pn < 16) { base = PXL; ldc = 2048; colt = (u.pn - 8) * 256; }
        else if (u.pn < 24) { base = PZ; ldc = 2048; colt = (u.pn - 16) * 256; }
        else { base = PXBC; ldc = 3072; colt = (u.pn - 24) * 256; }
        const int col0 = colt + wc * 32 + 8 * fq;
#pragma unroll
        for (int ai = 0; ai < 2; ++ai)
#pragma unroll
            for (int m = 0; m < 4; ++m) { bf16_t* rowp = base + (size_t)(row0 + ai * HALF + m * 16) * ldc + col0;
#pragma unroll
                for (int bj = 0; bj < 2; ++bj) { const f32x4 v0 = acc[ai][bj][m][0], v1 = acc[ai][bj][m][1];
                    u32x4 w; w.x = cvt_pk_bf16(v0[0], v0[1]); w.y = cvt_pk_bf16(v0[2], v0[3]); w.z = cvt_pk_bf16(v1[0], v1[1]); w.w = cvt_pk_bf16(v1[2], v1[3]);
                    *(u32x4*)(rowp + bj * HALF) = w; } }
    }
};
struct EpiRelu2 {
    static constexpr bool PERM = true, AFTER_DRAIN = false;
    bf16_t* O; int ldc;
    __device__ __forceinline__ void operator()(const f32x4 (&acc)[2][2][4][2], const Unit& u, int wr, int wc, int fr, int fq) const {
        const int row0 = u.pm * BM + wr * 64 + fr, col0 = u.pn * BM + wc * 32 + 8 * fq;
#pragma unroll
        for (int ai = 0; ai < 2; ++ai)
#pragma unroll
            for (int m = 0; m < 4; ++m) { bf16_t* rowp = O + (size_t)(row0 + ai * HALF + m * 16) * ldc + col0;
#pragma unroll
                for (int bj = 0; bj < 2; ++bj) { f32x4 v0 = acc[ai][bj][m][0], v1 = acc[ai][bj][m][1];
#pragma unroll
                    for (int e = 0; e < 4; ++e) { const float p = fmaxf(v0[e], 0.f), q = fmaxf(v1[e], 0.f); v0[e] = p * p; v1[e] = q * q; }
                    u32x4 w; w.x = cvt_pk_bf16(v0[0], v0[1]); w.y = cvt_pk_bf16(v0[2], v0[3]); w.z = cvt_pk_bf16(v1[0], v1[1]); w.w = cvt_pk_bf16(v1[2], v1[3]);
                    *(u32x4*)(rowp + bj * HALF) = w; } }
    }
};

struct EpiF32S {
    static constexpr bool PERM = false, AFTER_DRAIN = false;
    float* C; int ldc; float* R2; int nN, nfull, P; int mode; const float* res; const float* xp; const float* xs; const float* meta;
    __device__ __forceinline__ const float* rrow(int r) const {
        if (mode == 1) return res + (size_t)r * ldc;
        if (r >= 8768) r = 8767;
        if (r < 8256) { const int b = r / 2064, t = r - b * 2064; return t < 16 ? meta + (size_t)t * 2048 : xp + ((size_t)b * 2048 + (t - 16)) * 2048; }
        return xs + (size_t)(r - 8256) * 2048;
    }
    __device__ __forceinline__ void operator()(const f32x4 (&acc)[2][2][4][2], const Unit& u, int wr, int wc, int fr, int fq) const {
        const int r0 = wr * 64 + fr, c0 = wc * 32 + 4 * fq;
        if (u.slot < 0) {
#pragma unroll
            for (int ai = 0; ai < 2; ++ai)
#pragma unroll
                for (int m = 0; m < 4; ++m) { const int row = u.pm * BM + r0 + ai * HALF + m * 16; float* rowp = C + (size_t)row * ldc + u.pn * BM + c0; const float* rp = rrow(row) + u.pn * BM + c0;
#pragma unroll
                    for (int bj = 0; bj < 2; ++bj)
#pragma unroll
                        for (int n = 0; n < 2; ++n) *(f32x4*)(rowp + bj * HALF + n * 16) = acc[ai][bj][m][n] + *(const f32x4*)(rp + bj * HALF + n * 16);
                    if (m & 1) asm volatile("" ::: "memory"); }
        } else {
            float* base = R2 + ((size_t)((u.pm * nN + u.pn - nfull) * P + u.slot)) * 65536;
#pragma unroll
            for (int ai = 0; ai < 2; ++ai)
#pragma unroll
                for (int m = 0; m < 4; ++m) { float* rowp = base + (size_t)(r0 + ai * HALF + m * 16) * 256 + c0;
#pragma unroll
                    for (int bj = 0; bj < 2; ++bj)
#pragma unroll
                        for (int n = 0; n < 2; ++n) *(f32x4*)(rowp + bj * HALF + n * 16) = acc[ai][bj][m][n]; }
        }
    }
};
template <class Epi, class Sched, bool ALIGN_EPI = false, bool SP2 = false>
__device__ __forceinline__ void gemm_phase(PG8_LAS unsigned char* lds, const Gemm g, const Sched& S, const Epi& E) {
    const int tid = threadIdx.x, wid = __builtin_amdgcn_readfirstlane(tid >> 6), lane = tid & 63, wr = wid >> 2, wc = wid & 3, fr = lane & 15, fq = lane >> 4;
    const int K = g.K;
    unsigned voffA[2], voffB[2];
#pragma unroll
    for (int i = 0; i < 2; ++i) { int R, C; stage_rc(tid * 16 + i * 8192, R, C); const int Rb = Epi::PERM ? ((R & ~31) + perm32(R & 31)) : R;
        voffA[i] = (unsigned)(R * K + C) * 2u; voffB[i] = (unsigned)(Rb * K + C) * 2u; }
    const size_t kstep = (size_t)(BK * 2);
    const size_t hstep = (size_t)HALF * K * 2;
    const size_t tstep = 2 * hstep;
    const unsigned ldsw = (unsigned)wid * 1024u;
    const int aoff = lds_byte(wr * 64 + fr, fq * 8), boff = lds_byte(wc * 32 + fr, fq * 8);
#define PG8_SA(b, h) (((b) * 2 + (h)) * HTB)
#define PG8_SB(b, h) ((4 + (b) * 2 + (h)) * HTB)
#define PG8_STAGE(bufoff, gbase, voff) do { _Pragma("unroll") for (int _i = 0; _i < 2; ++_i) \
        __builtin_amdgcn_global_load_lds((const unsigned*)((const char*)(gbase) + (voff)[_i]), (PG8_LAS unsigned*)(lds + (bufoff) + ldsw + _i * 8192), 16, 0, 0); } while (0)
#define PG8_LDA(dst, b, h) do { _Pragma("unroll") for (int m = 0; m < 4; ++m) _Pragma("unroll") for (int k = 0; k < 2; ++k) dst[m][k] = *(const PG8_LAS bf16x8*)(lds + PG8_SA(b, h) + aoff + m * 2048 + k * 1024); } while (0)
#define PG8_LDB(dst, b, h) do { _Pragma("unroll") for (int n = 0; n < 2; ++n) _Pragma("unroll") for (int k = 0; k < 2; ++k) dst[n][k] = *(const PG8_LAS bf16x8*)(lds + PG8_SB(b, h) + boff + n * 2048 + k * 1024); } while (0)
#define PG8_MMA(ai, bj, At, Bt) do { __builtin_amdgcn_s_setprio(1); _Pragma("unroll") for (int m = 0; m < 4; ++m) _Pragma("unroll") for (int n = 0; n < 2; ++n) _Pragma("unroll") for (int k = 0; k < 2; ++k) \
        acc[ai][bj][m][n] = __builtin_amdgcn_mfma_f32_16x16x32_bf16(Bt[n][k], At[m][k], acc[ai][bj][m][n], 0, 0, 0); __builtin_amdgcn_s_setprio(0); } while (0)
#define PG8_WAIT_V(n) asm volatile("s_waitcnt vmcnt(" #n ")" ::: "memory")
#define PG8_WAIT_L(n) asm volatile("s_waitcnt lgkmcnt(" #n ")" ::: "memory")
#define PG8_BAR __builtin_amdgcn_s_barrier()
#define PG8_SCHED __builtin_amdgcn_sched_barrier(0)
    Unit cur, nxt; int ui = 0;
    if (!S.next(0, cur)) return;
    f32x4 acc[2][2][4][2];
#pragma unroll
    for (int a = 0; a < 2; ++a)
#pragma unroll
        for (int b = 0; b < 2; ++b)
#pragma unroll
            for (int m = 0; m < 4; ++m)
#pragma unroll
                for (int n = 0; n < 2; ++n) acc[a][b][m][n] = (f32x4){0.f, 0.f, 0.f, 0.f};
    bf16x8 At[4][2], B0[2][2], B1[2][2];
    const char* cA = (const char*)g.A + (size_t)cur.pm * tstep + (size_t)cur.kt0 * kstep; const char* cB = (const char*)g.Bt + (size_t)cur.pn * tstep + (size_t)cur.kt0 * kstep;
    S.a_ready(cur);
    if constexpr (SP2) {
        PG8_STAGE(PG8_SB(0, 0), cB, voffB); PG8_STAGE(PG8_SB(0, 1), cB + hstep, voffB); PG8_STAGE(PG8_SA(0, 0), cA, voffA); PG8_STAGE(PG8_SA(0, 1), cA + hstep, voffA);
        if (wr == 1) PG8_BAR;
        PG8_WAIT_V(2); PG8_BAR;
        PG8_STAGE(PG8_SB(1, 0), cB + kstep, voffB); PG8_STAGE(PG8_SA(1, 0), cA + kstep, voffA); PG8_STAGE(PG8_SB(1, 1), cB + hstep + kstep, voffB);
        PG8_WAIT_V(6); PG8_BAR;
    } else {
        PG8_STAGE(PG8_SB(0, 0), cB, voffB); PG8_STAGE(PG8_SA(0, 0), cA, voffA); PG8_STAGE(PG8_SB(0, 1), cB + hstep, voffB); PG8_STAGE(PG8_SA(0, 1), cA + hstep, voffA);
        if (wr == 1) PG8_BAR;
        PG8_WAIT_V(4); PG8_BAR;
        PG8_STAGE(PG8_SB(1, 0), cB + kstep, voffB); PG8_STAGE(PG8_SA(1, 0), cA + kstep, voffA); PG8_STAGE(PG8_SB(1, 1), cB + hstep + kstep, voffB);
        PG8_WAIT_V(6); PG8_BAR;
    }
    for (;;) {
        const bool has_next = S.next(ui + 1, nxt);
        const char* nA = has_next ? (const char*)g.A + (size_t)nxt.pm * tstep + (size_t)nxt.kt0 * kstep : cA; const char* nB = has_next ? (const char*)g.Bt + (size_t)nxt.pn * tstep + (size_t)nxt.kt0 * kstep : cB;
        const int nt = cur.nt;
        for (int t = 0; t < nt; t += 2) {
            const bool last = (t == nt - 2);
            const char* a1 = cA + (size_t)(t + 1) * kstep;
            const char* a2 = last ? nA : cA + (size_t)(t + 2) * kstep; const char* b2 = last ? nB : cB + (size_t)(t + 2) * kstep;
            const char* a3 = a2 + kstep; const char* b3 = b2 + kstep;
            if (last && has_next) S.a_ready(nxt);
            if constexpr (SP2) {
            PG8_LDB(B0, 0, 0); PG8_LDB(B1, 0, 1); PG8_SCHED; PG8_LDA(At, 0, 0); PG8_STAGE(PG8_SA(1, 1), a1 + hstep, voffA);
            PG8_WAIT_V(8); PG8_WAIT_L(0); PG8_BAR; PG8_MMA(0, 0, At, B0); PG8_MMA(0, 1, At, B1); PG8_BAR; PG8_SCHED;
            PG8_LDA(At, 0, 1); PG8_STAGE(PG8_SB(0, 0), b2, voffB); PG8_STAGE(PG8_SB(0, 1), b2 + hstep, voffB); PG8_STAGE(PG8_SA(0, 0), a2, voffA);
            PG8_WAIT_V(8); PG8_WAIT_L(0); PG8_BAR; PG8_MMA(1, 0, At, B0); PG8_MMA(1, 1, At, B1); PG8_BAR; PG8_SCHED;
            PG8_LDB(B0, 1, 0); PG8_LDB(B1, 1, 1); PG8_SCHED; PG8_LDA(At, 1, 0); PG8_STAGE(PG8_SA(0, 1), a2 + hstep, voffA);
            PG8_WAIT_V(8); PG8_WAIT_L(0); PG8_BAR; PG8_MMA(0, 0, At, B0); PG8_MMA(0, 1, At, B1); PG8_BAR; PG8_SCHED;
            PG8_LDA(At, 1, 1); PG8_STAGE(PG8_SB(1, 0), b3, voffB); PG8_STAGE(PG8_SB(1, 1), b3 + hstep, voffB); PG8_STAGE(PG8_SA(1, 0), a3, voffA);
            PG8_WAIT_V(8); PG8_WAIT_L(0); PG8_BAR; PG8_MMA(1, 0, At, B0); PG8_MMA(1, 1, At, B1); PG8_BAR; PG8_SCHED;
            } else {
            PG8_LDB(B0, 0, 0); PG8_SCHED; PG8_LDA(At, 0, 0); PG8_STAGE(PG8_SA(1, 1), a1 + hstep, voffA);
            PG8_WAIT_L(8); PG8_BAR; PG8_WAIT_L(0); PG8_MMA(0, 0, At, B0); PG8_BAR; PG8_SCHED;
            PG8_LDB(B1, 0, 1); PG8_STAGE(PG8_SB(0, 0), b2, voffB);
            PG8_BAR; PG8_WAIT_L(0); PG8_MMA(0, 1, At, B1); PG8_BAR;
            PG8_LDA(At, 0, 1); PG8_STAGE(PG8_SA(0, 0), a2, voffA);
            PG8_BAR; PG8_WAIT_L(0); PG8_MMA(1, 0, At, B0); PG8_BAR; PG8_SCHED;
            PG8_STAGE(PG8_SB(0, 1), b2 + hstep, voffB);
            PG8_WAIT_V(6); PG8_BAR; PG8_MMA(1, 1, At, B1); PG8_BAR;
            PG8_LDB(B0, 1, 0); PG8_SCHED; PG8_LDA(At, 1, 0); PG8_STAGE(PG8_SA(0, 1), a2 + hstep, voffA);
            PG8_WAIT_L(8); PG8_BAR; PG8_WAIT_L(0); PG8_MMA(0, 0, At, B0); PG8_BAR; PG8_SCHED;
            PG8_LDB(B1, 1, 1); PG8_STAGE(PG8_SB(1, 0), b3, voffB);
            PG8_BAR; PG8_WAIT_L(0); PG8_MMA(0, 1, At, B1); PG8_BAR;
            PG8_LDA(At, 1, 1); PG8_STAGE(PG8_SA(1, 0), a3, voffA);
            PG8_BAR; PG8_WAIT_L(0); PG8_MMA(1, 0, At, B0); PG8_BAR; PG8_SCHED;
            PG8_STAGE(PG8_SB(1, 1), b3 + hstep, voffB);
            PG8_WAIT_V(6); PG8_BAR; PG8_MMA(1, 1, At, B1); PG8_BAR;
            }
        }
        if constexpr (ALIGN_EPI) { if (wr == 0) PG8_BAR; }
        if constexpr (!Epi::AFTER_DRAIN) { E(acc, cur, wr, wc, fr, fq); S.done(cur); }
        if (!has_next) break;
#pragma unroll
        for (int a = 0; a < 2; ++a)
#pragma unroll
            for (int b = 0; b < 2; ++b)
#pragma unroll
                for (int m = 0; m < 4; ++m)
#pragma unroll
                    for (int n = 0; n < 2; ++n) acc[a][b][m][n] = (f32x4){0.f, 0.f, 0.f, 0.f};
        cur = nxt; cA = nA; cB = nB; ++ui;
        if constexpr (ALIGN_EPI) { if (wr == 1) PG8_BAR; }
    }
    PG8_WAIT_V(0);
    if constexpr (!ALIGN_EPI) { if (wr == 0) PG8_BAR; }
    PG8_BAR;
    if constexpr (Epi::AFTER_DRAIN) { E.fused(acc, cur, wr, wc, fr, fq, lds, wid, lane); S.done(cur); }
#undef PG8_SA
#undef PG8_SB
#undef PG8_STAGE
#undef PG8_LDA
#undef PG8_LDB
#undef PG8_MMA
#undef PG8_WAIT_V
#undef PG8_WAIT_L
#undef PG8_BAR
#undef PG8_SCHED
}
}
#ifndef PG8_SP2
#define PG8_SP2 true
#endif
#ifndef PG8_ALIGN
#define PG8_ALIGN true
#endif

#define LAS __attribute__((address_space(3)))
typedef unsigned short bf16;
typedef unsigned v4u __attribute__((ext_vector_type(4)));
typedef unsigned v2u __attribute__((ext_vector_type(2)));
typedef float f32x4 __attribute__((ext_vector_type(4)));
typedef short bf16x8 __attribute__((ext_vector_type(8)));
constexpr int NWAVES = 8, NTHR = 512;
constexpr int DM = 2048, NB = 4, SEQ = 2048, NMETA = 16, LP = 2064, DB = 128, DS = 4;
constexpr int MP = NB * LP;
constexpr int MS = DB * DS;
constexpr int MR = MP + MS;
constexpr int MPAD = 8960;
constexpr int NH = 32, NPROJ = 9248, NMAIN = 9216, DFF = 8192, DMIX = 4096, DCONV = 3072;
constexpr int NSEG = 33;
constexpr float EPS = 1e-6f;
constexpr size_t MiB = 1u << 20;
constexpr size_t WS_WIN = 1 * MiB, WS_WOUT = 38 * MiB, WS_WUP = 54 * MiB, WS_WDN = 86 * MiB, WS_WG = 118 * MiB;
constexpr size_t WS_H = 120 * MiB, WS_XN = 120 * MiB, WS_MIX = 120 * MiB, WS_XS = 190 * MiB, WS_BC = 225 * MiB;
constexpr size_t WS_PART = 260 * MiB, WS_A = 260 * MiB, WS_BT = 330 * MiB, WS_PXL = 260 * MiB, WS_PXBC = 295 * MiB;
constexpr size_t WS_PG = 400 * MiB, WS_PZ = 435 * MiB, WS_X1 = 400 * MiB, WS_XL = 470 * MiB, WS_HP = 470 * MiB;
constexpr size_t WS_DT = 505 * MiB, WS_AGGA = 507 * MiB, WS_AGGH = 509 * MiB, WS_END = 512 * MiB;
constexpr size_t WS_R2 = 330 * MiB;
constexpr int LDS_BYTES = 147456;
constexpr int NPHASE = 12;

struct Args { const float* in[28]; float* out; unsigned char* ws; int ph_lo, ph_hi; };
constexpr size_t O_YP = 0, O_YS = 16777216, O_PLH = O_YS + 1048576, O_PLC = O_PLH + 8192, O_PSSD = O_PLC + 24576, O_PSC = O_PSSD + 1048576,
                 O_SLH = O_PSC + 36864, O_SLC = O_SLH + 262144, O_SSSD = O_SLC + 786432, O_SSC = O_SSSD + 33554432, O_END = O_SSC + 1179648;

struct Ctx {
    const float *xp, *xs, *st_lru_h, *st_lru_conv, *st_ssd, *st_ssd_conv, *meta, *g_mix, *w_in, *conv_lru_w, *conv_lru_b, *lru_wa, *lru_ba, *lru_wx, *lru_bx,
                *lru_lam, *g_lru_out, *conv_ssd_w, *conv_ssd_b, *dt_bias, *a_log, *d_skip, *g_ssd_out, *w_out, *g_mlp, *w_up, *w_down, *g_final;
    float* out; unsigned char* ws;
    LAS unsigned char* lds;
    int tid, lane, wave, blk, G;
};

__device__ __forceinline__ unsigned f2bf(float f) { unsigned u = __builtin_bit_cast(unsigned, f); return (u + 0x7fffu + ((u >> 16) & 1u)) >> 16; }
__device__ __forceinline__ unsigned pk2(float lo, float hi) { unsigned r; asm("v_cvt_pk_bf16_f32 %0, %1, %2" : "=v"(r) : "v"(lo), "v"(hi)); return r; }
__device__ __forceinline__ float bflo(unsigned w) { return __builtin_bit_cast(float, w << 16); }
__device__ __forceinline__ float bfhi(unsigned w) { return __builtin_bit_cast(float, w & 0xffff0000u); }
__device__ __forceinline__ float bf1(bf16 h) { return __builtin_bit_cast(float, ((unsigned)h) << 16); }
#define SUM_DPP_STEP(v, ctrl, rmask) do { const int t_ = __builtin_amdgcn_update_dpp(0, __builtin_bit_cast(int, v), ctrl, rmask, 0xf, false); v += __builtin_bit_cast(float, t_); } while (0)
__device__ __forceinline__ float wave_sum(float v) {
    SUM_DPP_STEP(v, 0x111, 0xf); SUM_DPP_STEP(v, 0x112, 0xf); SUM_DPP_STEP(v, 0x114, 0xf); SUM_DPP_STEP(v, 0x118, 0xf);
    SUM_DPP_STEP(v, 0x142, 0xa); SUM_DPP_STEP(v, 0x143, 0xc);
    return __builtin_bit_cast(float, __builtin_amdgcn_readlane(__builtin_bit_cast(int, v), 63));
}
__device__ __forceinline__ float sigmoidf_(float x) { return __builtin_amdgcn_rcpf(1.0f + __expf(-x)); }
__device__ __forceinline__ float siluf_(float x) { return x * __builtin_amdgcn_rcpf(1.0f + __expf(-x)); }
__device__ __forceinline__ float softplusf_(float x) { return x > 20.f ? x : log1pf(expf(x)); }
__device__ __forceinline__ float gelu_tanh(float x) { const float u = 0.7978845608028654f * (x + 0.044715f * x * x * x); const float t = 1.0f - 2.0f * __builtin_amdgcn_rcpf(__expf(2.0f * u) + 1.0f); return 0.5f * x * (1.0f + t); }

__device__ __forceinline__ const float* xrow_ptr(const Ctx& F, int r) {
    if (r < MP) { const int b = r / LP, t = r - b * LP; return t < NMETA ? F.meta + (size_t)t * DM : F.xp + ((size_t)b * SEQ + (t - NMETA)) * DM; }
    return F.xs + (size_t)(r - MP) * DM;
}

__device__ __forceinline__ void transpose_item(const float* W, int ldw, bf16* WT, int K, int k0, int n0, LAS float* scr, int lane) {
#pragma unroll 8
    for (int i = 0; i < 32; ++i) { const int kk = 2 * i + (lane >> 5); scr[kk * 33 + (lane & 31)] = W[(size_t)(k0 + kk) * ldw + n0 + (lane & 31)]; }
    asm volatile("s_waitcnt lgkmcnt(0)" ::: "memory");
    const int c = lane & 7;
#pragma unroll
    for (int j = 0; j < 4; ++j) { const int n = (lane >> 3) + 8 * j; const LAS float* s = scr + (8 * c) * 33 + n;
        v4u o; o.x = pk2(s[0 * 33], s[1 * 33]); o.y = pk2(s[2 * 33], s[3 * 33]); o.z = pk2(s[4 * 33], s[5 * 33]); o.w = pk2(s[6 * 33], s[7 * 33]);
        *(v4u*)(WT + (size_t)(n0 + n) * K + k0 + 8 * c) = o; }
    asm volatile("s_waitcnt lgkmcnt(0)" ::: "memory");
}
__device__ __forceinline__ void rms_row_store(const f32x4 (&v)[8], const float* g, bf16* orow, int lane) {
    float ss = 0.f;
#pragma unroll
    for (int j = 0; j < 8; ++j) ss += (v[j].x * v[j].x + v[j].y * v[j].y) + (v[j].z * v[j].z + v[j].w * v[j].w);
    const float rs = rsqrtf(wave_sum(ss) * (1.f / DM) + EPS);
#pragma unroll
    for (int j = 0; j < 8; ++j) { const f32x4 gg = *(const f32x4*)(g + 4 * lane + 256 * j); const f32x4 o = v[j] * rs * gg;
        v2u w; w.x = pk2(o.x, o.y); w.y = pk2(o.z, o.w); *(v2u*)(orow + 4 * lane + 256 * j) = w; }
}
constexpr int I_IN = 32 * 289, I_OUT = 64 * 64, I_UP = 32 * 256, I_DN = 128 * 64, I_G = 256, NITEMS = I_IN + I_OUT + I_UP + I_DN + I_G;
__device__ __forceinline__ void convert_range(const Ctx& F, int lo, int hi, int part, int nparts) {
    LAS float* scr = (LAS float*)(F.lds + F.wave * 16384);
    bf16* WIN = (bf16*)(F.ws + WS_WIN); bf16* WOUT = (bf16*)(F.ws + WS_WOUT); bf16* WUP = (bf16*)(F.ws + WS_WUP); bf16* WDN = (bf16*)(F.ws + WS_WDN); bf16* WG = (bf16*)(F.ws + WS_WG);
    for (int it = lo + part * NWAVES + F.wave; it < hi; it += nparts * NWAVES) {
        int r = it;
        if (r < I_IN) { transpose_item(F.w_in, NPROJ, WIN, 2048, 64 * (r / 289), 32 * (r % 289), scr, F.lane); continue; } r -= I_IN;
        if (r < I_OUT) { transpose_item(F.w_out, 2048, WOUT, 4096, 64 * (r / 64), 32 * (r % 64), scr, F.lane); continue; } r -= I_OUT;
        if (r < I_UP) { transpose_item(F.w_up, 8192, WUP, 2048, 64 * (r / 256), 32 * (r % 256), scr, F.lane); continue; } r -= I_UP;
        if (r < I_DN) { transpose_item(F.w_down, 2048, WDN, 8192, 64 * (r / 64), 32 * (r % 64), scr, F.lane); continue; } r -= I_DN;
        { const int mat = r >> 7, hd = (r >> 3) & 15, sub = r & 7;
          transpose_item((mat ? F.lru_wx : F.lru_wa) + (size_t)hd * 16384, 128, WG + (size_t)(hd * 256 + mat * 128) * 128, 128, 64 * (sub >> 2), 32 * (sub & 3), scr, F.lane); }
    }
}
__device__ __forceinline__ void slack_parts(int n, int G, int blk, int& part, int& nparts) {
    const int nmax = (n + G - 1) / G, cut = (n % G == 0) ? 0 : n - (nmax - 1) * G;
    part = blk - cut; nparts = G - cut;
}
__device__ __forceinline__ void phase_prologue(const Ctx& F) {
    const int gw = F.blk * NWAVES + F.wave, NGW = F.G * NWAVES;
    convert_range(F, 0, I_IN, F.blk, F.G);
    convert_range(F, I_IN + I_OUT + I_UP + I_DN, NITEMS, F.blk, F.G);
    bf16* XN = (bf16*)(F.ws + WS_XN);
    for (int m = gw; m < MPAD; m += NGW) {
        bf16* orow = XN + (size_t)m * DM;
        if (m >= MR) {
#pragma unroll
            for (int j = 0; j < 8; ++j) *(v2u*)(orow + 4 * F.lane + 256 * j) = (v2u){0u, 0u};
            continue; }
        const float* xr = xrow_ptr(F, m); f32x4 v[8];
#pragma unroll
        for (int j = 0; j < 8; ++j) v[j] = *(const f32x4*)(xr + 4 * F.lane + 256 * j);
        rms_row_store(v, F.g_mix, orow, F.lane);
    }
}

__device__ __forceinline__ void phase_dt(const Ctx& F) {
    const int fr = F.lane & 15, fq = F.lane >> 4;
    const bf16* XN = (const bf16*)(F.ws + WS_XN); const bf16* WD = (const bf16*)(F.ws + WS_WIN) + (size_t)NMAIN * 2048; float* DT = (float*)(F.ws + WS_DT);
    LAS float* red = (LAS float*)F.lds;
    for (int blk = F.blk; blk < MR / 16; blk += F.G) {
        f32x4 c0 = {0.f, 0.f, 0.f, 0.f}, c1 = {0.f, 0.f, 0.f, 0.f};
        const int kb = F.wave * 256;
        const bf16* ap = XN + (size_t)(blk * 16 + fr) * DM + kb + fq * 8; const bf16* b0p = WD + (size_t)fr * DM + kb + fq * 8; const bf16* b1p = WD + (size_t)(16 + fr) * DM + kb + fq * 8;
#pragma unroll
        for (int k0 = 0; k0 < 256; k0 += 32) {
            const bf16x8 a = *(const bf16x8*)(ap + k0), b0 = *(const bf16x8*)(b0p + k0), b1 = *(const bf16x8*)(b1p + k0);
            c0 = __builtin_amdgcn_mfma_f32_16x16x32_bf16(a, b0, c0, 0, 0, 0); c1 = __builtin_amdgcn_mfma_f32_16x16x32_bf16(a, b1, c1, 0, 0, 0);
        }
        *(LAS f32x4*)(red + (F.wave * 64 + F.lane) * 8) = c0; *(LAS f32x4*)(red + (F.wave * 64 + F.lane) * 8 + 4) = c1;
        __syncthreads();
        if (F.wave == 0) {
#pragma unroll
            for (int w = 1; w < 8; ++w) { c0 += *(const LAS f32x4*)(red + (w * 64 + F.lane) * 8); c1 += *(const LAS f32x4*)(red + (w * 64 + F.lane) * 8 + 4); }
            const float bb0 = F.dt_bias[fr], bb1 = F.dt_bias[16 + fr];
#pragma unroll
            for (int e = 0; e < 4; ++e) { const int row = blk * 16 + fq * 4 + e; DT[row * NH + fr] = softplusf_(c0[e] + bb0); DT[row * NH + 16 + fr] = softplusf_(c1[e] + bb1); }
        }
        __syncthreads();
    }
}

__device__ __forceinline__ void phase_conv(const Ctx& F) {
    const bf16* PXL = (const bf16*)(F.ws + WS_PXL); const bf16* PXBC = (const bf16*)(F.ws + WS_PXBC);
    bf16* XL = (bf16*)(F.ws + WS_XL); bf16* XS = (bf16*)(F.ws + WS_XS); bf16* BC = (bf16*)(F.ws + WS_BC);
    constexpr int NRB = MR / 4, NCG = 640;
    const int vblk = (F.G % 8 == 0) ? (F.blk & 7) * (F.G >> 3) + (F.blk >> 3) : F.blk;
    for (int idx = vblk * NTHR + F.tid; idx < NRB * NCG; idx += F.G * NTHR) {
        const int cg_ = idx % NCG, rb = idx / NCG; const bool lru = cg_ < 256;
        const int c0 = lru ? cg_ * 8 : (cg_ - 256) * 8, ld = lru ? 2048 : 3072;
        const bf16* src = lru ? PXL : PXBC; const float* cw = lru ? F.conv_lru_w : F.conv_ssd_w; const float* cb = lru ? F.conv_lru_b : F.conv_ssd_b;
        const int row0 = rb * 4; const bool prompt = row0 < MP;
        int b = 0, t0 = 0, s = 0; if (prompt) { b = row0 / LP; t0 = row0 - b * LP; } else s = (row0 - MP) >> 2;
        float win[7][8];
        if (prompt) {
            if (t0 == 0) {
#pragma unroll
                for (int i = 0; i < 3; ++i)
#pragma unroll
                    for (int e = 0; e < 8; ++e) win[i][e] = 0.f;
            } else {
#pragma unroll
                for (int i = 0; i < 3; ++i) { const v4u w = *(const v4u*)(src + (size_t)(row0 - 3 + i) * ld + c0);
                    win[i][0] = bflo(w.x); win[i][1] = bfhi(w.x); win[i][2] = bflo(w.y); win[i][3] = bfhi(w.y); win[i][4] = bflo(w.z); win[i][5] = bfhi(w.z); win[i][6] = bflo(w.w); win[i][7] = bfhi(w.w); }
            }
        } else {
            const float* st = (lru ? F.st_lru_conv : F.st_ssd_conv) + (size_t)s * 3 * ld + c0;
#pragma unroll
            for (int i = 0; i < 3; ++i) { const f32x4 u0 = *(const f32x4*)(st + (size_t)i * ld), u1 = *(const f32x4*)(st + (size_t)i * ld + 4);
                win[i][0] = u0.x; win[i][1] = u0.y; win[i][2] = u0.z; win[i][3] = u0.w; win[i][4] = u1.x; win[i][5] = u1.y; win[i][6] = u1.z; win[i][7] = u1.w; }
        }
#pragma unroll
        for (int i = 0; i < 4; ++i) { const v4u w = *(const v4u*)(src + (size_t)(row0 + i) * ld + c0);
            win[3 + i][0] = bflo(w.x); win[3 + i][1] = bfhi(w.x); win[3 + i][2] = bflo(w.y); win[3 + i][3] = bfhi(w.y); win[3 + i][4] = bflo(w.z); win[3 + i][5] = bfhi(w.z); win[3 + i][6] = bflo(w.w); win[3 + i][7] = bfhi(w.w); }
        float wk[4][8], bias[8];
#pragma unroll
        for (int k = 0; k < 4; ++k) { const f32x4 u0 = *(const f32x4*)(cw + (size_t)k * ld + c0), u1 = *(const f32x4*)(cw + (size_t)k * ld + c0 + 4);
            wk[k][0] = u0.x; wk[k][1] = u0.y; wk[k][2] = u0.z; wk[k][3] = u0.w; wk[k][4] = u1.x; wk[k][5] = u1.y; wk[k][6] = u1.z; wk[k][7] = u1.w; }
        { const f32x4 u0 = *(const f32x4*)(cb + c0), u1 = *(const f32x4*)(cb + c0 + 4); bias[0] = u0.x; bias[1] = u0.y; bias[2] = u0.z; bias[3] = u0.w; bias[4] = u1.x; bias[5] = u1.y; bias[6] = u1.z; bias[7] = u1.w; }
#pragma unroll
        for (int j = 0; j < 4; ++j) {
            float o[8];
#pragma unroll
            for (int e = 0; e < 8; ++e) { float v = bias[e] + win[j][e] * wk[0][e]; v += win[j + 1][e] * wk[1][e]; v += win[j + 2][e] * wk[2][e]; v += win[j + 3][e] * wk[3][e]; o[e] = v; }
            const size_t row = (size_t)(row0 + j);
            if (lru) { v4u w; w.x = pk2(o[0], o[1]); w.y = pk2(o[2], o[3]); w.z = pk2(o[4], o[5]); w.w = pk2(o[6], o[7]); *(v4u*)(XL + row * 2048 + c0) = w; }
            else {
#pragma unroll
                for (int e = 0; e < 8; ++e) o[e] = siluf_(o[e]);
                if (c0 < 2048) { v4u w; w.x = pk2(o[0], o[1]); w.y = pk2(o[2], o[3]); w.z = pk2(o[4], o[5]); w.w = pk2(o[6], o[7]); *(v4u*)(XS + row * 2048 + c0) = w; }
                else { v4u w; w.x = pk2(o[0], o[1]); w.y = pk2(o[2], o[3]); w.z = pk2(o[4], o[5]); w.w = pk2(o[6], o[7]); *(v4u*)(BC + row * 1024 + (c0 - 2048)) = w; }
            }
        }
        float* cst = nullptr;
        if (prompt) { if (t0 == LP - 4) cst = F.out + (lru ? O_PLC : O_PSC) + (size_t)b * 3 * ld + c0; }
        else cst = F.out + (lru ? O_SLC : O_SSC) + (size_t)s * 3 * ld + c0;
        if (cst) {
#pragma unroll
            for (int i = 0; i < 3; ++i) { *(f32x4*)(cst + (size_t)i * ld) = (f32x4){win[4 + i][0], win[4 + i][1], win[4 + i][2], win[4 + i][3]}; *(f32x4*)(cst + (size_t)i * ld + 4) = (f32x4){win[4 + i][4], win[4 + i][5], win[4 + i][6], win[4 + i][7]}; }
        }
    }
}

__device__ __forceinline__ void gate_unit(const Ctx& F, int pm, int head) {
    constexpr int RS = 272;
    LAS unsigned char* LA = F.lds; LAS unsigned char* LB = F.lds + 256 * RS;
    const bf16* XL = (const bf16*)(F.ws + WS_XL) + (size_t)pm * 256 * 2048 + head * 128; const bf16* WG = (const bf16*)(F.ws + WS_WG) + (size_t)head * 256 * 128;
    float* Ao = (float*)(F.ws + WS_A); float* Bo = (float*)(F.ws + WS_BT);
    { const int row = F.tid >> 4, cp = F.tid & 15;
      const bf16* ga = XL + (size_t)row * 2048 + cp * 8; const bf16* gb = WG + row * 128 + cp * 8; LAS unsigned char* la = LA + row * RS + cp * 16;
#pragma unroll 2
      for (int i = 0; i < 8; ++i) { const v4u va = *(const v4u*)(ga + (size_t)i * 32 * 2048), vb = *(const v4u*)(gb + i * 32 * 128);
          *(LAS v4u*)(la + i * 32 * RS) = va; *(LAS v4u*)(la + 256 * RS + i * 32 * RS) = vb; } }
    __syncthreads();
    const int wr = F.wave >> 2, wc = F.wave & 3, fr = F.lane & 15, fq = F.lane >> 4;
    float cba[2][4], cbx[2][4], csp[2][4];
#pragma unroll
    for (int n = 0; n < 2; ++n)
#pragma unroll
        for (int e = 0; e < 4; ++e) { const int ch = head * 128 + 32 * wc + 16 * n + 4 * fq + e; cba[n][e] = F.lru_ba[ch]; cbx[n][e] = F.lru_bx[ch]; csp[n][e] = 8.0f * softplusf_(-F.lru_lam[ch]); }
#pragma unroll 1
    for (int mh = 0; mh < 2; ++mh) {
        f32x4 accr[4][2], acci[4][2];
#pragma unroll
        for (int m = 0; m < 4; ++m)
#pragma unroll
            for (int n = 0; n < 2; ++n) { accr[m][n] = (f32x4){0.f, 0.f, 0.f, 0.f}; acci[m][n] = (f32x4){0.f, 0.f, 0.f, 0.f}; }
        const int rbase = 128 * wr + 64 * mh;
#pragma unroll
        for (int ks = 0; ks < 4; ++ks) {
            bf16x8 br[2], bi[2];
#pragma unroll
            for (int n = 0; n < 2; ++n) { br[n] = *(const LAS bf16x8*)(LB + (32 * wc + 16 * n + fr) * RS + (32 * ks + 8 * fq) * 2); bi[n] = *(const LAS bf16x8*)(LB + (128 + 32 * wc + 16 * n + fr) * RS + (32 * ks + 8 * fq) * 2); }
#pragma unroll
            for (int m = 0; m < 4; ++m) { const bf16x8 af = *(const LAS bf16x8*)(LA + (rbase + 16 * m + fr) * RS + (32 * ks + 8 * fq) * 2);
#pragma unroll
                for (int n = 0; n < 2; ++n) { accr[m][n] = __builtin_amdgcn_mfma_f32_16x16x32_bf16(br[n], af, accr[m][n], 0, 0, 0); acci[m][n] = __builtin_amdgcn_mfma_f32_16x16x32_bf16(bi[n], af, acci[m][n], 0, 0, 0); } }
        }
#pragma unroll
        for (int m = 0; m < 4; ++m) {
            const int rl = rbase + 16 * m + fr, row = pm * 256 + rl;
            if (row < MR) {
                const bool first = (row < MP) && (row % LP == 0);
                const float* h0p = (row >= MP && ((row - MP) & 3) == 0) ? F.st_lru_h + (size_t)((row - MP) >> 2) * 2048 : nullptr;
#pragma unroll
                for (int n = 0; n < 2; ++n) {
                    const int j0 = 32 * wc + 16 * n + 4 * fq, ch0 = head * 128 + j0;
                    const v2u xw = *(const LAS v2u*)(LA + rl * RS + j0 * 2);
                    const float xl[4] = {bflo(xw.x), bfhi(xw.x), bflo(xw.y), bfhi(xw.y)};
                    f32x4 h0v = {0.f, 0.f, 0.f, 0.f}; if (h0p) h0v = *(const f32x4*)(h0p + ch0);
                    f32x4 av, bv;
#pragma unroll
                    for (int e = 0; e < 4; ++e) {
                        const float r = sigmoidf_(accr[m][n][e] + cba[n][e]), ii = sigmoidf_(acci[m][n][e] + cbx[n][e]);
                        const float a = __expf(-csp[n][e] * r); const float mult = first ? 1.0f : __builtin_amdgcn_sqrtf(fmaxf(1.0f - a * a, 0.f));
                        av[e] = a; bv[e] = mult * ii * xl[e] + a * h0v[e];
                    }
                    *(f32x4*)(Ao + (size_t)row * 2048 + ch0) = av; *(f32x4*)(Bo + (size_t)row * 2048 + ch0) = bv;
                }
            }
        }
    }
    __syncthreads();
}
__device__ __forceinline__ void phase_gates(const Ctx& F) {
    for (int u = F.blk; u < 35 * 16; u += F.G) gate_unit(F, u >> 4, u & 15);
#ifdef PROBE_G2
    for (int u = F.blk; u < 35 * 16; u += F.G) gate_unit(F, u >> 4, u & 15);
#endif
    int part, nparts; slack_parts(35 * 16, F.G, F.blk, part, nparts);
    if (part >= 0) convert_range(F, I_IN, I_IN + I_OUT + I_UP, part, nparts);
#ifdef PROBE_C2
    __syncthreads();
    if (part >= 0) convert_range(F, I_IN, I_IN + I_OUT + I_UP, part, nparts);
#endif
}

__device__ __forceinline__ void ssd_unit(const Ctx& F, int row0, int T, int head, const float* h0, float* hout) {
    const float* DT = (const float*)(F.ws + WS_DT); const bf16* XS = (const bf16*)(F.ws + WS_XS); const float* BC = (const float*)(F.ws + WS_BC); const bf16* PZ = (const bf16*)(F.ws + WS_PZ);
    bf16* MIX = (bf16*)(F.ws + WS_MIX);
    LAS float* xch = (LAS float*)F.lds;
    const int g = head >> 3, wave = F.wave, lane = F.lane;
    const float Ah = -expf(F.a_log[head]), Dh = F.d_skip[head];
    f32x4 h[4];
#pragma unroll
    for (int q = 0; q < 4; ++q) h[q] = h0 ? *(const f32x4*)(h0 + ((size_t)head * 64 + lane) * 128 + 16 * wave + 4 * q) : (f32x4){0.f, 0.f, 0.f, 0.f};
    for (int tb = 0; tb < T; tb += 4) {
        float part[4];
#pragma unroll
        for (int tt = 0; tt < 4; ++tt) {
            const size_t row = (size_t)(row0 + tb + tt);
            const float dt = DT[row * NH + head]; const float dA = __expf(dt * Ah);
            const float dtx = dt * bf1(XS[row * 2048 + head * 64 + lane]);
            const f32x4* Bp = (const f32x4*)(BC + row * 1024 + g * 128 + 16 * wave); const f32x4* Cp = (const f32x4*)(BC + row * 1024 + 512 + g * 128 + 16 * wave);
            float acc = 0.f;
#pragma unroll
            for (int q = 0; q < 4; ++q) { const f32x4 b4 = Bp[q], c4 = Cp[q];
#pragma unroll
                for (int e = 0; e < 4; ++e) { h[q][e] = dA * h[q][e] + dtx * b4[e]; acc += h[q][e] * c4[e]; } }
            part[tt] = acc;
        }
        const int buf = (tb >> 2) & 1;
#pragma unroll
        for (int tt = 0; tt < 4; ++tt) xch[buf * 2048 + (wave * 4 + tt) * 64 + lane] = part[tt];
        __syncthreads();
        if (F.tid < 256) {
            const int tt = F.tid >> 6, p = F.tid & 63; float y = 0.f;
#pragma unroll
            for (int w = 0; w < 8; ++w) y += xch[buf * 2048 + (w * 4 + tt) * 64 + p];
            const size_t row = (size_t)(row0 + tb + tt);
            const float x = bf1(XS[row * 2048 + head * 64 + p]), z = bf1(PZ[row * 2048 + head * 64 + p]);
            MIX[row * 4096 + 2048 + head * 64 + p] = (bf16)f2bf((y + Dh * x) * siluf_(z));
        }
    }
#pragma unroll
    for (int q = 0; q < 4; ++q) *(f32x4*)(hout + ((size_t)head * 64 + lane) * 128 + 16 * wave + 4 * q) = h[q];
    __syncthreads();
}

__device__ __forceinline__ void ssd_sample_wave(const Ctx& F, int part, int nparts) {
    const float* DT = (const float*)(F.ws + WS_DT); const bf16* XS = (const bf16*)(F.ws + WS_XS); const float* BC = (const float*)(F.ws + WS_BC); const bf16* PZ = (const bf16*)(F.ws + WS_PZ);
    bf16* MIX = (bf16*)(F.ws + WS_MIX);
    const int gw = part * NWAVES + F.wave, NGW = nparts * NWAVES, lane = F.lane, pl = lane >> 3, no = lane & 7;
    constexpr int NU = DB * NH * 8;
    f32x4 hn[4];
    if (gw < NU) { const float* hp = F.st_ssd + ((size_t)(gw >> 3) * 64 + (gw & 7) * 8 + pl) * 128 + 16 * no;
#pragma unroll
        for (int q = 0; q < 4; ++q) hn[q] = *(const f32x4*)(hp + 4 * q); }
    for (int u = gw; u < NU; u += NGW) {
        const int po = u & 7, head = (u >> 3) & 31, s_ = u >> 8, g = head >> 3, p = po * 8 + pl;
        f32x4 h[4];
#pragma unroll
        for (int q = 0; q < 4; ++q) h[q] = hn[q];
        const int un = u + NGW;
        if (un < NU) { const float* hp = F.st_ssd + ((size_t)(un >> 3) * 64 + (un & 7) * 8 + pl) * 128 + 16 * no;
#pragma unroll
            for (int q = 0; q < 4; ++q) hn[q] = *(const f32x4*)(hp + 4 * q); }
        const float Ah = -expf(F.a_log[head]), Dh = F.d_skip[head];
        float dtv[4], xv[4], zv[4]; f32x4 bv[4][4], cv[4][4];
#pragma unroll
        for (int j = 0; j < 4; ++j) { const size_t row = (size_t)(MP + 4 * s_ + j);
            dtv[j] = DT[row * NH + head]; xv[j] = bf1(XS[row * 2048 + head * 64 + p]); zv[j] = bf1(PZ[row * 2048 + head * 64 + p]);
            const float* bp = BC + row * 1024 + g * 128 + 16 * no;
#pragma unroll
            for (int q = 0; q < 4; ++q) { bv[j][q] = *(const f32x4*)(bp + 4 * q); cv[j][q] = *(const f32x4*)(bp + 512 + 4 * q); } }
#pragma unroll
        for (int j = 0; j < 4; ++j) {
            const float dA = __expf(dtv[j] * Ah), dtx = dtv[j] * xv[j]; float acc = 0.f;
#pragma unroll
            for (int q = 0; q < 4; ++q)
#pragma unroll
                for (int e = 0; e < 4; ++e) { h[q][e] = dA * h[q][e] + dtx * bv[j][q][e]; acc += h[q][e] * cv[j][q][e]; }
            acc += __shfl_xor(acc, 1); acc += __shfl_xor(acc, 2); acc += __shfl_xor(acc, 4);
            if (no == 0) MIX[(size_t)(MP + 4 * s_ + j) * 4096 + 2048 + head * 64 + p] = (bf16)f2bf((acc + Dh * xv[j]) * siluf_(zv[j]));
        }
        float* op = F.out + O_SSSD + ((size_t)(u >> 3) * 64 + po * 8 + pl) * 128 + 16 * no;
#pragma unroll
        for (int q = 0; q < 4; ++q) *(f32x4*)(op + 4 * q) = h[q];
    }
}

__device__ __forceinline__ void ssd_sample_blk(const Ctx& F, int part, int nparts) {
    const float* DT = (const float*)(F.ws + WS_DT); const bf16* XS = (const bf16*)(F.ws + WS_XS); const bf16* BC = (const bf16*)(F.ws + WS_BC); const bf16* PZ = (const bf16*)(F.ws + WS_PZ);
    bf16* MIX = (bf16*)(F.ws + WS_MIX);
    LAS float* sb = (LAS float*)F.lds;
    const int lane = F.lane, pl = lane >> 3, no = lane & 7, p = F.wave * 8 + pl;
    constexpr int NIT = DB * 4;
    f32x4 hn[4]; float dtn[4]; unsigned xzn[4];
#define SMP_LOAD(it_, hh_) do { const int s2 = (it_) >> 2, hd2 = 8 * ((it_) & 3) + (hh_); const float* hp = F.st_ssd + (((size_t)s2 * NH + hd2) * 64 + p) * 128 + 16 * no; \
        _Pragma("unroll") for (int q = 0; q < 4; ++q) hn[q] = *(const f32x4*)(hp + 4 * q); \
        _Pragma("unroll") for (int j = 0; j < 4; ++j) { const size_t row = (size_t)(MP + 4 * s2 + j); dtn[j] = DT[row * NH + hd2]; xzn[j] = (unsigned)XS[row * 2048 + hd2 * 64 + p] | ((unsigned)PZ[row * 2048 + hd2 * 64 + p] << 16); } } while (0)
#pragma unroll 1
    for (int it = part; it < NIT; it += nparts) {
        const int s_ = it >> 2, g = it & 3;
        SMP_LOAD(it, 0);
        if (F.tid < 256) { const int tok = F.tid >> 6, r = F.tid & 63, which = r >> 5, n4 = r & 31;
            const v2u w = *(const v2u*)(BC + (size_t)(MP + 4 * s_ + tok) * 1024 + which * 512 + g * 128 + 4 * n4);
            *(LAS f32x4*)(sb + (tok * 2 + which) * 128 + 4 * n4) = (f32x4){bflo(w.x), bfhi(w.x), bflo(w.y), bfhi(w.y)}; }
        __syncthreads();
#pragma unroll 1
        for (int hh = 0; hh < 8; ++hh) {
            const int head = 8 * g + hh;
            f32x4 h[4]; float dtv[4]; unsigned xz[4];
#pragma unroll
            for (int q = 0; q < 4; ++q) h[q] = hn[q];
#pragma unroll
            for (int j = 0; j < 4; ++j) { dtv[j] = dtn[j]; xz[j] = xzn[j]; }
            if (hh < 7) SMP_LOAD(it, hh + 1);
            const float Ah = -expf(F.a_log[head]), Dh = F.d_skip[head];
#pragma unroll
            for (int j = 0; j < 4; ++j) {
                const float xv = bflo(xz[j]), zv = bfhi(xz[j]);
                const float dA = __expf(dtv[j] * Ah), dtx = dtv[j] * xv; float acc = 0.f;
#pragma unroll
                for (int q = 0; q < 4; ++q) { const f32x4 b4 = *(const LAS f32x4*)(sb + (j * 2) * 128 + 16 * no + 4 * q), c4 = *(const LAS f32x4*)(sb + (j * 2 + 1) * 128 + 16 * no + 4 * q);
#pragma unroll
                    for (int e = 0; e < 4; ++e) { h[q][e] = dA * h[q][e] + dtx * b4[e]; acc += h[q][e] * c4[e]; } }
                acc += __shfl_xor(acc, 1); acc += __shfl_xor(acc, 2); acc += __shfl_xor(acc, 4);
                if (no == 0) MIX[(size_t)(MP + 4 * s_ + j) * 4096 + 2048 + head * 64 + p] = (bf16)f2bf((acc + Dh * xv) * siluf_(zv));
            }
            float* op = F.out + O_SSSD + (((size_t)s_ * NH + head) * 64 + p) * 128 + 16 * no;
#pragma unroll
            for (int q = 0; q < 4; ++q) *(f32x4*)(op + 4 * q) = h[q];
        }
        __syncthreads();
    }
#undef SMP_LOAD
}
__device__ __forceinline__ void lru_aggregate(const Ctx& F, int part, int nparts) {
    const float* Ai = (const float*)(F.ws + WS_A); const float* Bi = (const float*)(F.ws + WS_BT); float* GA = (float*)(F.ws + WS_AGGA); float* GH = (float*)(F.ws + WS_AGGH);
    for (int idx = part * NTHR + F.tid; idx < NB * NSEG * 2048; idx += nparts * NTHR) {
        const int ch = idx & 2047, sg = (idx >> 11) % NSEG, b = idx / (2048 * NSEG);
        const int t0 = sg * 64, t1 = min(t0 + 64, LP);
        float ap = 1.f, hh = 0.f;
        if (t1 - t0 == 64) {
            for (int t = t0; t < t1; t += 32) { float av[32], bv[32];
#pragma unroll
                for (int k = 0; k < 32; ++k) { const size_t o = (size_t)(b * LP + t + k) * 2048 + ch; av[k] = Ai[o]; bv[k] = Bi[o]; }
#pragma unroll
                for (int k = 0; k < 32; ++k) { hh = av[k] * hh + bv[k]; ap *= av[k]; } }
        } else {
            for (int t = t0; t < t1; t += 16) { float av[16], bv[16];
#pragma unroll
                for (int k = 0; k < 16; ++k) { const size_t o = (size_t)(b * LP + t + k) * 2048 + ch; av[k] = Ai[o]; bv[k] = Bi[o]; }
#pragma unroll
                for (int k = 0; k < 16; ++k) { hh = av[k] * hh + bv[k]; ap *= av[k]; } }
        }
        GA[idx] = ap; GH[idx] = hh;
    }
}

constexpr int NCH = 33;
constexpr size_t WS_S = 260 * MiB;
constexpr size_t WS_DC = 506 * MiB + 512 * 1024;
__device__ __forceinline__ float dpp_add_(float v, float src_shifted_default0, int) { return v + src_shifted_default0; }
#define SCAN_DPP_STEP(v, ctrl, rmask) do { const int t_ = __builtin_amdgcn_update_dpp(0, __builtin_bit_cast(int, v), ctrl, rmask, 0xf, false); v += __builtin_bit_cast(float, t_); } while (0)
__device__ __forceinline__ float wave_scan_incl(float v, int lane) {
    (void)lane;
    SCAN_DPP_STEP(v, 0x111, 0xf); SCAN_DPP_STEP(v, 0x112, 0xf); SCAN_DPP_STEP(v, 0x114, 0xf); SCAN_DPP_STEP(v, 0x118, 0xf);
    SCAN_DPP_STEP(v, 0x142, 0xa); SCAN_DPP_STEP(v, 0x143, 0xc);
    return v;
}
__device__ __forceinline__ void ssdA_unit(const Ctx& F, int b, int c, int g) {
    const float* DT = (const float*)(F.ws + WS_DT); const bf16* XS = (const bf16*)(F.ws + WS_XS); const float* BC = (const float*)(F.ws + WS_BC);
    float* S = (float*)(F.ws + WS_S); float* DC = (float*)(F.ws + WS_DC);
    const int row0 = b * LP + 64 * c, nq = min(64, LP - 64 * c), lane = F.lane, wave = F.wave, fr = lane & 15, fq = lane >> 4;
    LAS unsigned char* BT = F.lds; LAS unsigned char* XT = F.lds + 18432;
    { const int n = F.tid & 127, jq = F.tid >> 7; unsigned w[8];
#pragma unroll
      for (int jj = 0; jj < 8; ++jj) { const int j0 = 16 * jq + 2 * jj;
          const float v0 = j0 < nq ? BC[(size_t)(row0 + j0) * 1024 + g * 128 + n] : 0.f, v1 = (j0 + 1) < nq ? BC[(size_t)(row0 + j0 + 1) * 1024 + g * 128 + n] : 0.f; w[jj] = pk2(v0, v1); }
      *(LAS v4u*)(BT + n * 144 + jq * 32) = (v4u){w[0], w[1], w[2], w[3]}; *(LAS v4u*)(BT + n * 144 + jq * 32 + 16) = (v4u){w[4], w[5], w[6], w[7]}; }
    float dt_n = lane < nq ? DT[(size_t)(row0 + lane) * NH + 8 * g] : 0.f; unsigned xr_n[8];
#pragma unroll
    for (int jj = 0; jj < 8; ++jj) { const int j0 = 8 * wave + jj; xr_n[jj] = j0 < nq ? (unsigned)XS[(size_t)(row0 + j0) * 2048 + (8 * g) * 64 + lane] : 0u; }
#pragma unroll 1
    for (int hh = 0; hh < 8; ++hh) {
        const int head = 8 * g + hh; const float Ah = -expf(F.a_log[head]);
        const float dtj = dt_n; unsigned xr[8];
#pragma unroll
        for (int jj = 0; jj < 8; ++jj) xr[jj] = xr_n[jj];
        if (hh < 7) { dt_n = lane < nq ? DT[(size_t)(row0 + lane) * NH + head + 1] : 0.f;
#pragma unroll
            for (int jj = 0; jj < 8; ++jj) { const int j0 = 8 * wave + jj; xr_n[jj] = j0 < nq ? (unsigned)XS[(size_t)(row0 + j0) * 2048 + (head + 1) * 64 + lane] : 0u; } }
        const float acum = wave_scan_incl(dtj * Ah, lane), aend = __shfl(acum, 63), wj = __expf(aend - acum) * dtj;
        LAS unsigned char* XTb = XT + (hh & 1) * 9216;
        { unsigned w[4];
#pragma unroll
          for (int jj = 0; jj < 4; ++jj) { const int j0 = 8 * wave + 2 * jj;
              w[jj] = pk2(bflo(xr[2 * jj]) * __shfl(wj, j0), bflo(xr[2 * jj + 1]) * __shfl(wj, j0 + 1)); }
          *(LAS v4u*)(XTb + lane * 144 + wave * 16) = (v4u){w[0], w[1], w[2], w[3]}; }
        __syncthreads();
        f32x4 acc[4];
#pragma unroll
        for (int pb = 0; pb < 4; ++pb) acc[pb] = (f32x4){0.f, 0.f, 0.f, 0.f};
#pragma unroll
        for (int ks = 0; ks < 2; ++ks) { const bf16x8 wf = *(const LAS bf16x8*)(BT + (16 * wave + fr) * 144 + (32 * ks + 8 * fq) * 2);
#pragma unroll
            for (int pb = 0; pb < 4; ++pb) { const bf16x8 af = *(const LAS bf16x8*)(XTb + (16 * pb + fr) * 144 + (32 * ks + 8 * fq) * 2); acc[pb] = __builtin_amdgcn_mfma_f32_16x16x32_bf16(wf, af, acc[pb], 0, 0, 0); } }
        float* Sp = S + ((((size_t)b * NCH + c) * NH + head) * 64) * 128;
#pragma unroll
        for (int pb = 0; pb < 4; ++pb) *(f32x4*)(Sp + (size_t)(16 * pb + fr) * 128 + 16 * wave + 4 * fq) = acc[pb];
        if (F.tid == 0) DC[(b * NCH + c) * NH + head] = __expf(aend);
    }
    __syncthreads();
}
__device__ __forceinline__ void phase_ssdA(const Ctx& F) { for (int u = F.blk; u < NB * NCH * 4; u += F.G) { const int g = u & 3, bc = u >> 2; ssdA_unit(F, bc / NCH, bc % NCH, g); } }
__device__ __forceinline__ void phase_ssdB(const Ctx& F) {
    float* S = (float*)(F.ws + WS_S); const float* DC = (const float*)(F.ws + WS_DC);
    for (int idx = F.blk * NTHR + F.tid; idx < NB * NH * 64 * 32; idx += F.G * NTHR) {
        const int e4 = idx & 2047, head = (idx >> 11) & 31, b = idx >> 16;
        f32x4 H = {0.f, 0.f, 0.f, 0.f};
        float* sp = S + ((size_t)b * NCH * NH + head) * 8192 + 4 * e4; const float* dp = DC + b * NCH * NH + head;
        f32x4 v0 = *(const f32x4*)sp, v1 = *(const f32x4*)(sp + (size_t)NH * 8192);
        for (int c = 0; c < NCH; ++c) { const f32x4 v2 = (c + 2 < NCH) ? *(const f32x4*)(sp + (size_t)(c + 2) * NH * 8192) : (f32x4){0.f, 0.f, 0.f, 0.f}; const float d = dp[c * NH];
            *(f32x4*)(sp + (size_t)c * NH * 8192) = H; H = H * d + v0; v0 = v1; v1 = v2; }
        *(f32x4*)(F.out + O_PSSD + ((size_t)b * NH + head) * 8192 + 4 * e4) = H;
    }
}
__device__ __forceinline__ void ssdC_unit(const Ctx& F, int b, int c, int g) {
    const float* DT = (const float*)(F.ws + WS_DT); const bf16* XS = (const bf16*)(F.ws + WS_XS); const float* BC = (const float*)(F.ws + WS_BC); const bf16* PZ = (const bf16*)(F.ws + WS_PZ);
    const float* S = (const float*)(F.ws + WS_S); bf16* MIX = (bf16*)(F.ws + WS_MIX);
    const int row0 = b * LP + 64 * c, nq = min(64, LP - 64 * c), lane = F.lane, wave = F.wave, fr = lane & 15, fq = lane >> 4;
    LAS unsigned char* Cs = F.lds; LAS unsigned char* Bs = F.lds + 17408; LAS unsigned char* HB = F.lds + 34816;
    { const int r = F.tid >> 3, n0 = (F.tid & 7) * 16; const bool ok = r < nq; const float* src = BC + (size_t)(row0 + r) * 1024 + g * 128 + n0;
#pragma unroll
      for (int m = 0; m < 2; ++m) {
          f32x4 v[4];
#pragma unroll
          for (int q = 0; q < 4; ++q) v[q] = ok ? *(const f32x4*)(src + m * 512 + 4 * q) : (f32x4){0.f, 0.f, 0.f, 0.f};
          LAS unsigned char* d = (m ? Cs : Bs) + r * 272 + n0 * 2;
          *(LAS v4u*)d = (v4u){pk2(v[0].x, v[0].y), pk2(v[0].z, v[0].w), pk2(v[1].x, v[1].y), pk2(v[1].z, v[1].w)};
          *(LAS v4u*)(d + 16) = (v4u){pk2(v[2].x, v[2].y), pk2(v[2].z, v[2].w), pk2(v[3].x, v[3].y), pk2(v[3].z, v[3].w)}; } }
    __syncthreads();
    const int ib = wave >> 1, tb0 = 2 * (wave & 1);
    f32x4 cb[2] = {{0.f, 0.f, 0.f, 0.f}, {0.f, 0.f, 0.f, 0.f}};
#pragma unroll
    for (int ks = 0; ks < 4; ++ks) { const bf16x8 af = *(const LAS bf16x8*)(Cs + (16 * ib + fr) * 272 + (32 * ks + 8 * fq) * 2);
#pragma unroll
        for (int t = 0; t < 2; ++t) { const bf16x8 wf = *(const LAS bf16x8*)(Bs + (16 * (tb0 + t) + fr) * 272 + (32 * ks + 8 * fq) * 2); cb[t] = __builtin_amdgcn_mfma_f32_16x16x32_bf16(wf, af, cb[t], 0, 0, 0); } }
    const int irow = 16 * ib + fr;
    const int hp_ = F.tid >> 3, hn0 = (F.tid & 7) * 16;
    float dt_n = lane < nq ? DT[(size_t)(row0 + lane) * NH + 8 * g] : 0.f; unsigned xr_n[8]; f32x4 hv_n[4];
#pragma unroll
    for (int jj = 0; jj < 8; ++jj) { const int j0 = 8 * wave + jj; xr_n[jj] = j0 < nq ? (unsigned)XS[(size_t)(row0 + j0) * 2048 + (8 * g) * 64 + lane] : 0u; }
    { const float* hp = S + ((((size_t)b * NCH + c) * NH + 8 * g) * 64 + hp_) * 128 + hn0;
#pragma unroll
      for (int q = 0; q < 4; ++q) hv_n[q] = *(const f32x4*)(hp + 4 * q); }
#pragma unroll 1
    for (int hh = 0; hh < 8; ++hh) {
        const int head = 8 * g + hh; const float Ah = -expf(F.a_log[head]), Dh = F.d_skip[head];
        const float dtj = dt_n; unsigned xr[8]; f32x4 v[4];
#pragma unroll
        for (int jj = 0; jj < 8; ++jj) xr[jj] = xr_n[jj];
#pragma unroll
        for (int q = 0; q < 4; ++q) v[q] = hv_n[q];
        if (hh < 7) { dt_n = lane < nq ? DT[(size_t)(row0 + lane) * NH + head + 1] : 0.f;
#pragma unroll
            for (int jj = 0; jj < 8; ++jj) { const int j0 = 8 * wave + jj; xr_n[jj] = j0 < nq ? (unsigned)XS[(size_t)(row0 + j0) * 2048 + (head + 1) * 64 + lane] : 0u; }
            const float* hp = S + ((((size_t)b * NCH + c) * NH + head + 1) * 64 + hp_) * 128 + hn0;
#pragma unroll
            for (int q = 0; q < 4; ++q) hv_n[q] = *(const f32x4*)(hp + 4 * q); }
        v2u xw[2] = {{0u, 0u}, {0u, 0u}}, zw[2] = {{0u, 0u}, {0u, 0u}};
        if (irow < nq) {
#pragma unroll
            for (int t = 0; t < 2; ++t) { const size_t o = (size_t)(row0 + irow) * 2048 + head * 64 + 16 * (tb0 + t) + 4 * fq; xw[t] = *(const v2u*)(XS + o); zw[t] = *(const v2u*)(PZ + o); } }
        const float acum = wave_scan_incl(dtj * Ah, lane);
        LAS unsigned char* Ms = HB + (hh & 1) * 35840; LAS unsigned char* XT = Ms + 9216; LAS unsigned char* Hs = Ms + 18432;
        const float mi = __shfl(acum, irow);
#pragma unroll
        for (int t = 0; t < 2; ++t) { float mv[4];
#pragma unroll
            for (int e = 0; e < 4; ++e) { const int j = 16 * (tb0 + t) + 4 * fq + e; const float aj = __shfl(acum, j), dj = __shfl(dtj, j);
                mv[e] = (j <= irow) ? cb[t][e] * __expf(fminf(mi - aj, 0.f)) * dj : 0.f; }
            *(LAS v2u*)(Ms + irow * 144 + (16 * (tb0 + t) + 4 * fq) * 2) = (v2u){pk2(mv[0], mv[1]), pk2(mv[2], mv[3])}; }
        *(LAS v4u*)(XT + lane * 144 + wave * 16) = (v4u){xr[0] | (xr[1] << 16), xr[2] | (xr[3] << 16), xr[4] | (xr[5] << 16), xr[6] | (xr[7] << 16)};
        { LAS unsigned char* d = Hs + hp_ * 272 + hn0 * 2;
          *(LAS v4u*)d = (v4u){pk2(v[0].x, v[0].y), pk2(v[0].z, v[0].w), pk2(v[1].x, v[1].y), pk2(v[1].z, v[1].w)};
          *(LAS v4u*)(d + 16) = (v4u){pk2(v[2].x, v[2].y), pk2(v[2].z, v[2].w), pk2(v[3].x, v[3].y), pk2(v[3].z, v[3].w)}; }
        __syncthreads();
        f32x4 acc[2] = {{0.f, 0.f, 0.f, 0.f}, {0.f, 0.f, 0.f, 0.f}};
#pragma unroll
        for (int ks = 0; ks < 4; ++ks) { const bf16x8 af = *(const LAS bf16x8*)(Cs + irow * 272 + (32 * ks + 8 * fq) * 2);
#pragma unroll
            for (int t = 0; t < 2; ++t) { const bf16x8 wf = *(const LAS bf16x8*)(Hs + (16 * (tb0 + t) + fr) * 272 + (32 * ks + 8 * fq) * 2); acc[t] = __builtin_amdgcn_mfma_f32_16x16x32_bf16(wf, af, acc[t], 0, 0, 0); } }
        const float ei = __expf(mi);
#pragma unroll
        for (int t = 0; t < 2; ++t) acc[t] = acc[t] * ei;
#pragma unroll
        for (int ks = 0; ks < 2; ++ks) { const bf16x8 af = *(const LAS bf16x8*)(Ms + irow * 144 + (32 * ks + 8 * fq) * 2);
#pragma unroll
            for (int t = 0; t < 2; ++t) { const bf16x8 wf = *(const LAS bf16x8*)(XT + (16 * (tb0 + t) + fr) * 144 + (32 * ks + 8 * fq) * 2); acc[t] = __builtin_amdgcn_mfma_f32_16x16x32_bf16(wf, af, acc[t], 0, 0, 0); } }
        if (irow < nq) {
#pragma unroll
            for (int t = 0; t < 2; ++t) {
                const float y0 = (acc[t][0] + Dh * bflo(xw[t].x)) * siluf_(bflo(zw[t].x)), y1 = (acc[t][1] + Dh * bfhi(xw[t].x)) * siluf_(bfhi(zw[t].x));
                const float y2 = (acc[t][2] + Dh * bflo(xw[t].y)) * siluf_(bflo(zw[t].y)), y3 = (acc[t][3] + Dh * bfhi(xw[t].y)) * siluf_(bfhi(zw[t].y));
                *(v2u*)(MIX + (size_t)(row0 + irow) * 4096 + 2048 + head * 64 + 16 * (tb0 + t) + 4 * fq) = (v2u){pk2(y0, y1), pk2(y2, y3)}; }
        }
    }
    __syncthreads();
}
__device__ __forceinline__ void phase_ssdC(const Ctx& F) { for (int u = F.blk; u < NB * NCH * 4; u += F.G) { const int g = u & 3, bc = u >> 2; ssdC_unit(F, bc / NCH, bc % NCH, g); } }


#define SEQ_LOAD(cn) do { const int row0n = b * LP + 64 * (cn), nqn = min(64, LP - 64 * (cn)), lastn = nqn - 1;   \
        { const float d_ = DT[(size_t)(row0n + min(lane, lastn)) * NH + head]; pdt = lane < nqn ? d_ : 0.f; } \
        _Pragma("unroll") for (int jj = 0; jj < 8; ++jj) px[jj] = (unsigned)XS[(size_t)(row0n + min(8 * wave + jj, lastn)) * 2048 + head * 64 + lane]; \
        { const bf16* src = BC + (size_t)(row0n + min(sr, lastn)) * 1024 + g * 128 + sn0; \
          pB[0] = *(const v4u*)src; pB[1] = *(const v4u*)(src + 8); pC[0] = *(const v4u*)(src + 512); pC[1] = *(const v4u*)(src + 520); } \
        _Pragma("unroll") for (int t = 0; t < 2; ++t) { const size_t o = (size_t)(row0n + min(irow, lastn)) * 2048 + head * 64 + 16 * (tb0 + t) + 4 * fq; pxw[t] = *(const v2u*)(XS + o); pzw[t] = *(const v2u*)(PZ + o); } \
    } while (0)
#define SEQ_LOAD_FULL(cn) do { const int row0n = b * LP + 64 * (cn); \
        pdt = DT[(size_t)(row0n + lane) * NH + head]; \
        _Pragma("unroll") for (int jj = 0; jj < 8; ++jj) px[jj] = (unsigned)XS[(size_t)(row0n + 8 * wave + jj) * 2048 + head * 64 + lane]; \
        { const float* src = BC + (size_t)(row0n + sr) * 1024 + g * 128 + sn0; \
          _Pragma("unroll") for (int q = 0; q < 4; ++q) { pB[q] = *(const f32x4*)(src + 4 * q); pC[q] = *(const f32x4*)(src + 512 + 4 * q); } } \
        _Pragma("unroll") for (int t = 0; t < 2; ++t) { const size_t o = (size_t)(row0n + irow) * 2048 + head * 64 + 16 * (tb0 + t) + 4 * fq; pxw[t] = *(const v2u*)(XS + o); pzw[t] = *(const v2u*)(PZ + o); } \
    } while (0)
__device__ __forceinline__ void ssd_seq_unit(const Ctx& F, int b, int head) {
    const float* DT = (const float*)(F.ws + WS_DT); const bf16* XS = (const bf16*)(F.ws + WS_XS); const bf16* BC = (const bf16*)(F.ws + WS_BC); const bf16* PZ = (const bf16*)(F.ws + WS_PZ);
    bf16* MIX = (bf16*)(F.ws + WS_MIX);
    const int g = head >> 3, lane = F.lane, wave = F.wave, fr = lane & 15, fq = lane >> 4, ib = wave >> 1, tb0 = 2 * (wave & 1), irow = 16 * ib + fr;
    const int sr = F.tid >> 3, sn0 = (F.tid & 7) * 16;
    const float Ah = -expf(F.a_log[head]), Dh = F.d_skip[head];
    LAS unsigned char* Hs = F.lds + 106496; LAS unsigned char* Ms = F.lds + 123904;
    LAS float* tabA = (LAS float*)(F.lds + 133120); LAS float* tabD = (LAS float*)(F.lds + 133376);
    f32x4 Hacc[4];
#pragma unroll
    for (int pb = 0; pb < 4; ++pb) Hacc[pb] = (f32x4){0.f, 0.f, 0.f, 0.f};
    v4u pB[2], pC[2]; unsigned px[8]; float pdt; v2u pxw[2], pzw[2];
    SEQ_LOAD(0);
#pragma unroll 1
    for (int c = 0; c < NCH; ++c) {
        const int row0 = b * LP + 64 * c, nq = min(64, LP - 64 * c);
        LAS unsigned char* Cs = F.lds + (c & 1) * 53248; LAS unsigned char* Bs = Cs + 17408; LAS unsigned char* XT1 = Cs + 34816; LAS unsigned char* XT2 = Cs + 44032;
        const float dtj = pdt; const float acum = wave_scan_incl(dtj * Ah, lane), aend = __builtin_bit_cast(float, __builtin_amdgcn_readlane(__builtin_bit_cast(int, acum), 63)), wj = __expf(aend - acum) * dtj;
        if (wave == 0) { tabA[lane] = acum; tabD[lane] = dtj; }
        { LAS unsigned char* d = Bs + sr * 272 + sn0 * 2; *(LAS v4u*)d = pB[0]; *(LAS v4u*)(d + 16) = pB[1];
          d = Cs + sr * 272 + sn0 * 2; *(LAS v4u*)d = pC[0]; *(LAS v4u*)(d + 16) = pC[1]; }
        *(LAS v4u*)(XT1 + lane * 144 + wave * 16) = (v4u){px[0] | (px[1] << 16), px[2] | (px[3] << 16), px[4] | (px[5] << 16), px[6] | (px[7] << 16)};
        { unsigned w[4];
#pragma unroll
          for (int jj = 0; jj < 4; ++jj) { const int j0 = 8 * wave + 2 * jj; w[jj] = pk2(bflo(px[2 * jj]) * __builtin_bit_cast(float, __builtin_amdgcn_readlane(__builtin_bit_cast(int, wj), j0)), bflo(px[2 * jj + 1]) * __builtin_bit_cast(float, __builtin_amdgcn_readlane(__builtin_bit_cast(int, wj), j0 + 1))); }
          *(LAS v4u*)(XT2 + lane * 144 + wave * 16) = (v4u){w[0], w[1], w[2], w[3]}; }
        v2u xw[2], zw[2];
#pragma unroll
        for (int t = 0; t < 2; ++t) { xw[t] = pxw[t]; zw[t] = pzw[t]; }
        SEQ_LOAD(min(c + 1, NCH - 1));
        asm volatile("s_waitcnt lgkmcnt(0)" ::: "memory"); __builtin_amdgcn_s_barrier(); asm volatile("" ::: "memory");
        f32x4 cb[2] = {{0.f, 0.f, 0.f, 0.f}, {0.f, 0.f, 0.f, 0.f}}; bf16x8 afr[4];
#pragma unroll
        for (int ks = 0; ks < 4; ++ks) { afr[ks] = *(const LAS bf16x8*)(Cs + irow * 272 + (32 * ks + 8 * fq) * 2);
#pragma unroll
            for (int t = 0; t < 2; ++t) { const bf16x8 wf = *(const LAS bf16x8*)(Bs + (16 * (tb0 + t) + fr) * 272 + (32 * ks + 8 * fq) * 2); cb[t] = __builtin_amdgcn_mfma_f32_16x16x32_bf16(wf, afr[ks], cb[t], 0, 0, 0); } }
        const float mi = tabA[irow];
#pragma unroll
        for (int t = 0; t < 2; ++t) { float mv[4];
            const f32x4 aj4 = *(const LAS f32x4*)(tabA + 16 * (tb0 + t) + 4 * fq), dj4 = *(const LAS f32x4*)(tabD + 16 * (tb0 + t) + 4 * fq);
#pragma unroll
            for (int e = 0; e < 4; ++e) { const int j = 16 * (tb0 + t) + 4 * fq + e;
                mv[e] = (j <= irow) ? cb[t][e] * __expf(fminf(mi - aj4[e], 0.f)) * dj4[e] : 0.f; }
            *(LAS v2u*)(Ms + irow * 144 + (16 * (tb0 + t) + 4 * fq) * 2) = (v2u){pk2(mv[0], mv[1]), pk2(mv[2], mv[3])}; }
#pragma unroll
        for (int pb = 0; pb < 4; ++pb) *(LAS v2u*)(Hs + (16 * pb + fr) * 272 + (16 * wave + 4 * fq) * 2) = (v2u){pk2(Hacc[pb][0], Hacc[pb][1]), pk2(Hacc[pb][2], Hacc[pb][3])};
        asm volatile("s_waitcnt lgkmcnt(0)" ::: "memory"); __builtin_amdgcn_s_barrier(); asm volatile("" ::: "memory");
        f32x4 acc[2] = {{0.f, 0.f, 0.f, 0.f}, {0.f, 0.f, 0.f, 0.f}};
#pragma unroll
        for (int ks = 0; ks < 4; ++ks) {
#pragma unroll
            for (int t = 0; t < 2; ++t) { const bf16x8 wf = *(const LAS bf16x8*)(Hs + (16 * (tb0 + t) + fr) * 272 + (32 * ks + 8 * fq) * 2); acc[t] = __builtin_amdgcn_mfma_f32_16x16x32_bf16(wf, afr[ks], acc[t], 0, 0, 0); } }
        const float ei = __expf(mi);
#pragma unroll
        for (int t = 0; t < 2; ++t) acc[t] = acc[t] * ei;
#pragma unroll
        for (int ks = 0; ks < 2; ++ks) { const bf16x8 af = *(const LAS bf16x8*)(Ms + irow * 144 + (32 * ks + 8 * fq) * 2);
#pragma unroll
            for (int t = 0; t < 2; ++t) { const bf16x8 wf = *(const LAS bf16x8*)(XT1 + (16 * (tb0 + t) + fr) * 144 + (32 * ks + 8 * fq) * 2); acc[t] = __builtin_amdgcn_mfma_f32_16x16x32_bf16(wf, af, acc[t], 0, 0, 0); } }
        if (irow < nq) {
#pragma unroll
            for (int t = 0; t < 2; ++t) {
                const float y0 = (acc[t][0] + Dh * bflo(xw[t].x)) * siluf_(bflo(zw[t].x)), y1 = (acc[t][1] + Dh * bfhi(xw[t].x)) * siluf_(bfhi(zw[t].x));
                const float y2 = (acc[t][2] + Dh * bflo(xw[t].y)) * siluf_(bflo(zw[t].y)), y3 = (acc[t][3] + Dh * bfhi(xw[t].y)) * siluf_(bfhi(zw[t].y));
                *(v2u*)(MIX + (size_t)(row0 + irow) * 4096 + 2048 + head * 64 + 16 * (tb0 + t) + 4 * fq) = (v2u){pk2(y0, y1), pk2(y2, y3)}; }
        }
        const float dec = __expf(aend);
#pragma unroll
        for (int pb = 0; pb < 4; ++pb) Hacc[pb] = Hacc[pb] * dec;
#pragma unroll
        for (int ks = 0; ks < 2; ++ks) {
            unsigned wv[4];
#pragma unroll
            for (int jj = 0; jj < 4; ++jj) { const LAS unsigned char* q = Bs + (32 * ks + 8 * fq + 2 * jj) * 272 + (16 * wave + fr) * 2;
                wv[jj] = (unsigned)*(const LAS unsigned short*)q | ((unsigned)*(const LAS unsigned short*)(q + 272) << 16); }
            const bf16x8 wf = __builtin_bit_cast(bf16x8, (v4u){wv[0], wv[1], wv[2], wv[3]});
#pragma unroll
            for (int pb = 0; pb < 4; ++pb) { const bf16x8 af = *(const LAS bf16x8*)(XT2 + (16 * pb + fr) * 144 + (32 * ks + 8 * fq) * 2); Hacc[pb] = __builtin_amdgcn_mfma_f32_16x16x32_bf16(wf, af, Hacc[pb], 0, 0, 0); }
        }
    }
    float* op = F.out + O_PSSD + ((size_t)b * NH + head) * 8192;
#pragma unroll
    for (int pb = 0; pb < 4; ++pb) *(f32x4*)(op + (size_t)(16 * pb + fr) * 128 + 16 * wave + 4 * fq) = Hacc[pb];
    __syncthreads();
}

__device__ __forceinline__ void phase_scan1(const Ctx& F) {
    constexpr int NPU = NB * NH;
    if (F.G >= 2 * NPU) {
        if (F.blk < NPU) { const int v_ = (F.blk & 7) * (NPU / 8) + (F.blk >> 3);
            ssd_seq_unit(F, v_ >> 5, v_ & 31);
        } else { ssd_sample_blk(F, F.blk - NPU, F.G - NPU);
#ifdef PROBE_S2
            ssd_sample_blk(F, F.blk - NPU, F.G - NPU);
#endif
            lru_aggregate(F, F.blk - NPU, F.G - NPU); }
    } else {
        for (int u = F.blk; u < NPU; u += F.G) ssd_seq_unit(F, u >> 5, u & 31);
        ssd_sample_blk(F, F.blk, F.G); lru_aggregate(F, F.blk, F.G);
    }
}

__device__ __forceinline__ void phase_scan2(const Ctx& F) {
    const float* Ai = (const float*)(F.ws + WS_A); const float* Bi = (const float*)(F.ws + WS_BT); const float* GA = (const float*)(F.ws + WS_AGGA); const float* GH = (const float*)(F.ws + WS_AGGH);
    const bf16* PG = (const bf16*)(F.ws + WS_PG); bf16* MIX = (bf16*)(F.ws + WS_MIX);
    constexpr int NPI = NB * NSEG * 2048, NSI = DB * 2048;
    for (int idx = F.blk * NTHR + F.tid; idx < NPI + NSI; idx += F.G * NTHR) {
        if (idx < NPI) {
            const int ch = idx & 2047, sg = (idx >> 11) % NSEG, b = idx / (2048 * NSEG);
            float hh = 0.f;
            for (int s2 = 0; s2 < sg; s2 += 8) { float ga[8], gh[8];
#pragma unroll
                for (int k = 0; k < 8; ++k) { const int sk = (s2 + k < sg) ? s2 + k : 0; const int o = (b * NSEG + sk) * 2048 + ch; ga[k] = GA[o]; gh[k] = GH[o]; }
#pragma unroll
                for (int k = 0; k < 8; ++k) if (s2 + k < sg) hh = ga[k] * hh + gh[k]; }
            const int t0 = sg * 64, t1 = min(t0 + 64, LP);
            if (t1 - t0 == 64) {
                for (int t = t0; t < t1; t += 32) { float av[32], bv[32]; bf16 gv[32];
#pragma unroll
                    for (int k = 0; k < 32; ++k) { const size_t o = (size_t)(b * LP + t + k) * 2048 + ch; av[k] = Ai[o]; bv[k] = Bi[o]; gv[k] = PG[o]; }
#pragma unroll
                    for (int k = 0; k < 32; ++k) { hh = av[k] * hh + bv[k]; MIX[(size_t)(b * LP + t + k) * 4096 + ch] = (bf16)f2bf(hh * gelu_tanh(bf1(gv[k]))); } }
            } else {
                for (int t = t0; t < t1; t += 16) { float av[16], bv[16]; bf16 gv[16];
#pragma unroll
                    for (int k = 0; k < 16; ++k) { const size_t o = (size_t)(b * LP + t + k) * 2048 + ch; av[k] = Ai[o]; bv[k] = Bi[o]; gv[k] = PG[o]; }
#pragma unroll
                    for (int k = 0; k < 16; ++k) { hh = av[k] * hh + bv[k]; MIX[(size_t)(b * LP + t + k) * 4096 + ch] = (bf16)f2bf(hh * gelu_tanh(bf1(gv[k]))); } }
            }
            if (sg == NSEG - 1) F.out[O_PLH + (size_t)b * 2048 + ch] = hh;
        } else {
            const int i2 = idx - NPI, ch = i2 & 2047, s = i2 >> 11; float hh = 0.f;
#pragma unroll
            for (int j = 0; j < 4; ++j) { const size_t r = (size_t)(MP + 4 * s + j); const size_t o = r * 2048 + ch; hh = Ai[o] * hh + Bi[o];
                MIX[r * 4096 + ch] = (bf16)f2bf(hh * gelu_tanh(bf1(PG[o]))); }
            F.out[O_SLH + (size_t)s * 2048 + ch] = hh;
        }
    }
}

__device__ __forceinline__ void phase_mixnorm(const Ctx& F, bool dry = false) {
    const int gw = F.blk * NWAVES + F.wave, NGW = F.G * NWAVES; bf16* MIX = (bf16*)(F.ws + WS_MIX); bf16* DST = dry ? (bf16*)(F.ws + WS_PART) : MIX;
    for (int m = gw; m < MR; m += NGW) {
        bf16* rowp = MIX + (size_t)m * 4096 + 8 * F.lane; bf16* dstp = DST + (size_t)m * 4096 + 8 * F.lane; v4u w[8]; float ss[8];
#pragma unroll
        for (int j = 0; j < 8; ++j) { w[j] = *(const v4u*)(rowp + 512 * j);
            const float a0 = bflo(w[j].x), a1 = bfhi(w[j].x), a2 = bflo(w[j].y), a3 = bfhi(w[j].y), a4 = bflo(w[j].z), a5 = bfhi(w[j].z), a6 = bflo(w[j].w), a7 = bfhi(w[j].w);
            ss[j] = (a0 * a0 + a1 * a1) + (a2 * a2 + a3 * a3) + (a4 * a4 + a5 * a5) + (a6 * a6 + a7 * a7); }
        const float sl = wave_sum((ss[0] + ss[1]) + (ss[2] + ss[3])); const float rl = rsqrtf(sl * (1.f / 2048) + EPS);
#pragma unroll
        for (int j = 0; j < 8; ++j) {
            float rs = rl; if (j >= 4) rs = rsqrtf(wave_sum(ss[j]) * (1.f / 512) + EPS);
            const float* gp = (j < 4 ? F.g_lru_out + 512 * j : F.g_ssd_out + 512 * (j - 4)) + 8 * F.lane; const f32x4 g0 = *(const f32x4*)gp, g1 = *(const f32x4*)(gp + 4);
            v4u o; o.x = pk2(bflo(w[j].x) * rs * g0.x, bfhi(w[j].x) * rs * g0.y); o.y = pk2(bflo(w[j].y) * rs * g0.z, bfhi(w[j].y) * rs * g0.w);
            o.z = pk2(bflo(w[j].z) * rs * g1.x, bfhi(w[j].z) * rs * g1.y); o.w = pk2(bflo(w[j].w) * rs * g1.z, bfhi(w[j].w) * rs * g1.w);
            *(v4u*)(dstp + 512 * j) = o; }
    }
}


__device__ __forceinline__ f32x4 gemm_out4(const Ctx& F, int m, int j, int nfull, int P, bool& has_res) {
    const int T = (m >> 8) * 8 + j;
    if (T < nfull || P == 1) { has_res = true; return *(const f32x4*)((const float*)(F.ws + WS_PART) + (size_t)m * DM + 4 * F.lane + 256 * j); }
    has_res = false;
    const float* r = (const float*)(F.ws + WS_R2) + (size_t)(T - nfull) * P * 65536 + (size_t)(m & 255) * 256 + 4 * F.lane;
    f32x4 v = *(const f32x4*)r;
    for (int k = 1; k < P; ++k) v += *(const f32x4*)(r + (size_t)k * 65536);
    return v;
}
__device__ __forceinline__ void phase_resid1(const Ctx& F) {
    const int gw = F.blk * NWAVES + F.wave, NGW = F.G * NWAVES; float* X1 = (float*)(F.ws + WS_PART); bf16* HP = (bf16*)(F.ws + WS_HP);
    int nfull, P; pg8::split_params(35 * 8, F.G, 4096 / 64, nfull, P);
    for (int m = gw; m < MR; m += NGW) {
        const float* xr = xrow_ptr(F, m); f32x4 v[8];
#pragma unroll
        for (int j = 0; j < 8; ++j) { bool hr; v[j] = gemm_out4(F, m, j, nfull, P, hr); if (!hr) { v[j] += *(const f32x4*)(xr + 4 * F.lane + 256 * j); *(f32x4*)(X1 + (size_t)m * DM + 4 * F.lane + 256 * j) = v[j]; } }
        rms_row_store(v, F.g_mlp, HP + (size_t)m * DM, F.lane);
    }
}
__device__ __forceinline__ void phase_final(const Ctx& F) {
    const int gw = F.blk * NWAVES + F.wave, NGW = F.G * NWAVES; const float* X1 = (const float*)(F.ws + WS_PART);
    int nfull, P; pg8::split_params(35 * 8, F.G, DFF / 64, nfull, P);
    for (int m = gw; m < MR; m += NGW) {
        float* orow;
        if (m < MP) { const int b = m / LP, t = m - b * LP; if (t < NMETA) continue; orow = F.out + O_YP + ((size_t)b * SEQ + (t - NMETA)) * DM; } else orow = F.out + O_YS + (size_t)(m - MP) * DM;
        f32x4 v[8]; float ss = 0.f;
#pragma unroll
        for (int j = 0; j < 8; ++j) { bool hr; v[j] = gemm_out4(F, m, j, nfull, P, hr); if (!hr) v[j] += *(const f32x4*)(X1 + (size_t)m * DM + 4 * F.lane + 256 * j); ss += (v[j].x * v[j].x + v[j].y * v[j].y) + (v[j].z * v[j].z + v[j].w * v[j].w); }
        const float rs = rsqrtf(wave_sum(ss) * (1.f / DM) + EPS);
#pragma unroll
        for (int j = 0; j < 8; ++j) { const f32x4 gg = *(const f32x4*)(F.g_final + 4 * F.lane + 256 * j); *(f32x4*)(orow + 4 * F.lane + 256 * j) = v[j] * rs * gg; }
    }
}

#define RLX_AGENT __ATOMIC_RELAXED, __HIP_MEMORY_SCOPE_AGENT
constexpr size_t WS_BAR = 4096 * 4;
#define XB_TMO      128
#define XB_XCNT(j)  (256  + 64 * (j))
#define XB_XSUB(j)  (1280 + 64 * (j))
#define XB_XGEN(j)  (2304 + 64 * (j))
#define XB_TOP      3328
#define XB_TOPGEN   3392
#define XCD_BAR_WORDS 3456
#define XB_SPIN_CAP (1u << 18)

__device__ __forceinline__ unsigned xb_ld(unsigned* p)              { return __hip_atomic_load(p, __ATOMIC_RELAXED, __HIP_MEMORY_SCOPE_AGENT); }
__device__ __forceinline__ unsigned xb_add(unsigned* p, unsigned v) { return __hip_atomic_fetch_add(p, v, __ATOMIC_RELAXED, __HIP_MEMORY_SCOPE_AGENT); }
__device__ __forceinline__ unsigned xb_xcc_id() { return (unsigned)__builtin_amdgcn_s_getreg((3 << 11) | 20) & 0xFu; }
#define XB_SPIN(cond, bar) do { unsigned _sp = 0; while (cond) { __builtin_amdgcn_s_sleep(1); \
    if ((++_sp & 255u) == 0u) { if (xb_ld(&(bar)[XB_TMO])) break; if (_sp > XB_SPIN_CAP) { atomicAdd(&(bar)[XB_TMO], 1u); break; } } } } while (0)

struct XcdBarrier {
    unsigned* bar; unsigned x;
    volatile LAS unsigned* st;
};

__device__ __forceinline__ XcdBarrier xcd_barrier_post(unsigned* bar, volatile LAS unsigned* st) {
    XcdBarrier b; b.bar = bar; b.x = xb_xcc_id(); b.st = st;
    if (threadIdx.x == 0) (void)xb_add(&bar[XB_XCNT(b.x)], 1u);
    return b;
}
__device__ __forceinline__ void xcd_barrier_complete(unsigned* bar, unsigned x, unsigned& nloc, unsigned& nx) {
    const unsigned G = gridDim.x * gridDim.y * gridDim.z;
    unsigned sum, cnt, mine, sp = 0u;
    for (;;) {
        sum = 0u; cnt = 0u; mine = 0u;
#pragma unroll
        for (unsigned j = 0; j < 16; ++j) { const unsigned c = xb_ld(&bar[XB_XCNT(j)]); sum += c; cnt += (c > 0u) ? 1u : 0u; mine = (j == x) ? c : mine; }
        if (sum == G) break;
        __builtin_amdgcn_s_sleep(1);
        if ((++sp & 255u) == 0u) { if (xb_ld(&bar[XB_TMO])) break; if (sp > XB_SPIN_CAP) { atomicAdd(&bar[XB_TMO], 1u); break; } }
    }
    nloc = mine > 0u ? mine : 1u; nx = cnt > 0u ? cnt : 1u;
}

__device__ __forceinline__ void xcd_barrier(const XcdBarrier& b) {
    asm volatile("s_waitcnt vmcnt(0)" ::: "memory");
    __syncthreads();
    if (threadIdx.x == 0) {
        unsigned* bar = b.bar;
        __builtin_amdgcn_s_waitcnt(0);
        unsigned nloc = b.st[0], nx = b.st[1];
        if (nloc == 0u) { xcd_barrier_complete(bar, b.x, nloc, nx); b.st[0] = nloc; b.st[1] = nx; }
        const unsigned old = xb_add(&bar[XB_XSUB(b.x)], 1u);
        const unsigned gen = old / nloc;
        if (old + 1u == (gen + 1u) * nloc) {
            __builtin_amdgcn_fence(__ATOMIC_RELEASE, "agent");
            asm volatile("s_waitcnt vmcnt(0)" ::: "memory");
            const unsigned og = xb_add(&bar[XB_TOP], 1u);
            const unsigned tg = og / nx;
            if (og + 1u == (tg + 1u) * nx) xb_add(&bar[XB_TOPGEN], 1u);
            else XB_SPIN(xb_ld(&bar[XB_TOPGEN]) == tg, bar);
            __builtin_amdgcn_fence(__ATOMIC_ACQUIRE, "agent");
            xb_add(&bar[XB_XGEN(b.x)], 1u);
            asm volatile("s_waitcnt vmcnt(0)" ::: "memory");
        } else {
            XB_SPIN(xb_ld(&bar[XB_XGEN(b.x)]) == gen, bar);
            __builtin_amdgcn_fence(__ATOMIC_ACQUIRE, "agent");
            asm volatile("s_waitcnt vmcnt(0)" ::: "memory");
        }
    }
    __syncthreads();
}

__global__ void __launch_bounds__(NTHR, 2) hymba_fwd(Args args) {
    extern __shared__ __attribute__((aligned(16))) unsigned char lds_raw[];
    cg::grid_group grid = cg::this_grid();
    Ctx F;
    F.xp = args.in[0]; F.xs = args.in[1]; F.st_lru_h = args.in[2]; F.st_lru_conv = args.in[3]; F.st_ssd = args.in[4]; F.st_ssd_conv = args.in[5]; F.meta = args.in[6]; F.g_mix = args.in[7];
    F.w_in = args.in[8]; F.conv_lru_w = args.in[9]; F.conv_lru_b = args.in[10]; F.lru_wa = args.in[11]; F.lru_ba = args.in[12]; F.lru_wx = args.in[13]; F.lru_bx = args.in[14]; F.lru_lam = args.in[15];
    F.g_lru_out = args.in[16]; F.conv_ssd_w = args.in[17]; F.conv_ssd_b = args.in[18]; F.dt_bias = args.in[19]; F.a_log = args.in[20]; F.d_skip = args.in[21]; F.g_ssd_out = args.in[22];
    F.w_out = args.in[23]; F.g_mlp = args.in[24]; F.w_up = args.in[25]; F.w_down = args.in[26]; F.g_final = args.in[27];
    F.out = args.out; F.ws = args.ws; F.lds = (LAS unsigned char*)lds_raw;
    F.tid = threadIdx.x; F.lane = F.tid & 63; F.wave = __builtin_amdgcn_readfirstlane(F.tid >> 6); F.blk = blockIdx.x; F.G = gridDim.x;
    const int lo = args.ph_lo, hi = args.ph_hi;
    volatile LAS unsigned* bst = (volatile LAS unsigned*)(F.lds + LDS_BYTES - 64);
    if (F.tid < 16) bst[F.tid] = 0u;
    __syncthreads();
    XcdBarrier xbar; xbar.bar = (unsigned*)(F.ws + WS_BAR); xbar.x = 0; xbar.st = bst;
    if (hi - lo > 1) xbar = xcd_barrier_post((unsigned*)(F.ws + WS_BAR), bst);
    if (hi - lo > 1) grid.sync();
#define IN(k) (lo <= (k) && (k) < hi)
#ifndef PROBE_PH
#define PROBE_PH -1
#endif
#define REPS(k) for (int rep_ = 0; rep_ < (PROBE_PH == (k) ? 2 : 1); ++rep_)
#ifndef PROBE_SYNC
#define PROBE_SYNC 1
#endif
#define SEAM(k) do { if (IN(k) && IN((k) + 1)) { for (int s_ = 0; s_ < PROBE_SYNC; ++s_) { xcd_barrier(xbar); } } } while (0)
    if (IN(0)) REPS(0) phase_prologue(F);
    SEAM(0);
    if (IN(1)) {
        {
        pg8::Gemm g{(const pg8::bf16_t*)(F.ws + WS_XN), (const pg8::bf16_t*)(F.ws + WS_WIN), MPAD, NMAIN, 2048}; pg8::StaticOrder S; S.init(MPAD, NMAIN, F.G, F.blk, 2048);
        pg8::EpiProj E{(bf16*)(F.ws + WS_PG), (bf16*)(F.ws + WS_PXL), (bf16*)(F.ws + WS_PZ), (bf16*)(F.ws + WS_PXBC)};
        pg8::gemm_phase<pg8::EpiProj, pg8::StaticOrder, PG8_ALIGN, PG8_SP2>(F.lds, g, S, E);
        phase_dt(F);
            }
        if (PROBE_PH == 1) {
        pg8::Gemm g{(const pg8::bf16_t*)(F.ws + WS_XN), (const pg8::bf16_t*)(F.ws + WS_WIN), MPAD, NMAIN, 2048}; pg8::StaticOrder S; S.init(MPAD, NMAIN, F.G, F.blk, 2048);
        pg8::EpiProj E{(bf16*)(F.ws + WS_PG), (bf16*)(F.ws + WS_PXL), (bf16*)(F.ws + WS_PZ), (bf16*)(F.ws + WS_PXBC)};
        pg8::gemm_phase<pg8::EpiProj, pg8::StaticOrder, PG8_ALIGN, PG8_SP2>(F.lds, g, S, E);
        phase_dt(F);
            }
    }
    SEAM(1);
    if (IN(2)) REPS(2) phase_conv(F);
    SEAM(2);
    if (IN(3)) REPS(3) { phase_gates(F); __syncthreads(); }
    SEAM(3);
    if (IN(4)) REPS(4) phase_scan1(F);
    SEAM(4);
    if (IN(5)) REPS(5) phase_scan2(F);
    SEAM(5);
    if (IN(6)) { if (PROBE_PH == 6) phase_mixnorm(F, true); phase_mixnorm(F); }
    SEAM(6);
    if (IN(7)) {
        {
        pg8::Gemm g{(const pg8::bf16_t*)(F.ws + WS_MIX), (const pg8::bf16_t*)(F.ws + WS_WOUT), MPAD, 2048, 4096}; pg8::SplitOrder S; S.init(MPAD, 2048, F.G, F.blk, 4096);
        pg8::EpiF32S E{(float*)(F.ws + WS_PART), 2048, (float*)(F.ws + WS_R2), S.nN, S.nfull, S.P, 2, nullptr, F.xp, F.xs, F.meta};
        pg8::gemm_phase<pg8::EpiF32S, pg8::SplitOrder, PG8_ALIGN, PG8_SP2>(F.lds, g, S, E);
            }
        if (PROBE_PH == 7) {
        pg8::Gemm g{(const pg8::bf16_t*)(F.ws + WS_MIX), (const pg8::bf16_t*)(F.ws + WS_WOUT), MPAD, 2048, 4096}; pg8::SplitOrder S; S.init(MPAD, 2048, F.G, F.blk, 4096);
        pg8::EpiF32S E{(float*)(F.ws + WS_PART), 2048, (float*)(F.ws + WS_R2), S.nN, S.nfull, S.P, 2, nullptr, F.xp, F.xs, F.meta};
        pg8::gemm_phase<pg8::EpiF32S, pg8::SplitOrder, PG8_ALIGN, PG8_SP2>(F.lds, g, S, E);
            }
    }
    SEAM(7);
    if (IN(8)) REPS(8) phase_resid1(F);
    SEAM(8);
    if (IN(9)) {
        {
        pg8::Gemm g{(const pg8::bf16_t*)(F.ws + WS_HP), (const pg8::bf16_t*)(F.ws + WS_WUP), MPAD, DFF, 2048}; pg8::StaticOrder S; S.init(MPAD, DFF, F.G, F.blk, 2048);
        pg8::EpiRelu2 E{(bf16*)(F.ws + WS_H), DFF};
        pg8::gemm_phase<pg8::EpiRelu2, pg8::StaticOrder, PG8_ALIGN, PG8_SP2>(F.lds, g, S, E);
        { int part, nparts; slack_parts(35 * 32, F.G, F.blk, part, nparts); if (part >= 0) convert_range(F, I_IN + I_OUT + I_UP, I_IN + I_OUT + I_UP + I_DN, part, nparts); }
            }
        if (PROBE_PH == 9) { __syncthreads();
        pg8::Gemm g{(const pg8::bf16_t*)(F.ws + WS_HP), (const pg8::bf16_t*)(F.ws + WS_WUP), MPAD, DFF, 2048}; pg8::StaticOrder S; S.init(MPAD, DFF, F.G, F.blk, 2048);
        pg8::EpiRelu2 E{(bf16*)(F.ws + WS_H), DFF};
        pg8::gemm_phase<pg8::EpiRelu2, pg8::StaticOrder, PG8_ALIGN, PG8_SP2>(F.lds, g, S, E);
        { int part, nparts; slack_parts(35 * 32, F.G, F.blk, part, nparts); if (part >= 0) convert_range(F, I_IN + I_OUT + I_UP, I_IN + I_OUT + I_UP + I_DN, part, nparts); }
            }
    }
    SEAM(9);
    if (IN(10)) {
        {
        pg8::Gemm g{(const pg8::bf16_t*)(F.ws + WS_H), (const pg8::bf16_t*)(F.ws + WS_WDN), MPAD, 2048, DFF}; pg8::SplitOrder S; S.init(MPAD, 2048, F.G, F.blk, DFF);
        pg8::EpiF32S E{(float*)(F.ws + WS_PART), 2048, (float*)(F.ws + WS_R2), S.nN, S.nfull, S.P, 1, (const float*)(F.ws + WS_PART), nullptr, nullptr, nullptr};
        pg8::gemm_phase<pg8::EpiF32S, pg8::SplitOrder, PG8_ALIGN, PG8_SP2>(F.lds, g, S, E);
            }
        if (PROBE_PH == 10) {
        pg8::Gemm g{(const pg8::bf16_t*)(F.ws + WS_H), (const pg8::bf16_t*)(F.ws + WS_WDN), MPAD, 2048, DFF}; pg8::SplitOrder S; S.init(MPAD, 2048, F.G, F.blk, DFF);
        pg8::EpiF32S E{(float*)(F.ws + WS_PART), 2048, (float*)(F.ws + WS_R2), S.nN, S.nfull, S.P, 1, (const float*)(F.ws + WS_PART), nullptr, nullptr, nullptr};
        pg8::gemm_phase<pg8::EpiF32S, pg8::SplitOrder, PG8_ALIGN, PG8_SP2>(F.lds, g, S, E);
            }
    }
    SEAM(10);
    if (IN(11)) REPS(11) phase_final(F);
#undef IN
#undef SEAM
}

#ifndef N_LAUNCH_MODE
#define N_LAUNCH_MODE 1
#endif
extern "C" void kernel_launch(void* const* d_in, const int* in_sizes, int n_in, void* d_out, int out_size, void* d_ws, size_t ws_size, hipStream_t stream) {
    static int grid = 0;
    if (grid == 0) {
        if (n_in != 28 || (size_t)out_size != O_END || ws_size < WS_END) { fprintf(stderr, "kernel_launch: unexpected shapes: n_in %d out %d ws %zu\n", n_in, out_size, ws_size); grid = -1; return; }
        int dev = 0, cus = 0, per_cu = 0;
        (void)hipGetDevice(&dev); (void)hipDeviceGetAttribute(&cus, hipDeviceAttributeMultiprocessorCount, dev);
        if (hipFuncSetAttribute((const void*)hymba_fwd, hipFuncAttributeMaxDynamicSharedMemorySize, LDS_BYTES) != hipSuccess) { fprintf(stderr, "kernel_launch: hipFuncSetAttribute failed\n"); grid = -1; return; }
        if (hipOccupancyMaxActiveBlocksPerMultiprocessor(&per_cu, (const void*)hymba_fwd, NTHR, LDS_BYTES) != hipSuccess || per_cu < 1) { fprintf(stderr, "kernel_launch: occupancy query says %d\n", per_cu); per_cu = 1; }
        (void)hipGetLastError();
        grid = cus * 1;
        if (grid <= 0) grid = 256;
    }
    if (grid < 0) return;
    Args a{};
    for (int i = 0; i < 28; ++i) a.in[i] = (const float*)d_in[i];
    a.out = (float*)d_out; a.ws = (unsigned char*)d_ws;
#if N_LAUNCH_MODE == 1
    (void)hipMemsetAsync((char*)d_ws + WS_BAR, 0, XCD_BAR_WORDS * 4, stream);
    a.ph_lo = 0; a.ph_hi = NPHASE;
    void* kargs[] = {&a};
    hipError_t e = hipLaunchCooperativeKernel((const void*)hymba_fwd, dim3(grid), dim3(NTHR), kargs, LDS_BYTES, stream);
    if (e != hipSuccess) fprintf(stderr, "cooperative launch failed: %s (grid %d)\n", hipGetErrorString(e), grid);
#else
    for (int p = 0; p < NPHASE; ++p) { a.ph_lo = p; a.ph_hi = p + 1; hipLaunchKernelGGL(hymba_fwd, dim3(grid), dim3(NTHR), LDS_BYTES, stream, a); }
#endif
}
```

```cpp
#include <hip/hip_runtime.h>
#include <hip/hip_cooperative_groups.h>
#include <cstdio>
#include <cstdint>
namespace cg = cooperative_groups;
namespace pg8 {
#define PG8_LAS __attribute__((address_space(3)))
typedef unsigned short bf16_t;
typedef short bf16x8 __attribute__((ext_vector_type(8)));
typedef float f32x4 __attribute__((ext_vector_type(4)));
typedef unsigned u32x4 __attribute__((ext_vector_type(4)));
constexpr int BM = 256, BK = 64, HALF = 128, HTB = HALF * BK * 2  , STAGE_BYTES = 8 * HTB, NXCD = 8, WGM = 8;

__host__ __device__ __forceinline__ int lds_byte(int r, int c) { const int st = (r >> 4) * 2 + (c >> 5), rr = r & 15, cc = c & 31, ob = rr * 64 + cc * 2; return st * 1024 + (ob ^ (((ob >> 9) & 1) << 5)); }
__host__ __device__ __forceinline__ void stage_rc(int b, int& R, int& C) { const int st = b / 1024, sb = b % 1024, swz = sb ^ (((sb >> 9) & 1) << 5); R = (st >> 1) * 16 + swz / 64; C = (st & 1) * 32 + (swz % 64) / 2; }
__host__ __device__ __forceinline__ int perm32(int rho) { const int n = rho >> 4, i = rho & 15; return 8 * (i >> 2) + 4 * n + (i & 3); }

struct Unit { int pm, pn, kt0, nt, slot; };
struct Gemm { const bf16_t* A; const bf16_t* Bt; int M, N, K; };

struct StaticOrder {
    int nM, nN, nwg, G, c, ntk;
    __host__ __device__ __forceinline__ void init(int M, int N, int G_, int c_, int K_) { nM = M / BM; nN = N / BM; nwg = nM * nN; G = G_; c = c_; ntk = K_ / BK; }
    __host__ __device__ __forceinline__ bool next(int i, Unit& u) const {
        const long L = (long)i * G + c; if (L >= nwg) return false;
        int wgid = (int)L; { const int q = nwg / NXCD, r = nwg % NXCD, xcd = wgid % NXCD, off = wgid / NXCD; wgid = (xcd < r ? xcd * (q + 1) : r * (q + 1) + (xcd - r) * q) + off; }
        const int nig = WGM * nN, gid = wgid / nig, fm = gid * WGM, gsz = (nM - fm) < WGM ? (nM - fm) : WGM;
        u.pm = fm + ((wgid % nig) % gsz); u.pn = (wgid % nig) / gsz; u.kt0 = 0; u.nt = ntk; u.slot = -1; return true;
    }
    __device__ __forceinline__ void a_ready(const Unit&) const {}
    __device__ __forceinline__ void done(const Unit&) const {}
};


__host__ __device__ __forceinline__ void split_params(int nwg, int G, int ntk, int& nfull, int& P) {
    nfull = (nwg / G) * G; const int rem = nwg - nfull; P = 1;
    if (rem > 0) { int p = G / rem; p = p >= 8 ? 8 : (p >= 4 ? 4 : (p >= 2 ? 2 : 1)); while (p > 1 && ((ntk / p) < 4 || (ntk % (2 * p)) != 0)) p >>= 1; P = p; }
}
struct SplitOrder {
    int nN, nwg, G, c, ntk, nfull, P, perm;
    __host__ __device__ __forceinline__ void init(int M, int N, int G_, int c_, int K_) { nN = N / BM; nwg = (M / BM) * nN; G = G_; c = c_; ntk = K_ / BK; split_params(nwg, G, ntk, nfull, P);
        perm = (G % NXCD == 0) ? (c % NXCD) * (G / NXCD) + c / NXCD : c; }
    __host__ __device__ __forceinline__ bool next(int i, Unit& u) const {
        const int rounds = nfull / G;
        if (i < rounds) { const int T = i * G + perm; u.pm = T / nN; u.pn = T % nN; u.kt0 = 0; u.nt = ntk; u.slot = -1; return true; }
        int j = (i - rounds) * G + c; const int rem = nwg - nfull;
        if (j >= rem * P) return false;
        const int T = nfull + j / P, pc = j % P; u.pm = T / nN; u.pn = T % nN; u.nt = ntk / P; u.kt0 = pc * u.nt; u.slot = (P > 1) ? pc : -1; return true;
    }
    __device__ __forceinline__ void a_ready(const Unit&) const {}
    __device__ __forceinline__ void done(const Unit&) const {}
};
__device__ __forceinline__ unsigned cvt_pk_bf16(float lo, float hi) { unsigned r; asm volatile("v_cvt_pk_bf16_f32 %0, %1, %2" : "=v"(r) : "v"(lo), "v"(hi)); return r; }
struct EpiF32 {
    static constexpr bool PERM = false, AFTER_DRAIN = false;
    float* C; int ldc;
    __device__ __forceinline__ void operator()(const f32x4 (&acc)[2][2][4][2], const Unit& u, int wr, int wc, int fr, int fq) const {
        const int row0 = u.pm * BM + wr * 64 + fr, col0 = u.pn * BM + wc * 32 + 4 * fq;
#pragma unroll
        for (int ai = 0; ai < 2; ++ai)
#pragma unroll
            for (int m = 0; m < 4; ++m) { float* rowp = C + (size_t)(row0 + ai * HALF + m * 16) * ldc + col0;
#pragma unroll
                for (int bj = 0; bj < 2; ++bj)
#pragma unroll
                    for (int n = 0; n < 2; ++n) *(f32x4*)(rowp + bj * HALF + n * 16) = acc[ai][bj][m][n]; }
    }
};
struct EpiProj {
    static constexpr bool PERM = true, AFTER_DRAIN = false;
    bf16_t *PG, *PXL, *PZ, *PXBC;
    __device__ __forceinline__ void operator()(const f32x4 (&acc)[2][2][4][2], const Unit& u, int wr, int wc, int fr, int fq) const {
        const int row0 = u.pm * BM + wr * 64 + fr;
        bf16_t* base; int ldc, colt;
        if (u.pn < 8) { base = PG; ldc = 2048; colt = u.pn * 256; }
        else if (u.pn < 16) { base = PXL; ldc = 2048; colt = (u.pn - 8) * 256; }
        else if (u.pn < 24) { base = PZ; ldc = 2048; colt = (u.pn - 16) * 256; }
        else { base = PXBC; ldc = 3072; colt = (u.pn - 24) * 256; }
        const int col0 = colt + wc * 32 + 8 * fq;
#pragma unroll
        for (int ai = 0; ai < 2; ++ai)
#pragma unroll
            for (int m = 0; m < 4; ++m) { bf16_t* rowp = base + (size_t)(row0 + ai * HALF + m * 16) * ldc + col0;
#pragma unroll
                for (int bj = 0; bj < 2; ++bj) { const f32x4 v0 = acc[ai][bj][m][0], v1 = acc[ai][bj][m][1];
                    u32x4 w; w.x = cvt_pk_bf16(v0[0], v0[1]); w.y = cvt_pk_bf16(v0[2], v0[3]); w.z = cvt_pk_bf16(v1[0], v1[1]); w.w = cvt_pk_bf16(v1[2], v1[3]);
                    *(u32x4*)(rowp + bj * HALF) = w; } }
    }
};
struct EpiRelu2 {
    static constexpr bool PERM = true, AFTER_DRAIN = false;
    bf16_t* O; int ldc;
    __device__ __forceinline__ void operator()(const f32x4 (&acc)[2][2][4][2], const Unit& u, int wr, int wc, int fr, int fq) const {
        const int row0 = u.pm * BM + wr * 64 + fr, col0 = u.pn * BM + wc * 32 + 8 * fq;
#pragma unroll
        for (int ai = 0; ai < 2; ++ai)
#pragma unroll
            for (int m = 0; m < 4; ++m) { bf16_t* rowp = O + (size_t)(row0 + ai * HALF + m * 16) * ldc + col0;
#pragma unroll
                for (int bj = 0; bj < 2; ++bj) { f32x4 v0 = acc[ai][bj][m][0], v1 = acc[ai][bj][m][1];
#pragma unroll
                    for (int e = 0; e < 4; ++e) { const float p = fmaxf(v0[e], 0.f), q = fmaxf(v1[e], 0.f); v0[e] = p * p; v1[e] = q * q; }
                    u32x4 w; w.x = cvt_pk_bf16(v0[0], v0[1]); w.y = cvt_pk_bf16(v0[2], v0[3]); w.z = cvt_pk_bf16(v1[0], v1[1]); w.w = cvt_pk_bf16(v1[2], v1[3]);
                    *(u32x4*)(rowp + bj * HALF) = w; } }
    }
};

struct EpiF32S {
    static constexpr bool PERM = false, AFTER_DRAIN = false;
    float* C; int ldc; float* R2; int nN, nfull, P; int mode; const float* res; const float* xp; const float* xs; const float* meta;
    __device__ __forceinline__ const float* rrow(int r) const {
        if (mode == 1) return res + (size_t)r * ldc;
        if (r >= 8768) r = 8767;
        if (r < 8256) { const int b = r / 2064, t = r - b * 2064; return t < 16 ? meta + (size_t)t * 2048 : xp + ((size_t)b * 2048 + (t - 16)) * 2048; }
        return xs + (size_t)(r - 8256) * 2048;
    }
    __device__ __forceinline__ void operator()(const f32x4 (&acc)[2][2][4][2], const Unit& u, int wr, int wc, int fr, int fq) const {
        const int r0 = wr * 64 + fr, c0 = wc * 32 + 4 * fq;
        if (u.slot < 0) {
#pragma unroll
            for (int ai = 0; ai < 2; ++ai)
#pragma unroll
                for (int m = 0; m < 4; ++m) { const int row = u.pm * BM + r0 + ai * HALF + m * 16; float* rowp = C + (size_t)row * ldc + u.pn * BM + c0; const float* rp = rrow(row) + u.pn * BM + c0;
#pragma unroll
                    for (int bj = 0; bj < 2; ++bj)
#pragma unroll
                        for (int n = 0; n < 2; ++n) *(f32x4*)(rowp + bj * HALF + n * 16) = acc[ai][bj][m][n] + *(const f32x4*)(rp + bj * HALF + n * 16);
                    if (m & 1) asm volatile("" ::: "memory"); }
        } else {
            float* base = R2 + ((size_t)((u.pm * nN + u.pn - nfull) * P + u.slot)) * 65536;
#pragma unroll
            for (int ai = 0; ai < 2; ++ai)
#pragma unroll
                for (int m = 0; m < 4; ++m) { float* rowp = base + (size_t)(r0 + ai * HALF + m * 16) * 256 + c0;
#pragma unroll
                    for (int bj = 0; bj < 2; ++bj)
#pragma unroll
                        for (int n = 0; n < 2; ++n) *(f32x4*)(rowp + bj * HALF + n * 16) = acc[ai][bj][m][n]; }
        }
    }
};
template <class Epi, class Sched, bool ALIGN_EPI = false, bool SP2 = false>
__device__ __forceinline__ void gemm_phase(PG8_LAS unsigned char* lds, const Gemm g, const Sched& S, const Epi& E) {
    const int tid = threadIdx.x, wid = __builtin_amdgcn_readfirstlane(tid >> 6), lane = tid & 63, wr = wid >> 2, wc = wid & 3, fr = lane & 15, fq = lane >> 4;
    const int K = g.K;
    unsigned voffA[2], voffB[2];
#pragma unroll
    for (int i = 0; i < 2; ++i) { int R, C; stage_rc(tid * 16 + i * 8192, R, C); const int Rb = Epi::PERM ? ((R & ~31) + perm32(R & 31)) : R;
        voffA[i] = (unsigned)(R * K + C) * 2u; voffB[i] = (unsigned)(Rb * K + C) * 2u; }
    const size_t kstep = (size_t)(BK * 2);
    const size_t hstep = (size_t)HALF * K * 2;
    const size_t tstep = 2 * hstep;
    const unsigned ldsw = (unsigned)wid * 1024u;
    const int aoff = lds_byte(wr * 64 + fr, fq * 8), boff = lds_byte(wc * 32 + fr, fq * 8);
#define PG8_SA(b, h) (((b) * 2 + (h)) * HTB)
#define PG8_SB(b, h) ((4 + (b) * 2 + (h)) * HTB)
#define PG8_STAGE(bufoff, gbase, voff) do { _Pragma("unroll") for (int _i = 0; _i < 2; ++_i) \
        __builtin_amdgcn_global_load_lds((const unsigned*)((const char*)(gbase) + (voff)[_i]), (PG8_LAS unsigned*)(lds + (bufoff) + ldsw + _i * 8192), 16, 0, 0); } while (0)
#define PG8_LDA(dst, b, h) do { _Pragma("unroll") for (int m = 0; m < 4; ++m) _Pragma("unroll") for (int k = 0; k < 2; ++k) dst[m][k] = *(const PG8_LAS bf16x8*)(lds + PG8_SA(b, h) + aoff + m * 2048 + k * 1024); } while (0)
#define PG8_LDB(dst, b, h) do { _Pragma("unroll") for (int n = 0; n < 2; ++n) _Pragma("unroll") for (int k = 0; k < 2; ++k) dst[n][k] = *(const PG8_LAS bf16x8*)(lds + PG8_SB(b, h) + boff + n * 2048 + k * 1024); } while (0)
#define PG8_MMA(ai, bj, At, Bt) do { __builtin_amdgcn_s_setprio(1); _Pragma("unroll") for (int m = 0; m < 4; ++m) _Pragma("unroll") for (int n = 0; n < 2; ++n) _Pragma("unroll") for (int k = 0; k < 2; ++k) \
        acc[ai][bj][m][n] = __builtin_amdgcn_mfma_f32_16x16x32_bf16(Bt[n][k], At[m][k], acc[ai][bj][m][n], 0, 0, 0); __builtin_amdgcn_s_setprio(0); } while (0)
#define PG8_WAIT_V(n) asm volatile("s_waitcnt vmcnt(" #n ")" ::: "memory")
#define PG8_WAIT_L(n) asm volatile("s_waitcnt lgkmcnt(" #n ")" ::: "memory")
#define PG8_BAR __builtin_amdgcn_s_barrier()
#define PG8_SCHED __builtin_amdgcn_sched_barrier(0)
    Unit cur, nxt; int ui = 0;
    if (!S.next(0, cur)) return;
    f32x4 acc[2][2][4][2];
#pragma unroll
    for (int a = 0; a < 2; ++a)
#pragma unroll
        for (int b = 0; b < 2; ++b)
#pragma unroll
            for (int m = 0; m < 4; ++m)
#pragma unroll
                for (int n = 0; n < 2; ++n) acc[a][b][m][n] = (f32x4){0.f, 0.f, 0.f, 0.f};
    bf16x8 At[4][2], B0[2][2], B1[2][2];
    const char* cA = (const char*)g.A + (size_t)cur.pm * tstep + (size_t)cur.kt0 * kstep; const char* cB = (const char*)g.Bt + (size_t)cur.pn * tstep + (size_t)cur.kt0 * kstep;
    S.a_ready(cur);
    if constexpr (SP2) {
        PG8_STAGE(PG8_SB(0, 0), cB, voffB); PG8_STAGE(PG8_SB(0, 1), cB + hstep, voffB); PG8_STAGE(PG8_SA(0, 0), cA, voffA); PG8_STAGE(PG8_SA(0, 1), cA + hstep, voffA);
        if (wr == 1) PG8_BAR;
        PG8_WAIT_V(2); PG8_BAR;
        PG8_STAGE(PG8_SB(1, 0), cB + kstep, voffB); PG8_STAGE(PG8_SA(1, 0), cA + kstep, voffA); PG8_STAGE(PG8_SB(1, 1), cB + hstep + kstep, voffB);
        PG8_WAIT_V(6); PG8_BAR;
    } else {
        PG8_STAGE(PG8_SB(0, 0), cB, voffB); PG8_STAGE(PG8_SA(0, 0), cA, voffA); PG8_STAGE(PG8_SB(0, 1), cB + hstep, voffB); PG8_STAGE(PG8_SA(0, 1), cA + hstep, voffA);
        if (wr == 1) PG8_BAR;
        PG8_WAIT_V(4); PG8_BAR;
        PG8_STAGE(PG8_SB(1, 0), cB + kstep, voffB); PG8_STAGE(PG8_SA(1, 0), cA + kstep, voffA); PG8_STAGE(PG8_SB(1, 1), cB + hstep + kstep, voffB);
        PG8_WAIT_V(6); PG8_BAR;
    }
    for (;;) {
        const bool has_next = S.next(ui + 1, nxt);
        const char* nA = has_next ? (const char*)g.A + (size_t)nxt.pm * tstep + (size_t)nxt.kt0 * kstep : cA; const char* nB = has_next ? (const char*)g.Bt + (size_t)nxt.pn * tstep + (size_t)nxt.kt0 * kstep : cB;
        const int nt = cur.nt;
        for (int t = 0; t < nt; t += 2) {
            const bool last = (t == nt - 2);
            const char* a1 = cA + (size_t)(t + 1) * kstep;
            const char* a2 = last ? nA : cA + (size_t)(t + 2) * kstep; const char* b2 = last ? nB : cB + (size_t)(t + 2) * kstep;
            const char* a3 = a2 + kstep; const char* b3 = b2 + kstep;
            if (last && has_next) S.a_ready(nxt);
            if constexpr (SP2) {
            PG8_LDB(B0, 0, 0); PG8_LDB(B1, 0, 1); PG8_SCHED; PG8_LDA(At, 0, 0); PG8_STAGE(PG8_SA(1, 1), a1 + hstep, voffA);
            PG8_WAIT_V(8); PG8_WAIT_L(0); PG8_BAR; PG8_MMA(0, 0, At, B0); PG8_MMA(0, 1, At, B1); PG8_BAR; PG8_SCHED;
            PG8_LDA(At, 0, 1); PG8_STAGE(PG8_SB(0, 0), b2, voffB); PG8_STAGE(PG8_SB(0, 1), b2 + hstep, voffB); PG8_STAGE(PG8_SA(0, 0), a2, voffA);
            PG8_WAIT_V(8); PG8_WAIT_L(0); PG8_BAR; PG8_MMA(1, 0, At, B0); PG8_MMA(1, 1, At, B1); PG8_BAR; PG8_SCHED;
            PG8_LDB(B0, 1, 0); PG8_LDB(B1, 1, 1); PG8_SCHED; PG8_LDA(At, 1, 0); PG8_STAGE(PG8_SA(0, 1), a2 + hstep, voffA);
            PG8_WAIT_V(8); PG8_WAIT_L(0); PG8_BAR; PG8_MMA(0, 0, At, B0); PG8_MMA(0, 1, At, B1); PG8_BAR; PG8_SCHED;
            PG8_LDA(At, 1, 1); PG8_STAGE(PG8_SB(1, 0), b3, voffB); PG8_STAGE(PG8_SB(1, 1), b3 + hstep, voffB); PG8_STAGE(PG8_SA(1, 0), a3, voffA);
            PG8_WAIT_V(8); PG8_WAIT_L(0); PG8_BAR; PG8_MMA(1, 0, At, B0); PG8_MMA(1, 1, At, B1); PG8_BAR; PG8_SCHED;
            } else {
            PG8_LDB(B0, 0, 0); PG8_SCHED; PG8_LDA(At, 0, 0); PG8_STAGE(PG8_SA(1, 1), a1 + hstep, voffA);
            PG8_WAIT_L(8); PG8_BAR; PG8_WAIT_L(0); PG8_MMA(0, 0, At, B0); PG8_BAR; PG8_SCHED;
            PG8_LDB(B1, 0, 1); PG8_STAGE(PG8_SB(0, 0), b2, voffB);
            PG8_BAR; PG8_WAIT_L(0); PG8_MMA(0, 1, At, B1); PG8_BAR;
            PG8_LDA(At, 0, 1); PG8_STAGE(PG8_SA(0, 0), a2, voffA);
            PG8_BAR; PG8_WAIT_L(0); PG8_MMA(1, 0, At, B0); PG8_BAR; PG8_SCHED;
            PG8_STAGE(PG8_SB(0, 1), b2 + hstep, voffB);
            PG8_WAIT_V(6); PG8_BAR; PG8_MMA(1, 1, At, B1); PG8_BAR;
            PG8_LDB(B0, 1, 0); PG8_SCHED; PG8_LDA(At, 1, 0); PG8_STAGE(PG8_SA(0, 1), a2 + hstep, voffA);
            PG8_WAIT_L(8); PG8_BAR; PG8_WAIT_L(0); PG8_MMA(0, 0, At, B0); PG8_BAR; PG8_SCHED;
            PG8_LDB(B1, 1, 1); PG8_STAGE(PG8_SB(1, 0), b3, voffB);
            PG8_BAR; PG8_WAIT_L(0); PG8_MMA(0, 1, At, B1); PG8_BAR;
            PG8_LDA(At, 1, 1); PG8_STAGE(PG8_SA(1, 0), a3, voffA);
            PG8_BAR; PG8_WAIT_L(0); PG8_MMA(1, 0, At, B0); PG8_BAR; PG8_SCHED;
            PG8_STAGE(PG8_SB(1, 1), b3 + hstep, voffB);
            PG8_WAIT_V(6); PG8_BAR; PG8_MMA(1, 1, At, B1); PG8_BAR;
            }
        }
        if constexpr (ALIGN_EPI) { if (wr == 0) PG8_BAR; }
        if constexpr (!Epi::AFTER_DRAIN) { E(acc, cur, wr, wc, fr, fq); S.done(cur); }
        if (!has_next) break;
#pragma unroll
        for (int a = 0; a < 2; ++a)
#pragma unroll
            for (int b = 0; b < 2; ++b)
#pragma unroll
                for (int m = 0; m < 4; ++m)
#pragma unroll
                    for (int n = 0; n < 2; ++n) acc[a][b][m][n] = (f32x4){0.f, 0.f, 0.f, 0.f};
        cur = nxt; cA = nA; cB = nB; ++ui;
        if constexpr (ALIGN_EPI) { if (wr == 1) PG8_BAR; }
    }
    PG8_WAIT_V(0);
    if constexpr (!ALIGN_EPI) { if (wr == 0) PG8_BAR; }
    PG8_BAR;
    if constexpr (Epi::AFTER_DRAIN) { E.fused(acc, cur, wr, wc, fr, fq, lds, wid, lane); S.done(cur); }
#undef PG8_SA
#undef PG8_SB
#undef PG8_STAGE
#undef PG8_LDA
#undef PG8_LDB
#undef PG8_MMA
#undef PG8_WAIT_V
#undef PG8_WAIT_L
#undef PG8_BAR
#undef PG8_SCHED
}
}
#ifndef PG8_SP2
#define PG8_SP2 true
#endif
#ifndef PG8_ALIGN
#define PG8_ALIGN true
#endif

#define LAS __attribute__((address_space(3)))
typedef unsigned short bf16;
typedef unsigned v4u __attribute__((ext_vector_type(4)));
typedef unsigned v2u __attribute__((ext_vector_type(2)));
typedef float f32x4 __attribute__((ext_vector_type(4)));
typedef short bf16x8 __attribute__((ext_vector_type(8)));
constexpr int NWAVES = 8, NTHR = 512;
constexpr int DM = 2048, NB = 4, SEQ = 2048, NMETA = 16, LP = 2064, DB = 128, DS = 4;
constexpr int MP = NB * LP;
constexpr int MS = DB * DS;
constexpr int MR = MP + MS;
constexpr int MPAD = 8960;
constexpr int NH = 32, NPROJ = 9248, NMAIN = 9216, DFF = 8192, DMIX = 4096, DCONV = 3072;
constexpr int NSEG = 33;
constexpr float EPS = 1e-6f;
constexpr size_t MiB = 1u << 20;
constexpr size_t WS_WIN = 1 * MiB, WS_WOUT = 38 * MiB, WS_WUP = 54 * MiB, WS_WDN = 86 * MiB, WS_WG = 118 * MiB;
constexpr size_t WS_H = 120 * MiB, WS_XN = 120 * MiB, WS_MIX = 120 * MiB, WS_XS = 190 * MiB, WS_BC = 225 * MiB;
constexpr size_t WS_PART = 260 * MiB, WS_A = 260 * MiB, WS_BT = 330 * MiB, WS_PXL = 260 * MiB, WS_PXBC = 295 * MiB;
constexpr size_t WS_PG = 400 * MiB, WS_PZ = 435 * MiB, WS_X1 = 400 * MiB, WS_XL = 470 * MiB, WS_HP = 470 * MiB;
constexpr size_t WS_DT = 505 * MiB, WS_AGGA = 507 * MiB, WS_AGGH = 509 * MiB, WS_END = 512 * MiB;
constexpr size_t WS_R2 = 330 * MiB;
constexpr int LDS_BYTES = 147456;
constexpr int NPHASE = 12;

struct Args { const float* in[28]; float* out; unsigned char* ws; int ph_lo, ph_hi; };
constexpr size_t O_YP = 0, O_YS = 16777216, O_PLH = O_YS + 1048576, O_PLC = O_PLH + 8192, O_PSSD = O_PLC + 24576, O_PSC = O_PSSD + 1048576,
                 O_SLH = O_PSC + 36864, O_SLC = O_SLH + 262144, O_SSSD = O_SLC + 786432, O_SSC = O_SSSD + 33554432, O_END = O_SSC + 1179648;

struct Ctx {
    const float *xp, *xs, *st_lru_h, *st_lru_conv, *st_ssd, *st_ssd_conv, *meta, *g_mix, *w_in, *conv_lru_w, *conv_lru_b, *lru_wa, *lru_ba, *lru_wx, *lru_bx,
                *lru_lam, *g_lru_out, *conv_ssd_w, *conv_ssd_b, *dt_bias, *a_log, *d_skip, *g_ssd_out, *w_out, *g_mlp, *w_up, *w_down, *g_final;
    float* out; unsigned char* ws;
    LAS unsigned char* lds;
    int tid, lane, wave, blk, G;
};

__device__ __forceinline__ unsigned f2bf(float f) { unsigned u = __builtin_bit_cast(unsigned, f); return (u + 0x7fffu + ((u >> 16) & 1u)) >> 16; }
__device__ __forceinline__ unsigned pk2(float lo, float hi) { unsigned r; asm("v_cvt_pk_bf16_f32 %0, %1, %2" : "=v"(r) : "v"(lo), "v"(hi)); return r; }
__device__ __forceinline__ float bflo(unsigned w) { return __builtin_bit_cast(float, w << 16); }
__device__ __forceinline__ float bfhi(unsigned w) { return __builtin_bit_cast(float, w & 0xffff0000u); }
__device__ __forceinline__ float bf1(bf16 h) { return __builtin_bit_cast(float, ((unsigned)h) << 16); }
#define SUM_DPP_STEP(v, ctrl, rmask) do { const int t_ = __builtin_amdgcn_update_dpp(0, __builtin_bit_cast(int, v), ctrl, rmask, 0xf, false); v += __builtin_bit_cast(float, t_); } while (0)
__device__ __forceinline__ float wave_sum(float v) {
    SUM_DPP_STEP(v, 0x111, 0xf); SUM_DPP_STEP(v, 0x112, 0xf); SUM_DPP_STEP(v, 0x114, 0xf); SUM_DPP_STEP(v, 0x118, 0xf);
    SUM_DPP_STEP(v, 0x142, 0xa); SUM_DPP_STEP(v, 0x143, 0xc);
    return __builtin_bit_cast(float, __builtin_amdgcn_readlane(__builtin_bit_cast(int, v), 63));
}
__device__ __forceinline__ float sigmoidf_(float x) { return __builtin_amdgcn_rcpf(1.0f + __expf(-x)); }
__device__ __forceinline__ float siluf_(float x) { return x * __builtin_amdgcn_rcpf(1.0f + __expf(-x)); }
__device__ __forceinline__ float softplusf_(float x) { return x > 20.f ? x : log1pf(expf(x)); }
__device__ __forceinline__ float gelu_tanh(float x) { const float u = 0.7978845608028654f * (x + 0.044715f * x * x * x); const float t = 1.0f - 2.0f * __builtin_amdgcn_rcpf(__expf(2.0f * u) + 1.0f); return 0.5f * x * (1.0f + t); }

__device__ __forceinline__ const float* xrow_ptr(const Ctx& F, int r) {
    if (r < MP) { const int b = r / LP, t = r - b * LP; return t < NMETA ? F.meta + (size_t)t * DM : F.xp + ((size_t)b * SEQ + (t - NMETA)) * DM; }
    return F.xs + (size_t)(r - MP) * DM;
}

__device__ __forceinline__ void transpose_item(const float* W, int ldw, bf16* WT, int K, int k0, int n0, LAS float* scr, int lane) {
#pragma unroll 8
    for (int i = 0; i < 32; ++i) { const int kk = 2 * i + (lane >> 5); scr[kk * 33 + (lane & 31)] = W[(size_t)(k0 + kk) * ldw + n0 + (lane & 31)]; }
    asm volatile("s_waitcnt lgkmcnt(0)" ::: "memory");
    const int c = lane & 7;
#pragma unroll
    for (int j = 0; j < 4; ++j) { const int n = (lane >> 3) + 8 * j; const LAS float* s = scr + (8 * c) * 33 + n;
        v4u o; o.x = pk2(s[0 * 33], s[1 * 33]); o.y = pk2(s[2 * 33], s[3 * 33]); o.z = pk2(s[4 * 33], s[5 * 33]); o.w = pk2(s[6 * 33], s[7 * 33]);
        *(v4u*)(WT + (size_t)(n0 + n) * K + k0 + 8 * c) = o; }
    asm volatile("s_waitcnt lgkmcnt(0)" ::: "memory");
}
__device__ __forceinline__ void rms_row_store(const f32x4 (&v)[8], const float* g, bf16* orow, int lane) {
    float ss = 0.f;
#pragma unroll
    for (int j = 0; j < 8; ++j) ss += (v[j].x * v[j].x + v[j].y * v[j].y) + (v[j].z * v[j].z + v[j].w * v[j].w);
    const float rs = rsqrtf(wave_sum(ss) * (1.f / DM) + EPS);
#pragma unroll
    for (int j = 0; j < 8; ++j) { const f32x4 gg = *(const f32x4*)(g + 4 * lane + 256 * j); const f32x4 o = v[j] * rs * gg;
        v2u w; w.x = pk2(o.x, o.y); w.y = pk2(o.z, o.w); *(v2u*)(orow + 4 * lane + 256 * j) = w; }
}
constexpr int I_IN = 32 * 289, I_OUT = 64 * 64, I_UP = 32 * 256, I_DN = 128 * 64, I_G = 256, NITEMS = I_IN + I_OUT + I_UP + I_DN + I_G;
__device__ __forceinline__ void convert_range(const Ctx& F, int lo, int hi, int part, int nparts) {
    LAS float* scr = (LAS float*)(F.lds + F.wave * 16384);
    bf16* WIN = (bf16*)(F.ws + WS_WIN); bf16* WOUT = (bf16*)(F.ws + WS_WOUT); bf16* WUP = (bf16*)(F.ws + WS_WUP); bf16* WDN = (bf16*)(F.ws + WS_WDN); bf16* WG = (bf16*)(F.ws + WS_WG);
    for (int it = lo + part * NWAVES + F.wave; it < hi; it += nparts * NWAVES) {
        int r = it;
        if (r < I_IN) { transpose_item(F.w_in, NPROJ, WIN, 2048, 64 * (r / 289), 32 * (r % 289), scr, F.lane); continue; } r -= I_IN;
        if (r < I_OUT) { transpose_item(F.w_out, 2048, WOUT, 4096, 64 * (r / 64), 32 * (r % 64), scr, F.lane); continue; } r -= I_OUT;
        if (r < I_UP) { transpose_item(F.w_up, 8192, WUP, 2048, 64 * (r / 256), 32 * (r % 256), scr, F.lane); continue; } r -= I_UP;
        if (r < I_DN) { transpose_item(F.w_down, 2048, WDN, 8192, 64 * (r / 64), 32 * (r % 64), scr, F.lane); continue; } r -= I_DN;
        { const int mat = r >> 7, hd = (r >> 3) & 15, sub = r & 7;
          transpose_item((mat ? F.lru_wx : F.lru_wa) + (size_t)hd * 16384, 128, WG + (size_t)(hd * 256 + mat * 128) * 128, 128, 64 * (sub >> 2), 32 * (sub & 3), scr, F.lane); }
    }
}
__device__ __forceinline__ void slack_parts(int n, int G, int blk, int& part, int& nparts) {
    const int nmax = (n + G - 1) / G, cut = (n % G == 0) ? 0 : n - (nmax - 1) * G;
    part = blk - cut; nparts = G - cut;
}
__device__ __forceinline__ void phase_prologue(const Ctx& F) {
    const int gw = F.blk * NWAVES + F.wave, NGW = F.G * NWAVES;
    convert_range(F, 0, I_IN, F.blk, F.G);
    convert_range(F, I_IN + I_OUT + I_UP + I_DN, NITEMS, F.blk, F.G);
    bf16* XN = (bf16*)(F.ws + WS_XN);
    for (int m = gw; m < MPAD; m += NGW) {
        bf16* orow = XN + (size_t)m * DM;
        if (m >= MR) {
#pragma unroll
            for (int j = 0; j < 8; ++j) *(v2u*)(orow + 4 * F.lane + 256 * j) = (v2u){0u, 0u};
            continue; }
        const float* xr = xrow_ptr(F, m); f32x4 v[8];
#pragma unroll
        for (int j = 0; j < 8; ++j) v[j] = *(const f32x4*)(xr + 4 * F.lane + 256 * j);
        rms_row_store(v, F.g_mix, orow, F.lane);
    }
}

__device__ __forceinline__ void phase_dt(const Ctx& F) {
    const int fr = F.lane & 15, fq = F.lane >> 4;
    const bf16* XN = (const bf16*)(F.ws + WS_XN); const bf16* WD = (const bf16*)(F.ws + WS_WIN) + (size_t)NMAIN * 2048; float* DT = (float*)(F.ws + WS_DT);
    LAS float* red = (LAS float*)F.lds;
    for (int blk = F.blk; blk < MR / 16; blk += F.G) {
        f32x4 c0 = {0.f, 0.f, 0.f, 0.f}, c1 = {0.f, 0.f, 0.f, 0.f};
        const int kb = F.wave * 256;
        const bf16* ap = XN + (size_t)(blk * 16 + fr) * DM + kb + fq * 8; const bf16* b0p = WD + (size_t)fr * DM + kb + fq * 8; const bf16* b1p = WD + (size_t)(16 + fr) * DM + kb + fq * 8;
#pragma unroll
        for (int k0 = 0; k0 < 256; k0 += 32) {
            const bf16x8 a = *(const bf16x8*)(ap + k0), b0 = *(const bf16x8*)(b0p + k0), b1 = *(const bf16x8*)(b1p + k0);
            c0 = __builtin_amdgcn_mfma_f32_16x16x32_bf16(a, b0, c0, 0, 0, 0); c1 = __builtin_amdgcn_mfma_f32_16x16x32_bf16(a, b1, c1, 0, 0, 0);
        }
        *(LAS f32x4*)(red + (F.wave * 64 + F.lane) * 8) = c0; *(LAS f32x4*)(red + (F.wave * 64 + F.lane) * 8 + 4) = c1;
        __syncthreads();
        if (F.wave == 0) {
#pragma unroll
            for (int w = 1; w < 8; ++w) { c0 += *(const LAS f32x4*)(red + (w * 64 + F.lane) * 8); c1 += *(const LAS f32x4*)(red + (w * 64 + F.lane) * 8 + 4); }
            const float bb0 = F.dt_bias[fr], bb1 = F.dt_bias[16 + fr];
#pragma unroll
            for (int e = 0; e < 4; ++e) { const int row = blk * 16 + fq * 4 + e; DT[row * NH + fr] = softplusf_(c0[e] + bb0); DT[row * NH + 16 + fr] = softplusf_(c1[e] + bb1); }
        }
        __syncthreads();
    }
}

__device__ __forceinline__ void phase_conv(const Ctx& F) {
    const bf16* PXL = (const bf16*)(F.ws + WS_PXL); const bf16* PXBC = (const bf16*)(F.ws + WS_PXBC);
    bf16* XL = (bf16*)(F.ws + WS_XL); bf16* XS = (bf16*)(F.ws + WS_XS); bf16* BC = (bf16*)(F.ws + WS_BC);
    constexpr int NRB = MR / 4, NCG = 640;
    const int vblk = (F.G % 8 == 0) ? (F.blk & 7) * (F.G >> 3) + (F.blk >> 3) : F.blk;
    for (int idx = vblk * NTHR + F.tid; idx < NRB * NCG; idx += F.G * NTHR) {
        const int cg_ = idx % NCG, rb = idx / NCG; const bool lru = cg_ < 256;
        const int c0 = lru ? cg_ * 8 : (cg_ - 256) * 8, ld = lru ? 2048 : 3072;
        const bf16* src = lru ? PXL : PXBC; const float* cw = lru ? F.conv_lru_w : F.conv_ssd_w; const float* cb = lru ? F.conv_lru_b : F.conv_ssd_b;
        const int row0 = rb * 4; const bool prompt = row0 < MP;
        int b = 0, t0 = 0, s = 0; if (prompt) { b = row0 / LP; t0 = row0 - b * LP; } else s = (row0 - MP) >> 2;
        float win[7][8];
        if (prompt) {
            if (t0 == 0) {
#pragma unroll
                for (int i = 0; i < 3; ++i)
#pragma unroll
                    for (int e = 0; e < 8; ++e) win[i][e] = 0.f;
            } else {
#pragma unroll
                for (int i = 0; i < 3; ++i) { const v4u w = *(const v4u*)(src + (size_t)(row0 - 3 + i) * ld + c0);
                    win[i][0] = bflo(w.x); win[i][1] = bfhi(w.x); win[i][2] = bflo(w.y); win[i][3] = bfhi(w.y); win[i][4] = bflo(w.z); win[i][5] = bfhi(w.z); win[i][6] = bflo(w.w); win[i][7] = bfhi(w.w); }
            }
        } else {
            const float* st = (lru ? F.st_lru_conv : F.st_ssd_conv) + (size_t)s * 3 * ld + c0;
#pragma unroll
            for (int i = 0; i < 3; ++i) { const f32x4 u0 = *(const f32x4*)(st + (size_t)i * ld), u1 = *(const f32x4*)(st + (size_t)i * ld + 4);
                win[i][0] = u0.x; win[i][1] = u0.y; win[i][2] = u0.z; win[i][3] = u0.w; win[i][4] = u1.x; win[i][5] = u1.y; win[i][6] = u1.z; win[i][7] = u1.w; }
        }
#pragma unroll
        for (int i = 0; i < 4; ++i) { const v4u w = *(const v4u*)(src + (size_t)(row0 + i) * ld + c0);
            win[3 + i][0] = bflo(w.x); win[3 + i][1] = bfhi(w.x); win[3 + i][2] = bflo(w.y); win[3 + i][3] = bfhi(w.y); win[3 + i][4] = bflo(w.z); win[3 + i][5] = bfhi(w.z); win[3 + i][6] = bflo(w.w); win[3 + i][7] = bfhi(w.w); }
        float wk[4][8], bias[8];
#pragma unroll
        for (int k = 0; k < 4; ++k) { const f32x4 u0 = *(const f32x4*)(cw + (size_t)k * ld + c0), u1 = *(const f32x4*)(cw + (size_t)k * ld + c0 + 4);
            wk[k][0] = u0.x; wk[k][1] = u0.y; wk[k][2] = u0.z; wk[k][3] = u0.w; wk[k][4] = u1.x; wk[k][5] = u1.y; wk[k][6] = u1.z; wk[k][7] = u1.w; }
        { const f32x4 u0 = *(const f32x4*)(cb + c0), u1 = *(const f32x4*)(cb + c0 + 4); bias[0] = u0.x; bias[1] = u0.y; bias[2] = u0.z; bias[3] = u0.w; bias[4] = u1.x; bias[5] = u1.y; bias[6] = u1.z; bias[7] = u1.w; }
#pragma unroll
        for (int j = 0; j < 4; ++j) {
            float o[8];
#pragma unroll
            for (int e = 0; e < 8; ++e) { float v = bias[e] + win[j][e] * wk[0][e]; v += win[j + 1][e] * wk[1][e]; v += win[j + 2][e] * wk[2][e]; v += win[j + 3][e] * wk[3][e]; o[e] = v; }
            const size_t row = (size_t)(row0 + j);
            if (lru) { v4u w; w.x = pk2(o[0], o[1]); w.y = pk2(o[2], o[3]); w.z = pk2(o[4], o[5]); w.w = pk2(o[6], o[7]); *(v4u*)(XL + row * 2048 + c0) = w; }
            else {
#pragma unroll
                for (int e = 0; e < 8; ++e) o[e] = siluf_(o[e]);
                if (c0 < 2048) { v4u w; w.x = pk2(o[0], o[1]); w.y = pk2(o[2], o[3]); w.z = pk2(o[4], o[5]); w.w = pk2(o[6], o[7]); *(v4u*)(XS + row * 2048 + c0) = w; }
                else { v4u w; w.x = pk2(o[0], o[1]); w.y = pk2(o[2], o[3]); w.z = pk2(o[4], o[5]); w.w = pk2(o[6], o[7]); *(v4u*)(BC + row * 1024 + (c0 - 2048)) = w; }
            }
        }
        float* cst = nullptr;
        if (prompt) { if (t0 == LP - 4) cst = F.out + (lru ? O_PLC : O_PSC) + (size_t)b * 3 * ld + c0; }
        else cst = F.out + (lru ? O_SLC : O_SSC) + (size_t)s * 3 * ld + c0;
        if (cst) {
#pragma unroll
            for (int i = 0; i < 3; ++i) { *(f32x4*)(cst + (size_t)i * ld) = (f32x4){win[4 + i][0], win[4 + i][1], win[4 + i][2], win[4 + i][3]}; *(f32x4*)(cst + (size_t)i * ld + 4) = (f32x4){win[4 + i][4], win[4 + i][5], win[4 + i][6], win[4 + i][7]}; }
        }
    }
}

__device__ __forceinline__ void gate_unit(const Ctx& F, int pm, int head) {
    constexpr int RS = 272;
    LAS unsigned char* LA = F.lds; LAS unsigned char* LB = F.lds + 256 * RS;
    const bf16* XL = (const bf16*)(F.ws + WS_XL) + (size_t)pm * 256 * 2048 + head * 128; const bf16* WG = (const bf16*)(F.ws + WS_WG) + (size_t)head * 256 * 128;
    float* Ao = (float*)(F.ws + WS_A); float* Bo = (float*)(F.ws + WS_BT);
    { const int row = F.tid >> 4, cp = F.tid & 15;
      const bf16* ga = XL + (size_t)row * 2048 + cp * 8; const bf16* gb = WG + row * 128 + cp * 8; LAS unsigned char* la = LA + row * RS + cp * 16;
#pragma unroll 2
      for (int i = 0; i < 8; ++i) { const v4u va = *(const v4u*)(ga + (size_t)i * 32 * 2048), vb = *(const v4u*)(gb + i * 32 * 128);
          *(LAS v4u*)(la + i * 32 * RS) = va; *(LAS v4u*)(la + 256 * RS + i * 32 * RS) = vb; } }
    __syncthreads();
    const int wr = F.wave >> 2, wc = F.wave & 3, fr = F.lane & 15, fq = F.lane >> 4;
    float cba[2][4], cbx[2][4], csp[2][4];
#pragma unroll
    for (int n = 0; n < 2; ++n)
#pragma unroll
        for (int e = 0; e < 4; ++e) { const int ch = head * 128 + 32 * wc + 16 * n + 4 * fq + e; cba[n][e] = F.lru_ba[ch]; cbx[n][e] = F.lru_bx[ch]; csp[n][e] = 8.0f * softplusf_(-F.lru_lam[ch]); }
#pragma unroll 1
    for (int mh = 0; mh < 2; ++mh) {
        f32x4 accr[4][2], acci[4][2];
#pragma unroll
        for (int m = 0; m < 4; ++m)
#pragma unroll
            for (int n = 0; n < 2; ++n) { accr[m][n] = (f32x4){0.f, 0.f, 0.f, 0.f}; acci[m][n] = (f32x4){0.f, 0.f, 0.f, 0.f}; }
        const int rbase = 128 * wr + 64 * mh;
#pragma unroll
        for (int ks = 0; ks < 4; ++ks) {
            bf16x8 br[2], bi[2];
#pragma unroll
            for (int n = 0; n < 2; ++n) { br[n] = *(const LAS bf16x8*)(LB + (32 * wc + 16 * n + fr) * RS + (32 * ks + 8 * fq) * 2); bi[n] = *(const LAS bf16x8*)(LB + (128 + 32 * wc + 16 * n + fr) * RS + (32 * ks + 8 * fq) * 2); }
#pragma unroll
            for (int m = 0; m < 4; ++m) { const bf16x8 af = *(const LAS bf16x8*)(LA + (rbase + 16 * m + fr) * RS + (32 * ks + 8 * fq) * 2);
#pragma unroll
                for (int n = 0; n < 2; ++n) { accr[m][n] = __builtin_amdgcn_mfma_f32_16x16x32_bf16(br[n], af, accr[m][n], 0, 0, 0); acci[m][n] = __builtin_amdgcn_mfma_f32_16x16x32_bf16(bi[n], af, acci[m][n], 0, 0, 0); } }
        }
#pragma unroll
        for (int m = 0; m < 4; ++m) {
            const int rl = rbase + 16 * m + fr, row = pm * 256 + rl;
            if (row < MR) {
                const bool first = (row < MP) && (row % LP == 0);
                const float* h0p = (row >= MP && ((row - MP) & 3) == 0) ? F.st_lru_h + (size_t)((row - MP) >> 2) * 2048 : nullptr;
#pragma unroll
                for (int n = 0; n < 2; ++n) {
                    const int j0 = 32 * wc + 16 * n + 4 * fq, ch0 = head * 128 + j0;
                    const v2u xw = *(const LAS v2u*)(LA + rl * RS + j0 * 2);
                    const float xl[4] = {bflo(xw.x), bfhi(xw.x), bflo(xw.y), bfhi(xw.y)};
                    f32x4 h0v = {0.f, 0.f, 0.f, 0.f}; if (h0p) h0v = *(const f32x4*)(h0p + ch0);
                    f32x4 av, bv;
#pragma unroll
                    for (int e = 0; e < 4; ++e) {
                        const float r = sigmoidf_(accr[m][n][e] + cba[n][e]), ii = sigmoidf_(acci[m][n][e] + cbx[n][e]);
                        const float a = __expf(-csp[n][e] * r); const float mult = first ? 1.0f : __builtin_amdgcn_sqrtf(fmaxf(1.0f - a * a, 0.f));
                        av[e] = a; bv[e] = mult * ii * xl[e] + a * h0v[e];
                    }
                    *(f32x4*)(Ao + (size_t)row * 2048 + ch0) = av; *(f32x4*)(Bo + (size_t)row * 2048 + ch0) = bv;
                }
            }
        }
    }
    __syncthreads();
}
__device__ __forceinline__ void phase_gates(const Ctx& F) {
    for (int u = F.blk; u < 35 * 16; u += F.G) gate_unit(F, u >> 4, u & 15);
#ifdef PROBE_G2
    for (int u = F.blk; u < 35 * 16; u += F.G) gate_unit(F, u >> 4, u & 15);
#endif
    int part, nparts; slack_parts(35 * 16, F.G, F.blk, part, nparts);
    if (part >= 0) convert_range(F, I_IN, I_IN + I_OUT + I_UP, part, nparts);
#ifdef PROBE_C2
    __syncthreads();
    if (part >= 0) convert_range(F, I_IN, I_IN + I_OUT + I_UP, part, nparts);
#endif
}

__device__ __forceinline__ void ssd_unit(const Ctx& F, int row0, int T, int head, const float* h0, float* hout) {
    const float* DT = (const float*)(F.ws + WS_DT); const bf16* XS = (const bf16*)(F.ws + WS_XS); const float* BC = (const float*)(F.ws + WS_BC); const bf16* PZ = (const bf16*)(F.ws + WS_PZ);
    bf16* MIX = (bf16*)(F.ws + WS_MIX);
    LAS float* xch = (LAS float*)F.lds;
    const int g = head >> 3, wave = F.wave, lane = F.lane;
    const float Ah = -expf(F.a_log[head]), Dh = F.d_skip[head];
    f32x4 h[4];
#pragma unroll
    for (int q = 0; q < 4; ++q) h[q] = h0 ? *(const f32x4*)(h0 + ((size_t)head * 64 + lane) * 128 + 16 * wave + 4 * q) : (f32x4){0.f, 0.f, 0.f, 0.f};
    for (int tb = 0; tb < T; tb += 4) {
        float part[4];
#pragma unroll
        for (int tt = 0; tt < 4; ++tt) {
            const size_t row = (size_t)(row0 + tb + tt);
            const float dt = DT[row * NH + head]; const float dA = __expf(dt * Ah);
            const float dtx = dt * bf1(XS[row * 2048 + head * 64 + lane]);
            const f32x4* Bp = (const f32x4*)(BC + row * 1024 + g * 128 + 16 * wave); const f32x4* Cp = (const f32x4*)(BC + row * 1024 + 512 + g * 128 + 16 * wave);
            float acc = 0.f;
#pragma unroll
            for (int q = 0; q < 4; ++q) { const f32x4 b4 = Bp[q], c4 = Cp[q];
#pragma unroll
                for (int e = 0; e < 4; ++e) { h[q][e] = dA * h[q][e] + dtx * b4[e]; acc += h[q][e] * c4[e]; } }
            part[tt] = acc;
        }
        const int buf = (tb >> 2) & 1;
#pragma unroll
        for (int tt = 0; tt < 4; ++tt) xch[buf * 2048 + (wave * 4 + tt) * 64 + lane] = part[tt];
        __syncthreads();
        if (F.tid < 256) {
            const int tt = F.tid >> 6, p = F.tid & 63; float y = 0.f;
#pragma unroll
            for (int w = 0; w < 8; ++w) y += xch[buf * 2048 + (w * 4 + tt) * 64 + p];
            const size_t row = (size_t)(row0 + tb + tt);
            const float x = bf1(XS[row * 2048 + head * 64 + p]), z = bf1(PZ[row * 2048 + head * 64 + p]);
            MIX[row * 4096 + 2048 + head * 64 + p] = (bf16)f2bf((y + Dh * x) * siluf_(z));
        }
    }
#pragma unroll
    for (int q = 0; q < 4; ++q) *(f32x4*)(hout + ((size_t)head * 64 + lane) * 128 + 16 * wave + 4 * q) = h[q];
    __syncthreads();
}

__device__ __forceinline__ void ssd_sample_wave(const Ctx& F, int part, int nparts) {
    const float* DT = (const float*)(F.ws + WS_DT); const bf16* XS = (const bf16*)(F.ws + WS_XS); const float* BC = (const float*)(F.ws + WS_BC); const bf16* PZ = (const bf16*)(F.ws + WS_PZ);
    bf16* MIX = (bf16*)(F.ws + WS_MIX);
    const int gw = part * NWAVES + F.wave, NGW = nparts * NWAVES, lane = F.lane, pl = lane >> 3, no = lane & 7;
    constexpr int NU = DB * NH * 8;
    f32x4 hn[4];
    if (gw < NU) { const float* hp = F.st_ssd + ((size_t)(gw >> 3) * 64 + (gw & 7) * 8 + pl) * 128 + 16 * no;
#pragma unroll
        for (int q = 0; q < 4; ++q) hn[q] = *(const f32x4*)(hp + 4 * q); }
    for (int u = gw; u < NU; u += NGW) {
        const int po = u & 7, head = (u >> 3) & 31, s_ = u >> 8, g = head >> 3, p = po * 8 + pl;
        f32x4 h[4];
#pragma unroll
        for (int q = 0; q < 4; ++q) h[q] = hn[q];
        const int un = u + NGW;
        if (un < NU) { const float* hp = F.st_ssd + ((size_t)(un >> 3) * 64 + (un & 7) * 8 + pl) * 128 + 16 * no;
#pragma unroll
            for (int q = 0; q < 4; ++q) hn[q] = *(const f32x4*)(hp + 4 * q); }
        const float Ah = -expf(F.a_log[head]), Dh = F.d_skip[head];
        float dtv[4], xv[4], zv[4]; f32x4 bv[4][4], cv[4][4];
#pragma unroll
        for (int j = 0; j < 4; ++j) { const size_t row = (size_t)(MP + 4 * s_ + j);
            dtv[j] = DT[row * NH + head]; xv[j] = bf1(XS[row * 2048 + head * 64 + p]); zv[j] = bf1(PZ[row * 2048 + head * 64 + p]);
            const float* bp = BC + row * 1024 + g * 128 + 16 * no;
#pragma unroll
            for (int q = 0; q < 4; ++q) { bv[j][q] = *(const f32x4*)(bp + 4 * q); cv[j][q] = *(const f32x4*)(bp + 512 + 4 * q); } }
#pragma unroll
        for (int j = 0; j < 4; ++j) {
            const float dA = __expf(dtv[j] * Ah), dtx = dtv[j] * xv[j]; float acc = 0.f;
#pragma unroll
            for (int q = 0; q < 4; ++q)
#pragma unroll
                for (int e = 0; e < 4; ++e) { h[q][e] = dA * h[q][e] + dtx * bv[j][q][e]; acc += h[q][e] * cv[j][q][e]; }
            acc += __shfl_xor(acc, 1); acc += __shfl_xor(acc, 2); acc += __shfl_xor(acc, 4);
            if (no == 0) MIX[(size_t)(MP + 4 * s_ + j) * 4096 + 2048 + head * 64 + p] = (bf16)f2bf((acc + Dh * xv[j]) * siluf_(zv[j]));
        }
        float* op = F.out + O_SSSD + ((size_t)(u >> 3) * 64 + po * 8 + pl) * 128 + 16 * no;
#pragma unroll
        for (int q = 0; q < 4; ++q) *(f32x4*)(op + 4 * q) = h[q];
    }
}

__device__ __forceinline__ void ssd_sample_blk(const Ctx& F, int part, int nparts) {
    const float* DT = (const float*)(F.ws + WS_DT); const bf16* XS = (const bf16*)(F.ws + WS_XS); const bf16* BC = (const bf16*)(F.ws + WS_BC); const bf16* PZ = (const bf16*)(F.ws + WS_PZ);
    bf16* MIX = (bf16*)(F.ws + WS_MIX);
    LAS float* sb = (LAS float*)F.lds;
    LAS bf16* xl = (LAS bf16*)(F.lds + 4096); LAS bf16* zl = (LAS bf16*)(F.lds + 8192);
    LAS float* dl = (LAS float*)(F.lds + 12288);
    const int lane = F.lane, pl = lane >> 3, no = lane & 7, p = F.wave * 8 + pl;
    constexpr int NIT = DB * 4;
    f32x4 hn[4];
#define SMP_LOAD(it_, hh_) do { const float* hp = F.st_ssd + (((size_t)((it_) >> 2) * NH + 8 * ((it_) & 3) + (hh_)) * 64 + p) * 128 + 16 * no; \
        _Pragma("unroll") for (int q = 0; q < 4; ++q) hn[q] = *(const f32x4*)(hp + 4 * q); } while (0)
    if (part < NIT) SMP_LOAD(part, 0);
#pragma unroll 1
    for (int it = part; it < NIT; it += nparts) {
        const int s_ = it >> 2, g = it & 3;
        if (F.tid < 256) { const int tok = F.tid >> 6, r = F.tid & 63, which = r >> 5, n4 = r & 31;
            const v2u w = *(const v2u*)(BC + (size_t)(MP + 4 * s_ + tok) * 1024 + which * 512 + g * 128 + 4 * n4);
            *(LAS f32x4*)(sb + (tok * 2 + which) * 128 + 4 * n4) = (f32x4){bflo(w.x), bfhi(w.x), bflo(w.y), bfhi(w.y)}; }
        { const int tok = F.tid >> 7, which = (F.tid >> 6) & 1, piece = F.tid & 63;
          const v4u w = *(const v4u*)((which ? PZ : XS) + (size_t)(MP + 4 * s_ + tok) * 2048 + g * 512 + piece * 8);
          *(LAS v4u*)((which ? zl : xl) + tok * 512 + piece * 8) = w; }
        if (F.tid < 32) dl[F.tid] = DT[(size_t)(MP + 4 * s_ + (F.tid >> 3)) * NH + 8 * g + (F.tid & 7)];
        __syncthreads();
#pragma unroll 1
        for (int hh = 0; hh < 8; ++hh) {
            const int head = 8 * g + hh;
            f32x4 h[4];
#pragma unroll
            for (int q = 0; q < 4; ++q) h[q] = hn[q];
            if (hh < 7) SMP_LOAD(it, hh + 1); else if (it + nparts < NIT) SMP_LOAD(it + nparts, 0);
            const float Ah = -expf(F.a_log[head]), Dh = F.d_skip[head];
#pragma unroll
            for (int j = 0; j < 4; ++j) {
                const float xv = bf1(xl[j * 512 + hh * 64 + p]), zv = bf1(zl[j * 512 + hh * 64 + p]), dtv = dl[j * 8 + hh];
                const float dA = __expf(dtv * Ah), dtx = dtv * xv; float acc = 0.f;
#pragma unroll
                for (int q = 0; q < 4; ++q) { const f32x4 b4 = *(const LAS f32x4*)(sb + (j * 2) * 128 + 16 * no + 4 * q), c4 = *(const LAS f32x4*)(sb + (j * 2 + 1) * 128 + 16 * no + 4 * q);
#pragma unroll
                    for (int e = 0; e < 4; ++e) { h[q][e] = dA * h[q][e] + dtx * b4[e]; acc += h[q][e] * c4[e]; } }
                acc += __shfl_xor(acc, 1); acc += __shfl_xor(acc, 2); acc += __shfl_xor(acc, 4);
                if (no == 0) MIX[(size_t)(MP + 4 * s_ + j) * 4096 + 2048 + head * 64 + p] = (bf16)f2bf((acc + Dh * xv) * siluf_(zv));
            }
            float* op = F.out + O_SSSD + (((size_t)s_ * NH + head) * 64 + p) * 128 + 16 * no;
#pragma unroll
            for (int q = 0; q < 4; ++q) *(f32x4*)(op + 4 * q) = h[q];
        }
        __syncthreads();
    }
#undef SMP_LOAD
}
__device__ __forceinline__ void lru_aggregate(const Ctx& F, int part, int nparts) {
    const float* Ai = (const float*)(F.ws + WS_A); const float* Bi = (const float*)(F.ws + WS_BT); float* GA = (float*)(F.ws + WS_AGGA); float* GH = (float*)(F.ws + WS_AGGH);
    for (int idx = part * NTHR + F.tid; idx < NB * NSEG * 2048; idx += nparts * NTHR) {
        const int ch = idx & 2047, sg = (idx >> 11) % NSEG, b = idx / (2048 * NSEG);
        const int t0 = sg * 64, t1 = min(t0 + 64, LP);
        float ap = 1.f, hh = 0.f;
        if (t1 - t0 == 64) {
            for (int t = t0; t < t1; t += 32) { float av[32], bv[32];
#pragma unroll
                for (int k = 0; k < 32; ++k) { const size_t o = (size_t)(b * LP + t + k) * 2048 + ch; av[k] = Ai[o]; bv[k] = Bi[o]; }
#pragma unroll
                for (int k = 0; k < 32; ++k) { hh = av[k] * hh + bv[k]; ap *= av[k]; } }
        } else {
            for (int t = t0; t < t1; t += 16) { float av[16], bv[16];
#pragma unroll
                for (int k = 0; k < 16; ++k) { const size_t o = (size_t)(b * LP + t + k) * 2048 + ch; av[k] = Ai[o]; bv[k] = Bi[o]; }
#pragma unroll
                for (int k = 0; k < 16; ++k) { hh = av[k] * hh + bv[k]; ap *= av[k]; } }
        }
        GA[idx] = ap; GH[idx] = hh;
    }
}

constexpr int NCH = 33;
constexpr size_t WS_S = 260 * MiB;
constexpr size_t WS_DC = 506 * MiB + 512 * 1024;
__device__ __forceinline__ float dpp_add_(float v, float src_shifted_default0, int) { return v + src_shifted_default0; }
#define SCAN_DPP_STEP(v, ctrl, rmask) do { const int t_ = __builtin_amdgcn_update_dpp(0, __builtin_bit_cast(int, v), ctrl, rmask, 0xf, false); v += __builtin_bit_cast(float, t_); } while (0)
__device__ __forceinline__ float wave_scan_incl(float v, int lane) {
    (void)lane;
    SCAN_DPP_STEP(v, 0x111, 0xf); SCAN_DPP_STEP(v, 0x112, 0xf); SCAN_DPP_STEP(v, 0x114, 0xf); SCAN_DPP_STEP(v, 0x118, 0xf);
    SCAN_DPP_STEP(v, 0x142, 0xa); SCAN_DPP_STEP(v, 0x143, 0xc);
    return v;
}
__device__ __forceinline__ void ssdA_unit(const Ctx& F, int b, int c, int g) {
    const float* DT = (const float*)(F.ws + WS_DT); const bf16* XS = (const bf16*)(F.ws + WS_XS); const float* BC = (const float*)(F.ws + WS_BC);
    float* S = (float*)(F.ws + WS_S); float* DC = (float*)(F.ws + WS_DC);
    const int row0 = b * LP + 64 * c, nq = min(64, LP - 64 * c), lane = F.lane, wave = F.wave, fr = lane & 15, fq = lane >> 4;
    LAS unsigned char* BT = F.lds; LAS unsigned char* XT = F.lds + 18432;
    { const int n = F.tid & 127, jq = F.tid >> 7; unsigned w[8];
#pragma unroll
      for (int jj = 0; jj < 8; ++jj) { const int j0 = 16 * jq + 2 * jj;
          const float v0 = j0 < nq ? BC[(size_t)(row0 + j0) * 1024 + g * 128 + n] : 0.f, v1 = (j0 + 1) < nq ? BC[(size_t)(row0 + j0 + 1) * 1024 + g * 128 + n] : 0.f; w[jj] = pk2(v0, v1); }
      *(LAS v4u*)(BT + n * 144 + jq * 32) = (v4u){w[0], w[1], w[2], w[3]}; *(LAS v4u*)(BT + n * 144 + jq * 32 + 16) = (v4u){w[4], w[5], w[6], w[7]}; }
    float dt_n = lane < nq ? DT[(size_t)(row0 + lane) * NH + 8 * g] : 0.f; unsigned xr_n[8];
#pragma unroll
    for (int jj = 0; jj < 8; ++jj) { const int j0 = 8 * wave + jj; xr_n[jj] = j0 < nq ? (unsigned)XS[(size_t)(row0 + j0) * 2048 + (8 * g) * 64 + lane] : 0u; }
#pragma unroll 1
    for (int hh = 0; hh < 8; ++hh) {
        const int head = 8 * g + hh; const float Ah = -expf(F.a_log[head]);
        const float dtj = dt_n; unsigned xr[8];
#pragma unroll
        for (int jj = 0; jj < 8; ++jj) xr[jj] = xr_n[jj];
        if (hh < 7) { dt_n = lane < nq ? DT[(size_t)(row0 + lane) * NH + head + 1] : 0.f;
#pragma unroll
            for (int jj = 0; jj < 8; ++jj) { const int j0 = 8 * wave + jj; xr_n[jj] = j0 < nq ? (unsigned)XS[(size_t)(row0 + j0) * 2048 + (head + 1) * 64 + lane] : 0u; } }
        const float acum = wave_scan_incl(dtj * Ah, lane), aend = __shfl(acum, 63), wj = __expf(aend - acum) * dtj;
        LAS unsigned char* XTb = XT + (hh & 1) * 9216;
        { unsigned w[4];
#pragma unroll
          for (int jj = 0; jj < 4; ++jj) { const int j0 = 8 * wave + 2 * jj;
              w[jj] = pk2(bflo(xr[2 * jj]) * __shfl(wj, j0), bflo(xr[2 * jj + 1]) * __shfl(wj, j0 + 1)); }
          *(LAS v4u*)(XTb + lane * 144 + wave * 16) = (v4u){w[0], w[1], w[2], w[3]}; }
        __syncthreads();
        f32x4 acc[4];
#pragma unroll
        for (int pb = 0; pb < 4; ++pb) acc[pb] = (f32x4){0.f, 0.f, 0.f, 0.f};
#pragma unroll
        for (int ks = 0; ks < 2; ++ks) { const bf16x8 wf = *(const LAS bf16x8*)(BT + (16 * wave + fr) * 144 + (32 * ks + 8 * fq) * 2);
#pragma unroll
            for (int pb = 0; pb < 4; ++pb) { const bf16x8 af = *(const LAS bf16x8*)(XTb + (16 * pb + fr) * 144 + (32 * ks + 8 * fq) * 2); acc[pb] = __builtin_amdgcn_mfma_f32_16x16x32_bf16(wf, af, acc[pb], 0, 0, 0); } }
        float* Sp = S + ((((size_t)b * NCH + c) * NH + head) * 64) * 128;
#pragma unroll
        for (int pb = 0; pb < 4; ++pb) *(f32x4*)(Sp + (size_t)(16 * pb + fr) * 128 + 16 * wave + 4 * fq) = acc[pb];
        if (F.tid == 0) DC[(b * NCH + c) * NH + head] = __expf(aend);
    }
    __syncthreads();
}
__device__ __forceinline__ void phase_ssdA(const Ctx& F) { for (int u = F.blk; u < NB * NCH * 4; u += F.G) { const int g = u & 3, bc = u >> 2; ssdA_unit(F, bc / NCH, bc % NCH, g); } }
__device__ __forceinline__ void phase_ssdB(const Ctx& F) {
    float* S = (float*)(F.ws + WS_S); const float* DC = (const float*)(F.ws + WS_DC);
    for (int idx = F.blk * NTHR + F.tid; idx < NB * NH * 64 * 32; idx += F.G * NTHR) {
        const int e4 = idx & 2047, head = (idx >> 11) & 31, b = idx >> 16;
        f32x4 H = {0.f, 0.f, 0.f, 0.f};
        float* sp = S + ((size_t)b * NCH * NH + head) * 8192 + 4 * e4; const float* dp = DC + b * NCH * NH + head;
        f32x4 v0 = *(const f32x4*)sp, v1 = *(const f32x4*)(sp + (size_t)NH * 8192);
        for (int c = 0; c < NCH; ++c) { const f32x4 v2 = (c + 2 < NCH) ? *(const f32x4*)(sp + (size_t)(c + 2) * NH * 8192) : (f32x4){0.f, 0.f, 0.f, 0.f}; const float d = dp[c * NH];
            *(f32x4*)(sp + (size_t)c * NH * 8192) = H; H = H * d + v0; v0 = v1; v1 = v2; }
        *(f32x4*)(F.out + O_PSSD + ((size_t)b * NH + head) * 8192 + 4 * e4) = H;
    }
}
__device__ __forceinline__ void ssdC_unit(const Ctx& F, int b, int c, int g) {
    const float* DT = (const float*)(F.ws + WS_DT); const bf16* XS = (const bf16*)(F.ws + WS_XS); const float* BC = (const float*)(F.ws + WS_BC); const bf16* PZ = (const bf16*)(F.ws + WS_PZ);
    const float* S = (const float*)(F.ws + WS_S); bf16* MIX = (bf16*)(F.ws + WS_MIX);
    const int row0 = b * LP + 64 * c, nq = min(64, LP - 64 * c), lane = F.lane, wave = F.wave, fr = lane & 15, fq = lane >> 4;
    LAS unsigned char* Cs = F.lds; LAS unsigned char* Bs = F.lds + 17408; LAS unsigned char* HB = F.lds + 34816;
    { const int r = F.tid >> 3, n0 = (F.tid & 7) * 16; const bool ok = r < nq; const float* src = BC + (size_t)(row0 + r) * 1024 + g * 128 + n0;
#pragma unroll
      for (int m = 0; m < 2; ++m) {
          f32x4 v[4];
#pragma unroll
          for (int q = 0; q < 4; ++q) v[q] = ok ? *(const f32x4*)(src + m * 512 + 4 * q) : (f32x4){0.f, 0.f, 0.f, 0.f};
          LAS unsigned char* d = (m ? Cs : Bs) + r * 272 + n0 * 2;
          *(LAS v4u*)d = (v4u){pk2(v[0].x, v[0].y), pk2(v[0].z, v[0].w), pk2(v[1].x, v[1].y), pk2(v[1].z, v[1].w)};
          *(LAS v4u*)(d + 16) = (v4u){pk2(v[2].x, v[2].y), pk2(v[2].z, v[2].w), pk2(v[3].x, v[3].y), pk2(v[3].z, v[3].w)}; } }
    __syncthreads();
    const int ib = wave >> 1, tb0 = 2 * (wave & 1);
    f32x4 cb[2] = {{0.f, 0.f, 0.f, 0.f}, {0.f, 0.f, 0.f, 0.f}};
#pragma unroll
    for (int ks = 0; ks < 4; ++ks) { const bf16x8 af = *(const LAS bf16x8*)(Cs + (16 * ib + fr) * 272 + (32 * ks + 8 * fq) * 2);
#pragma unroll
        for (int t = 0; t < 2; ++t) { const bf16x8 wf = *(const LAS bf16x8*)(Bs + (16 * (tb0 + t) + fr) * 272 + (32 * ks + 8 * fq) * 2); cb[t] = __builtin_amdgcn_mfma_f32_16x16x32_bf16(wf, af, cb[t], 0, 0, 0); } }
    const int irow = 16 * ib + fr;
    const int hp_ = F.tid >> 3, hn0 = (F.tid & 7) * 16;
    float dt_n = lane < nq ? DT[(size_t)(row0 + lane) * NH + 8 * g] : 0.f; unsigned xr_n[8]; f32x4 hv_n[4];
#pragma unroll
    for (int jj = 0; jj < 8; ++jj) { const int j0 = 8 * wave + jj; xr_n[jj] = j0 < nq ? (unsigned)XS[(size_t)(row0 + j0) * 2048 + (8 * g) * 64 + lane] : 0u; }
    { const float* hp = S + ((((size_t)b * NCH + c) * NH + 8 * g) * 64 + hp_) * 128 + hn0;
#pragma unroll
      for (int q = 0; q < 4; ++q) hv_n[q] = *(const f32x4*)(hp + 4 * q); }
#pragma unroll 1
    for (int hh = 0; hh < 8; ++hh) {
        const int head = 8 * g + hh; const float Ah = -expf(F.a_log[head]), Dh = F.d_skip[head];
        const float dtj = dt_n; unsigned xr[8]; f32x4 v[4];
#pragma unroll
        for (int jj = 0; jj < 8; ++jj) xr[jj] = xr_n[jj];
#pragma unroll
        for (int q = 0; q < 4; ++q) v[q] = hv_n[q];
        if (hh < 7) { dt_n = lane < nq ? DT[(size_t)(row0 + lane) * NH + head + 1] : 0.f;
#pragma unroll
            for (int jj = 0; jj < 8; ++jj) { const int j0 = 8 * wave + jj; xr_n[jj] = j0 < nq ? (unsigned)XS[(size_t)(row0 + j0) * 2048 + (head + 1) * 64 + lane] : 0u; }
            const float* hp = S + ((((size_t)b * NCH + c) * NH + head + 1) * 64 + hp_) * 128 + hn0;
#pragma unroll
            for (int q = 0; q < 4; ++q) hv_n[q] = *(const f32x4*)(hp + 4 * q); }
        v2u xw[2] = {{0u, 0u}, {0u, 0u}}, zw[2] = {{0u, 0u}, {0u, 0u}};
        if (irow < nq) {
#pragma unroll
            for (int t = 0; t < 2; ++t) { const size_t o = (size_t)(row0 + irow) * 2048 + head * 64 + 16 * (tb0 + t) + 4 * fq; xw[t] = *(const v2u*)(XS + o); zw[t] = *(const v2u*)(PZ + o); } }
        const float acum = wave_scan_incl(dtj * Ah, lane);
        LAS unsigned char* Ms = HB + (hh & 1) * 35840; LAS unsigned char* XT = Ms + 9216; LAS unsigned char* Hs = Ms + 18432;
        const float mi = __shfl(acum, irow);
#pragma unroll
        for (int t = 0; t < 2; ++t) { float mv[4];
#pragma unroll
            for (int e = 0; e < 4; ++e) { const int j = 16 * (tb0 + t) + 4 * fq + e; const float aj = __shfl(acum, j), dj = __shfl(dtj, j);
                mv[e] = (j <= irow) ? cb[t][e] * __expf(fminf(mi - aj, 0.f)) * dj : 0.f; }
            *(LAS v2u*)(Ms + irow * 144 + (16 * (tb0 + t) + 4 * fq) * 2) = (v2u){pk2(mv[0], mv[1]), pk2(mv[2], mv[3])}; }
        *(LAS v4u*)(XT + lane * 144 + wave * 16) = (v4u){xr[0] | (xr[1] << 16), xr[2] | (xr[3] << 16), xr[4] | (xr[5] << 16), xr[6] | (xr[7] << 16)};
        { LAS unsigned char* d = Hs + hp_ * 272 + hn0 * 2;
          *(LAS v4u*)d = (v4u){pk2(v[0].x, v[0].y), pk2(v[0].z, v[0].w), pk2(v[1].x, v[1].y), pk2(v[1].z, v[1].w)};
          *(LAS v4u*)(d + 16) = (v4u){pk2(v[2].x, v[2].y), pk2(v[2].z, v[2].w), pk2(v[3].x, v[3].y), pk2(v[3].z, v[3].w)}; }
        __syncthreads();
        f32x4 acc[2] = {{0.f, 0.f, 0.f, 0.f}, {0.f, 0.f, 0.f, 0.f}};
#pragma unroll
        for (int ks = 0; ks < 4; ++ks) { const bf16x8 af = *(const LAS bf16x8*)(Cs + irow * 272 + (32 * ks + 8 * fq) * 2);
#pragma unroll
            for (int t = 0; t < 2; ++t) { const bf16x8 wf = *(const LAS bf16x8*)(Hs + (16 * (tb0 + t) + fr) * 272 + (32 * ks + 8 * fq) * 2); acc[t] = __builtin_amdgcn_mfma_f32_16x16x32_bf16(wf, af, acc[t], 0, 0, 0); } }
        const float ei = __expf(mi);
#pragma unroll
        for (int t = 0; t < 2; ++t) acc[t] = acc[t] * ei;
#pragma unroll
        for (int ks = 0; ks < 2; ++ks) { const bf16x8 af = *(const LAS bf16x8*)(Ms + irow * 144 + (32 * ks + 8 * fq) * 2);
#pragma unroll
            for (int t = 0; t < 2; ++t) { const bf16x8 wf = *(const LAS bf16x8*)(XT + (16 * (tb0 + t) + fr) * 144 + (32 * ks + 8 * fq) * 2); acc[t] = __builtin_amdgcn_mfma_f32_16x16x32_bf16(wf, af, acc[t], 0, 0, 0); } }
        if (irow < nq) {
#pragma unroll
            for (int t = 0; t < 2; ++t) {
                const float y0 = (acc[t][0] + Dh * bflo(xw[t].x)) * siluf_(bflo(zw[t].x)), y1 = (acc[t][1] + Dh * bfhi(xw[t].x)) * siluf_(bfhi(zw[t].x));
                const float y2 = (acc[t][2] + Dh * bflo(xw[t].y)) * siluf_(bflo(zw[t].y)), y3 = (acc[t][3] + Dh * bfhi(xw[t].y)) * siluf_(bfhi(zw[t].y));
                *(v2u*)(MIX + (size_t)(row0 + irow) * 4096 + 2048 + head * 64 + 16 * (tb0 + t) + 4 * fq) = (v2u){pk2(y0, y1), pk2(y2, y3)}; }
        }
    }
    __syncthreads();
}
__device__ __forceinline__ void phase_ssdC(const Ctx& F) { for (int u = F.blk; u < NB * NCH * 4; u += F.G) { const int g = u & 3, bc = u >> 2; ssdC_unit(F, bc / NCH, bc % NCH, g); } }


#define SEQ_LOAD(cn) do { const int row0n = b * LP + 64 * (cn), nqn = min(64, LP - 64 * (cn)), lastn = nqn - 1;   \
        { const float d_ = DT[(size_t)(row0n + min(lane, lastn)) * NH + head]; pdt = lane < nqn ? d_ : 0.f; } \
        _Pragma("unroll") for (int jj = 0; jj < 8; ++jj) px[jj] = (unsigned)XS[(size_t)(row0n + min(8 * wave + jj, lastn)) * 2048 + head * 64 + lane]; \
        { const bf16* src = BC + (size_t)(row0n + min(sr, lastn)) * 1024 + g * 128 + sn0; \
          pB[0] = *(const v4u*)src; pB[1] = *(const v4u*)(src + 8); pC[0] = *(const v4u*)(src + 512); pC[1] = *(const v4u*)(src + 520); } \
        _Pragma("unroll") for (int t = 0; t < 2; ++t) { const size_t o = (size_t)(row0n + min(irow, lastn)) * 2048 + head * 64 + 16 * (tb0 + t) + 4 * fq; pxw[t] = *(const v2u*)(XS + o); pzw[t] = *(const v2u*)(PZ + o); } \
    } while (0)
#define SEQ_LOAD_FULL(cn) do { const int row0n = b * LP + 64 * (cn); \
        pdt = DT[(size_t)(row0n + lane) * NH + head]; \
        _Pragma("unroll") for (int jj = 0; jj < 8; ++jj) px[jj] = (unsigned)XS[(size_t)(row0n + 8 * wave + jj) * 2048 + head * 64 + lane]; \
        { const float* src = BC + (size_t)(row0n + sr) * 1024 + g * 128 + sn0; \
          _Pragma("unroll") for (int q = 0; q < 4; ++q) { pB[q] = *(const f32x4*)(src + 4 * q); pC[q] = *(const f32x4*)(src + 512 + 4 * q); } } \
        _Pragma("unroll") for (int t = 0; t < 2; ++t) { const size_t o = (size_t)(row0n + irow) * 2048 + head * 64 + 16 * (tb0 + t) + 4 * fq; pxw[t] = *(const v2u*)(XS + o); pzw[t] = *(const v2u*)(PZ + o); } \
    } while (0)
__device__ __forceinline__ void ssd_seq_unit(const Ctx& F, int b, int head) {
    const float* DT = (const float*)(F.ws + WS_DT); const bf16* XS = (const bf16*)(F.ws + WS_XS); const bf16* BC = (const bf16*)(F.ws + WS_BC); const bf16* PZ = (const bf16*)(F.ws + WS_PZ);
    bf16* MIX = (bf16*)(F.ws + WS_MIX);
    const int g = head >> 3, lane = F.lane, wave = F.wave, fr = lane & 15, fq = lane >> 4, ib = wave >> 1, tb0 = 2 * (wave & 1), irow = 16 * ib + fr;
    const int sr = F.tid >> 3, sn0 = (F.tid & 7) * 16;
    const float Ah = -expf(F.a_log[head]), Dh = F.d_skip[head];
    LAS unsigned char* Hs = F.lds + 106496; LAS unsigned char* Ms = F.lds + 123904;
    LAS float* tabA = (LAS float*)(F.lds + 133120); LAS float* tabD = (LAS float*)(F.lds + 133376);
    f32x4 Hacc[4];
#pragma unroll
    for (int pb = 0; pb < 4; ++pb) Hacc[pb] = (f32x4){0.f, 0.f, 0.f, 0.f};
    v4u pB[2], pC[2]; unsigned px[8]; float pdt; v2u pxw[2], pzw[2];
    SEQ_LOAD(0);
#pragma unroll 1
    for (int c = 0; c < NCH; ++c) {
        const int row0 = b * LP + 64 * c, nq = min(64, LP - 64 * c);
        LAS unsigned char* Cs = F.lds + (c & 1) * 53248; LAS unsigned char* Bs = Cs + 17408; LAS unsigned char* XT1 = Cs + 34816; LAS unsigned char* XT2 = Cs + 44032;
        const float dtj = pdt; const float acum = wave_scan_incl(dtj * Ah, lane), aend = __builtin_bit_cast(float, __builtin_amdgcn_readlane(__builtin_bit_cast(int, acum), 63)), wj = __expf(aend - acum) * dtj;
        if (wave == 0) { tabA[lane] = acum; tabD[lane] = dtj; }
        { LAS unsigned char* d = Bs + sr * 272 + sn0 * 2; *(LAS v4u*)d = pB[0]; *(LAS v4u*)(d + 16) = pB[1];
          d = Cs + sr * 272 + sn0 * 2; *(LAS v4u*)d = pC[0]; *(LAS v4u*)(d + 16) = pC[1]; }
        *(LAS v4u*)(XT1 + lane * 144 + wave * 16) = (v4u){px[0] | (px[1] << 16), px[2] | (px[3] << 16), px[4] | (px[5] << 16), px[6] | (px[7] << 16)};
        { unsigned w[4];
#pragma unroll
          for (int jj = 0; jj < 4; ++jj) { const int j0 = 8 * wave + 2 * jj; w[jj] = pk2(bflo(px[2 * jj]) * __builtin_bit_cast(float, __builtin_amdgcn_readlane(__builtin_bit_cast(int, wj), j0)), bflo(px[2 * jj + 1]) * __builtin_bit_cast(float, __builtin_amdgcn_readlane(__builtin_bit_cast(int, wj), j0 + 1))); }
          *(LAS v4u*)(XT2 + lane * 144 + wave * 16) = (v4u){w[0], w[1], w[2], w[3]}; }
        v2u xw[2], zw[2];
#pragma unroll
        for (int t = 0; t < 2; ++t) { xw[t] = pxw[t]; zw[t] = pzw[t]; }
        SEQ_LOAD(min(c + 1, NCH - 1));
        asm volatile("s_waitcnt lgkmcnt(0)" ::: "memory"); __builtin_amdgcn_s_barrier(); asm volatile("" ::: "memory");
        f32x4 cb[2] = {{0.f, 0.f, 0.f, 0.f}, {0.f, 0.f, 0.f, 0.f}}; bf16x8 afr[4];
#pragma unroll
        for (int ks = 0; ks < 4; ++ks) { afr[ks] = *(const LAS bf16x8*)(Cs + irow * 272 + (32 * ks + 8 * fq) * 2);
#pragma unroll
            for (int t = 0; t < 2; ++t) { const bf16x8 wf = *(const LAS bf16x8*)(Bs + (16 * (tb0 + t) + fr) * 272 + (32 * ks + 8 * fq) * 2); cb[t] = __builtin_amdgcn_mfma_f32_16x16x32_bf16(wf, afr[ks], cb[t], 0, 0, 0); } }
        const float mi = tabA[irow];
#pragma unroll
        for (int t = 0; t < 2; ++t) { float mv[4];
            const f32x4 aj4 = *(const LAS f32x4*)(tabA + 16 * (tb0 + t) + 4 * fq), dj4 = *(const LAS f32x4*)(tabD + 16 * (tb0 + t) + 4 * fq);
#pragma unroll
            for (int e = 0; e < 4; ++e) { const int j = 16 * (tb0 + t) + 4 * fq + e;
                mv[e] = (j <= irow) ? cb[t][e] * __expf(fminf(mi - aj4[e], 0.f)) * dj4[e] : 0.f; }
            *(LAS v2u*)(Ms + irow * 144 + (16 * (tb0 + t) + 4 * fq) * 2) = (v2u){pk2(mv[0], mv[1]), pk2(mv[2], mv[3])}; }
#pragma unroll
        for (int pb = 0; pb < 4; ++pb) *(LAS v2u*)(Hs + (16 * pb + fr) * 272 + (16 * wave + 4 * fq) * 2) = (v2u){pk2(Hacc[pb][0], Hacc[pb][1]), pk2(Hacc[pb][2], Hacc[pb][3])};
        asm volatile("s_waitcnt lgkmcnt(0)" ::: "memory"); __builtin_amdgcn_s_barrier(); asm volatile("" ::: "memory");
        f32x4 acc[2] = {{0.f, 0.f, 0.f, 0.f}, {0.f, 0.f, 0.f, 0.f}};
#pragma unroll
        for (int ks = 0; ks < 4; ++ks) {
#pragma unroll
            for (int t = 0; t < 2; ++t) { const bf16x8 wf = *(const LAS bf16x8*)(Hs + (16 * (tb0 + t) + fr) * 272 + (32 * ks + 8 * fq) * 2); acc[t] = __builtin_amdgcn_mfma_f32_16x16x32_bf16(wf, afr[ks], acc[t], 0, 0, 0); } }
        const float ei = __expf(mi);
#pragma unroll
        for (int t = 0; t < 2; ++t) acc[t] = acc[t] * ei;
#pragma unroll
        for (int ks = 0; ks < 2; ++ks) { const bf16x8 af = *(const LAS bf16x8*)(Ms + irow * 144 + (32 * ks + 8 * fq) * 2);
#pragma unroll
            for (int t = 0; t < 2; ++t) { const bf16x8 wf = *(const LAS bf16x8*)(XT1 + (16 * (tb0 + t) + fr) * 144 + (32 * ks + 8 * fq) * 2); acc[t] = __builtin_amdgcn_mfma_f32_16x16x32_bf16(wf, af, acc[t], 0, 0, 0); } }
        if (irow < nq) {
#pragma unroll
            for (int t = 0; t < 2; ++t) {
                const float y0 = (acc[t][0] + Dh * bflo(xw[t].x)) * siluf_(bflo(zw[t].x)), y1 = (acc[t][1] + Dh * bfhi(xw[t].x)) * siluf_(bfhi(zw[t].x));
                const float y2 = (acc[t][2] + Dh * bflo(xw[t].y)) * siluf_(bflo(zw[t].y)), y3 = (acc[t][3] + Dh * bfhi(xw[t].y)) * siluf_(bfhi(zw[t].y));
                *(v2u*)(MIX + (size_t)(row0 + irow) * 4096 + 2048 + head * 64 + 16 * (tb0 + t) + 4 * fq) = (v2u){pk2(y0, y1), pk2(y2, y3)}; }
        }
        const float dec = __expf(aend);
#pragma unroll
        for (int pb = 0; pb < 4; ++pb) Hacc[pb] = Hacc[pb] * dec;
#pragma unroll
        for (int ks = 0; ks < 2; ++ks) {
            unsigned wv[4];
#pragma unroll
            for (int jj = 0; jj < 4; ++jj) { const LAS unsigned char* q = Bs + (32 * ks + 8 * fq + 2 * jj) * 272 + (16 * wave + fr) * 2;
                wv[jj] = (unsigned)*(const LAS unsigned short*)q | ((unsigned)*(const LAS unsigned short*)(q + 272) << 16); }
            const bf16x8 wf = __builtin_bit_cast(bf16x8, (v4u){wv[0], wv[1], wv[2], wv[3]});
#pragma unroll
            for (int pb = 0; pb < 4; ++pb) { const bf16x8 af = *(const LAS bf16x8*)(XT2 + (16 * pb + fr) * 144 + (32 * ks + 8 * fq) * 2); Hacc[pb] = __builtin_amdgcn_mfma_f32_16x16x32_bf16(wf, af, Hacc[pb], 0, 0, 0); }
        }
    }
    float* op = F.out + O_PSSD + ((size_t)b * NH + head) * 8192;
#pragma unroll
    for (int pb = 0; pb < 4; ++pb) *(f32x4*)(op + (size_t)(16 * pb + fr) * 128 + 16 * wave + 4 * fq) = Hacc[pb];
    __syncthreads();
}

__device__ __forceinline__ void phase_scan1(const Ctx& F) {
    constexpr int NPU = NB * NH;
    if (F.G >= 2 * NPU) {
        if (F.blk < NPU) { const int v_ = (F.blk & 7) * (NPU / 8) + (F.blk >> 3);
            ssd_seq_unit(F, v_ >> 5, v_ & 31);
        } else { ssd_sample_blk(F, F.blk - NPU, F.G - NPU);
#ifdef PROBE_S2
            ssd_sample_blk(F, F.blk - NPU, F.G - NPU);
#endif
            lru_aggregate(F, F.blk - NPU, F.G - NPU); }
    } else {
        for (int u = F.blk; u < NPU; u += F.G) ssd_seq_unit(F, u >> 5, u & 31);
        ssd_sample_blk(F, F.blk, F.G); lru_aggregate(F, F.blk, F.G);
    }
}

__device__ __forceinline__ void phase_scan2(const Ctx& F) {
    const float* Ai = (const float*)(F.ws + WS_A); const float* Bi = (const float*)(F.ws + WS_BT); const float* GA = (const float*)(F.ws + WS_AGGA); const float* GH = (const float*)(F.ws + WS_AGGH);
    const bf16* PG = (const bf16*)(F.ws + WS_PG); bf16* MIX = (bf16*)(F.ws + WS_MIX);
    constexpr int NPI = NB * NSEG * 2048, NSI = DB * 2048;
    for (int idx = F.blk * NTHR + F.tid; idx < NPI + NSI; idx += F.G * NTHR) {
        if (idx < NPI) {
            const int ch = idx & 2047, sg = (idx >> 11) % NSEG, b = idx / (2048 * NSEG);
            float hh = 0.f;
            for (int s2 = 0; s2 < sg; s2 += 8) { float ga[8], gh[8];
#pragma unroll
                for (int k = 0; k < 8; ++k) { const int sk = (s2 + k < sg) ? s2 + k : 0; const int o = (b * NSEG + sk) * 2048 + ch; ga[k] = GA[o]; gh[k] = GH[o]; }
#pragma unroll
                for (int k = 0; k < 8; ++k) if (s2 + k < sg) hh = ga[k] * hh + gh[k]; }
            const int t0 = sg * 64, t1 = min(t0 + 64, LP);
            if (t1 - t0 == 64) {
                for (int t = t0; t < t1; t += 32) { float av[32], bv[32]; bf16 gv[32];
#pragma unroll
                    for (int k = 0; k < 32; ++k) { const size_t o = (size_t)(b * LP + t + k) * 2048 + ch; av[k] = Ai[o]; bv[k] = Bi[o]; gv[k] = PG[o]; }
#pragma unroll
                    for (int k = 0; k < 32; ++k) { hh = av[k] * hh + bv[k]; MIX[(size_t)(b * LP + t + k) * 4096 + ch] = (bf16)f2bf(hh * gelu_tanh(bf1(gv[k]))); } }
            } else {
                for (int t = t0; t < t1; t += 16) { float av[16], bv[16]; bf16 gv[16];
#pragma unroll
                    for (int k = 0; k < 16; ++k) { const size_t o = (size_t)(b * LP + t + k) * 2048 + ch; av[k] = Ai[o]; bv[k] = Bi[o]; gv[k] = PG[o]; }
#pragma unroll
                    for (int k = 0; k < 16; ++k) { hh = av[k] * hh + bv[k]; MIX[(size_t)(b * LP + t + k) * 4096 + ch] = (bf16)f2bf(hh * gelu_tanh(bf1(gv[k]))); } }
            }
            if (sg == NSEG - 1) F.out[O_PLH + (size_t)b * 2048 + ch] = hh;
        } else {
            const int i2 = idx - NPI, ch = i2 & 2047, s = i2 >> 11; float hh = 0.f;
#pragma unroll
            for (int j = 0; j < 4; ++j) { const size_t r = (size_t)(MP + 4 * s + j); const size_t o = r * 2048 + ch; hh = Ai[o] * hh + Bi[o];
                MIX[r * 4096 + ch] = (bf16)f2bf(hh * gelu_tanh(bf1(PG[o]))); }
            F.out[O_SLH + (size_t)s * 2048 + ch] = hh;
        }
    }
}

__device__ __forceinline__ void phase_mixnorm(const Ctx& F, bool dry = false) {
    const int gw = F.blk * NWAVES + F.wave, NGW = F.G * NWAVES; bf16* MIX = (bf16*)(F.ws + WS_MIX); bf16* DST = dry ? (bf16*)(F.ws + WS_PART) : MIX;
    for (int m = gw; m < MR; m += NGW) {
        bf16* rowp = MIX + (size_t)m * 4096 + 8 * F.lane; bf16* dstp = DST + (size_t)m * 4096 + 8 * F.lane; v4u w[8]; float ss[8];
#pragma unroll
        for (int j = 0; j < 8; ++j) { w[j] = *(const v4u*)(rowp + 512 * j);
            const float a0 = bflo(w[j].x), a1 = bfhi(w[j].x), a2 = bflo(w[j].y), a3 = bfhi(w[j].y), a4 = bflo(w[j].z), a5 = bfhi(w[j].z), a6 = bflo(w[j].w), a7 = bfhi(w[j].w);
            ss[j] = (a0 * a0 + a1 * a1) + (a2 * a2 + a3 * a3) + (a4 * a4 + a5 * a5) + (a6 * a6 + a7 * a7); }
        const float sl = wave_sum((ss[0] + ss[1]) + (ss[2] + ss[3])); const float rl = rsqrtf(sl * (1.f / 2048) + EPS);
#pragma unroll
        for (int j = 0; j < 8; ++j) {
            float rs = rl; if (j >= 4) rs = rsqrtf(wave_sum(ss[j]) * (1.f / 512) + EPS);
            const float* gp = (j < 4 ? F.g_lru_out + 512 * j : F.g_ssd_out + 512 * (j - 4)) + 8 * F.lane; const f32x4 g0 = *(const f32x4*)gp, g1 = *(const f32x4*)(gp + 4);
            v4u o; o.x = pk2(bflo(w[j].x) * rs * g0.x, bfhi(w[j].x) * rs * g0.y); o.y = pk2(bflo(w[j].y) * rs * g0.z, bfhi(w[j].y) * rs * g0.w);
            o.z = pk2(bflo(w[j].z) * rs * g1.x, bfhi(w[j].z) * rs * g1.y); o.w = pk2(bflo(w[j].w) * rs * g1.z, bfhi(w[j].w) * rs * g1.w);
            *(v4u*)(dstp + 512 * j) = o; }
    }
}


__device__ __forceinline__ f32x4 gemm_out4(const Ctx& F, int m, int j, int nfull, int P, bool& has_res) {
    const int T = (m >> 8) * 8 + j;
    if (T < nfull || P == 1) { has_res = true; return *(const f32x4*)((const float*)(F.ws + WS_PART) + (size_t)m * DM + 4 * F.lane + 256 * j); }
    has_res = false;
    const float* r = (const float*)(F.ws + WS_R2) + (size_t)(T - nfull) * P * 65536 + (size_t)(m & 255) * 256 + 4 * F.lane;
    f32x4 v = *(const f32x4*)r;
    for (int k = 1; k < P; ++k) v += *(const f32x4*)(r + (size_t)k * 65536);
    return v;
}
__device__ __forceinline__ void phase_resid1(const Ctx& F) {
    const int gw = F.blk * NWAVES + F.wave, NGW = F.G * NWAVES; float* X1 = (float*)(F.ws + WS_PART); bf16* HP = (bf16*)(F.ws + WS_HP);
    int nfull, P; pg8::split_params(35 * 8, F.G, 4096 / 64, nfull, P);
    for (int m = gw; m < MR; m += NGW) {
        const float* xr = xrow_ptr(F, m); f32x4 v[8];
#pragma unroll
        for (int j = 0; j < 8; ++j) { bool hr; v[j] = gemm_out4(F, m, j, nfull, P, hr); if (!hr) { v[j] += *(const f32x4*)(xr + 4 * F.lane + 256 * j); *(f32x4*)(X1 + (size_t)m * DM + 4 * F.lane + 256 * j) = v[j]; } }
        rms_row_store(v, F.g_mlp, HP + (size_t)m * DM, F.lane);
    }
}
__device__ __forceinline__ void phase_final(const Ctx& F) {
    const int gw = F.blk * NWAVES + F.wave, NGW = F.G * NWAVES; const float* X1 = (const float*)(F.ws + WS_PART);
    int nfull, P; pg8::split_params(35 * 8, F.G, DFF / 64, nfull, P);
    for (int m = gw; m < MR; m += NGW) {
        float* orow;
        if (m < MP) { const int b = m / LP, t = m - b * LP; if (t < NMETA) continue; orow = F.out + O_YP + ((size_t)b * SEQ + (t - NMETA)) * DM; } else orow = F.out + O_YS + (size_t)(m - MP) * DM;
        f32x4 v[8]; float ss = 0.f;
#pragma unroll
        for (int j = 0; j < 8; ++j) { bool hr; v[j] = gemm_out4(F, m, j, nfull, P, hr); if (!hr) v[j] += *(const f32x4*)(X1 + (size_t)m * DM + 4 * F.lane + 256 * j); ss += (v[j].x * v[j].x + v[j].y * v[j].y) + (v[j].z * v[j].z + v[j].w * v[j].w); }
        const float rs = rsqrtf(wave_sum(ss) * (1.f / DM) + EPS);
#pragma unroll
        for (int j = 0; j < 8; ++j) { const f32x4 gg = *(const f32x4*)(F.g_final + 4 * F.lane + 256 * j); *(f32x4*)(orow + 4 * F.lane + 256 * j) = v[j] * rs * gg; }
    }
}

#define RLX_AGENT __ATOMIC_RELAXED, __HIP_MEMORY_SCOPE_AGENT
constexpr size_t WS_BAR = 4096 * 4;
#define XB_TMO      128
#define XB_XCNT(j)  (256  + 64 * (j))
#define XB_XSUB(j)  (1280 + 64 * (j))
#define XB_XGEN(j)  (2304 + 64 * (j))
#define XB_TOP      3328
#define XB_TOPGEN   3392
#define XCD_BAR_WORDS 3456
#define XB_SPIN_CAP (1u << 18)

__device__ __forceinline__ unsigned xb_ld(unsigned* p)              { return __hip_atomic_load(p, __ATOMIC_RELAXED, __HIP_MEMORY_SCOPE_AGENT); }
__device__ __forceinline__ unsigned xb_add(unsigned* p, unsigned v) { return __hip_atomic_fetch_add(p, v, __ATOMIC_RELAXED, __HIP_MEMORY_SCOPE_AGENT); }
__device__ __forceinline__ unsigned xb_xcc_id() { return (unsigned)__builtin_amdgcn_s_getreg((3 << 11) | 20) & 0xFu; }
#define XB_SPIN(cond, bar) do { unsigned _sp = 0; while (cond) { __builtin_amdgcn_s_sleep(1); \
    if ((++_sp & 255u) == 0u) { if (xb_ld(&(bar)[XB_TMO])) break; if (_sp > XB_SPIN_CAP) { atomicAdd(&(bar)[XB_TMO], 1u); break; } } } } while (0)

struct XcdBarrier {
    unsigned* bar; unsigned x;
    volatile LAS unsigned* st;
};

__device__ __forceinline__ XcdBarrier xcd_barrier_post(unsigned* bar, volatile LAS unsigned* st) {
    XcdBarrier b; b.bar = bar; b.x = xb_xcc_id(); b.st = st;
    if (threadIdx.x == 0) (void)xb_add(&bar[XB_XCNT(b.x)], 1u);
    return b;
}
__device__ __forceinline__ void xcd_barrier_complete(unsigned* bar, unsigned x, unsigned& nloc, unsigned& nx) {
    const unsigned G = gridDim.x * gridDim.y * gridDim.z;
    unsigned sum, cnt, mine, sp = 0u;
    for (;;) {
        sum = 0u; cnt = 0u; mine = 0u;
#pragma unroll
        for (unsigned j = 0; j < 16; ++j) { const unsigned c = xb_ld(&bar[XB_XCNT(j)]); sum += c; cnt += (c > 0u) ? 1u : 0u; mine = (j == x) ? c : mine; }
        if (sum == G) break;
        __builtin_amdgcn_s_sleep(1);
        if ((++sp & 255u) == 0u) { if (xb_ld(&bar[XB_TMO])) break; if (sp > XB_SPIN_CAP) { atomicAdd(&bar[XB_TMO], 1u); break; } }
    }
    nloc = mine > 0u ? mine : 1u; nx = cnt > 0u ? cnt : 1u;
}

__device__ __forceinline__ void xcd_barrier(const XcdBarrier& b) {
    asm volatile("s_waitcnt vmcnt(0)" ::: "memory");
    __syncthreads();
    if (threadIdx.x == 0) {
        unsigned* bar = b.bar;
        __builtin_amdgcn_s_waitcnt(0);
        unsigned nloc = b.st[0], nx = b.st[1];
        if (nloc == 0u) { xcd_barrier_complete(bar, b.x, nloc, nx); b.st[0] = nloc; b.st[1] = nx; }
        const unsigned old = xb_add(&bar[XB_XSUB(b.x)], 1u);
        const unsigned gen = old / nloc;
        if (old + 1u == (gen + 1u) * nloc) {
            __builtin_amdgcn_fence(__ATOMIC_RELEASE, "agent");
            asm volatile("s_waitcnt vmcnt(0)" ::: "memory");
            const unsigned og = xb_add(&bar[XB_TOP], 1u);
            const unsigned tg = og / nx;
            if (og + 1u == (tg + 1u) * nx) xb_add(&bar[XB_TOPGEN], 1u);
            else XB_SPIN(xb_ld(&bar[XB_TOPGEN]) == tg, bar);
            __builtin_amdgcn_fence(__ATOMIC_ACQUIRE, "agent");
            xb_add(&bar[XB_XGEN(b.x)], 1u);
            asm volatile("s_waitcnt vmcnt(0)" ::: "memory");
        } else {
            XB_SPIN(xb_ld(&bar[XB_XGEN(b.x)]) == gen, bar);
            __builtin_amdgcn_fence(__ATOMIC_ACQUIRE, "agent");
            asm volatile("s_waitcnt vmcnt(0)" ::: "memory");
        }
    }
    __syncthreads();
}

__global__ void __launch_bounds__(NTHR, 2) hymba_fwd(Args args) {
    extern __shared__ __attribute__((aligned(16))) unsigned char lds_raw[];
    cg::grid_group grid = cg::this_grid();
    Ctx F;
    F.xp = args.in[0]; F.xs = args.in[1]; F.st_lru_h = args.in[2]; F.st_lru_conv = args.in[3]; F.st_ssd = args.in[4]; F.st_ssd_conv = args.in[5]; F.meta = args.in[6]; F.g_mix = args.in[7];
    F.w_in = args.in[8]; F.conv_lru_w = args.in[9]; F.conv_lru_b = args.in[10]; F.lru_wa = args.in[11]; F.lru_ba = args.in[12]; F.lru_wx = args.in[13]; F.lru_bx = args.in[14]; F.lru_lam = args.in[15];
    F.g_lru_out = args.in[16]; F.conv_ssd_w = args.in[17]; F.conv_ssd_b = args.in[18]; F.dt_bias = args.in[19]; F.a_log = args.in[20]; F.d_skip = args.in[21]; F.g_ssd_out = args.in[22];
    F.w_out = args.in[23]; F.g_mlp = args.in[24]; F.w_up = args.in[25]; F.w_down = args.in[26]; F.g_final = args.in[27];
    F.out = args.out; F.ws = args.ws; F.lds = (LAS unsigned char*)lds_raw;
    F.tid = threadIdx.x; F.lane = F.tid & 63; F.wave = __builtin_amdgcn_readfirstlane(F.tid >> 6); F.blk = blockIdx.x; F.G = gridDim.x;
    const int lo = args.ph_lo, hi = args.ph_hi;
    volatile LAS unsigned* bst = (volatile LAS unsigned*)(F.lds + LDS_BYTES - 64);
    if (F.tid < 16) bst[F.tid] = 0u;
    __syncthreads();
    XcdBarrier xbar; xbar.bar = (unsigned*)(F.ws + WS_BAR); xbar.x = 0; xbar.st = bst;
    if (hi - lo > 1) xbar = xcd_barrier_post((unsigned*)(F.ws + WS_BAR), bst);
    if (hi - lo > 1) grid.sync();
#define IN(k) (lo <= (k) && (k) < hi)
#ifndef PROBE_PH
#define PROBE_PH -1
#endif
#define REPS(k) for (int rep_ = 0; rep_ < (PROBE_PH == (k) ? 2 : 1); ++rep_)
#ifndef PROBE_SYNC
#define PROBE_SYNC 1
#endif
#define SEAM(k) do { if (IN(k) && IN((k) + 1)) { for (int s_ = 0; s_ < PROBE_SYNC; ++s_) { xcd_barrier(xbar); } } } while (0)
    if (IN(0)) REPS(0) phase_prologue(F);
    SEAM(0);
    if (IN(1)) {
        {
        pg8::Gemm g{(const pg8::bf16_t*)(F.ws + WS_XN), (const pg8::bf16_t*)(F.ws + WS_WIN), MPAD, NMAIN, 2048}; pg8::StaticOrder S; S.init(MPAD, NMAIN, F.G, F.blk, 2048);
        pg8::EpiProj E{(bf16*)(F.ws + WS_PG), (bf16*)(F.ws + WS_PXL), (bf16*)(F.ws + WS_PZ), (bf16*)(F.ws + WS_PXBC)};
        pg8::gemm_phase<pg8::EpiProj, pg8::StaticOrder, PG8_ALIGN, PG8_SP2>(F.lds, g, S, E);
        phase_dt(F);
            }
        if (PROBE_PH == 1) {
        pg8::Gemm g{(const pg8::bf16_t*)(F.ws + WS_XN), (const pg8::bf16_t*)(F.ws + WS_WIN), MPAD, NMAIN, 2048}; pg8::StaticOrder S; S.init(MPAD, NMAIN, F.G, F.blk, 2048);
        pg8::EpiProj E{(bf16*)(F.ws + WS_PG), (bf16*)(F.ws + WS_PXL), (bf16*)(F.ws + WS_PZ), (bf16*)(F.ws + WS_PXBC)};
        pg8::gemm_phase<pg8::EpiProj, pg8::StaticOrder, PG8_ALIGN, PG8_SP2>(F.lds, g, S, E);
        phase_dt(F);
            }
    }
    SEAM(1);
    if (IN(2)) REPS(2) phase_conv(F);
    SEAM(2);
    if (IN(3)) REPS(3) { phase_gates(F); __syncthreads(); }
    SEAM(3);
    if (IN(4)) REPS(4) phase_scan1(F);
    SEAM(4);
    if (IN(5)) REPS(5) phase_scan2(F);
    SEAM(5);
    if (IN(6)) { if (PROBE_PH == 6) phase_mixnorm(F, true); phase_mixnorm(F); }
    SEAM(6);
    if (IN(7)) {
        {
        pg8::Gemm g{(const pg8::bf16_t*)(F.ws + WS_MIX), (const pg8::bf16_t*)(F.ws + WS_WOUT), MPAD, 2048, 4096}; pg8::SplitOrder S; S.init(MPAD, 2048, F.G, F.blk, 4096);
        pg8::EpiF32S E{(float*)(F.ws + WS_PART), 2048, (float*)(F.ws + WS_R2), S.nN, S.nfull, S.P, 2, nullptr, F.xp, F.xs, F.meta};
        pg8::gemm_phase<pg8::EpiF32S, pg8::SplitOrder, PG8_ALIGN, PG8_SP2>(F.lds, g, S, E);
            }
        if (PROBE_PH == 7) {
        pg8::Gemm g{(const pg8::bf16_t*)(F.ws + WS_MIX), (const pg8::bf16_t*)(F.ws + WS_WOUT), MPAD, 2048, 4096}; pg8::SplitOrder S; S.init(MPAD, 2048, F.G, F.blk, 4096);
        pg8::EpiF32S E{(float*)(F.ws + WS_PART), 2048, (float*)(F.ws + WS_R2), S.nN, S.nfull, S.P, 2, nullptr, F.xp, F.xs, F.meta};
        pg8::gemm_phase<pg8::EpiF32S, pg8::SplitOrder, PG8_ALIGN, PG8_SP2>(F.lds, g, S, E);
            }
    }
    SEAM(7);
    if (IN(8)) REPS(8) phase_resid1(F);
    SEAM(8);
    if (IN(9)) {
        {
        pg8::Gemm g{(const pg8::bf16_t*)(F.ws + WS_HP), (const pg8::bf16_t*)(F.ws + WS_WUP), MPAD, DFF, 2048}; pg8::StaticOrder S; S.init(MPAD, DFF, F.G, F.blk, 2048);
        pg8::EpiRelu2 E{(bf16*)(F.ws + WS_H), DFF};
        pg8::gemm_phase<pg8::EpiRelu2, pg8::StaticOrder, PG8_ALIGN, PG8_SP2>(F.lds, g, S, E);
        { int part, nparts; slack_parts(35 * 32, F.G, F.blk, part, nparts); if (part >= 0) convert_range(F, I_IN + I_OUT + I_UP, I_IN + I_OUT + I_UP + I_DN, part, nparts); }
            }
        if (PROBE_PH == 9) { __syncthreads();
        pg8::Gemm g{(const pg8::bf16_t*)(F.ws + WS_HP), (const pg8::bf16_t*)(F.ws + WS_WUP), MPAD, DFF, 2048}; pg8::StaticOrder S; S.init(MPAD, DFF, F.G, F.blk, 2048);
        pg8::EpiRelu2 E{(bf16*)(F.ws + WS_H), DFF};
        pg8::gemm_phase<pg8::EpiRelu2, pg8::StaticOrder, PG8_ALIGN, PG8_SP2>(F.lds, g, S, E);
        { int part, nparts; slack_parts(35 * 32, F.G, F.blk, part, nparts); if (part >= 0) convert_range(F, I_IN + I_OUT + I_UP, I_IN + I_OUT + I_UP + I_DN, part, nparts); }
            }
    }
    SEAM(9);
    if (IN(10)) {
        {
        pg8::Gemm g{(const pg8::bf16_t*)(F.ws + WS_H), (const pg8::bf16_t*)(F.ws + WS_WDN), MPAD, 2048, DFF}; pg8::SplitOrder S; S.init(MPAD, 2048, F.G, F.blk, DFF);
        pg8::EpiF32S E{(float*)(F.ws + WS_PART), 2048, (float*)(F.ws + WS_R2), S.nN, S.nfull, S.P, 1, (const float*)(F.ws + WS_PART), nullptr, nullptr, nullptr};
        pg8::gemm_phase<pg8::EpiF32S, pg8::SplitOrder, PG8_ALIGN, PG8_SP2>(F.lds, g, S, E);
            }
        if (PROBE_PH == 10) {
        pg8::Gemm g{(const pg8::bf16_t*)(F.ws + WS_H), (const pg8::bf16_t*)(F.ws + WS_WDN), MPAD, 2048, DFF}; pg8::SplitOrder S; S.init(MPAD, 2048, F.G, F.blk, DFF);
        pg8::EpiF32S E{(float*)(F.ws + WS_PART), 2048, (float*)(F.ws + WS_R2), S.nN, S.nfull, S.P, 1, (const float*)(F.ws + WS_PART), nullptr, nullptr, nullptr};
        pg8::gemm_phase<pg8::EpiF32S, pg8::SplitOrder, PG8_ALIGN, PG8_SP2>(F.lds, g, S, E);
            }
    }
    SEAM(10);
    if (IN(11)) REPS(11) phase_final(F);
#undef IN
#undef SEAM
}

#ifndef N_LAUNCH_MODE
#define N_LAUNCH_MODE 1
#endif
extern "C" void kernel_launch(void* const* d_in, const int* in_sizes, int n_in, void* d_out, int out_size, void* d_ws, size_t ws_size, hipStream_t stream) {
    static int grid = 0;
    if (grid == 0) {
        if (n_in != 28 || (size_t)out_size != O_END || ws_size < WS_END) { fprintf(stderr, "kernel_launch: unexpected shapes: n_in %d out %d ws %zu\n", n_in, out_size, ws_size); grid = -1; return; }
        int dev = 0, cus = 0, per_cu = 0;
        (void)hipGetDevice(&dev); (void)hipDeviceGetAttribute(&cus, hipDeviceAttributeMultiprocessorCount, dev);
        if (hipFuncSetAttribute((const void*)hymba_fwd, hipFuncAttributeMaxDynamicSharedMemorySize, LDS_BYTES) != hipSuccess) { fprintf(stderr, "kernel_launch: hipFuncSetAttribute failed\n"); grid = -1; return; }
        if (hipOccupancyMaxActiveBlocksPerMultiprocessor(&per_cu, (const void*)hymba_fwd, NTHR, LDS_BYTES) != hipSuccess || per_cu < 1) { fprintf(stderr, "kernel_launch: occupancy query says %d\n", per_cu); per_cu = 1; }
        (void)hipGetLastError();
        grid = cus * 1;
        if (grid <= 0) grid = 256;
    }
    if (grid < 0) return;
    Args a{};
    for (int i = 0; i < 28; ++i) a.in[i] = (const float*)d_in[i];
    a.out = (float*)d_out; a.ws = (unsigned char*)d_ws;
#if N_LAUNCH_MODE == 1
    (void)hipMemsetAsync((char*)d_ws + WS_BAR, 0, XCD_BAR_WORDS * 4, stream);
    a.ph_lo = 0; a.ph_hi = NPHASE;
    void* kargs[] = {&a};
    hipError_t e = hipLaunchCooperativeKernel((const void*)hymba_fwd, dim3(grid), dim3(NTHR), kargs, LDS_BYTES, stream);
    if (e != hipSuccess) fprintf(stderr, "cooperative launch failed: %s (grid %d)\n", hipGetErrorString(e), grid);
#else
    for (int p = 0; p < NPHASE; ++p) { a.ph_lo = p; a.ph_hi = p + 1; hipLaunchKernelGGL(hymba_fwd, dim3(grid), dim3(NTHR), LDS_BYTES, stream, a); }
#endif
}
```

```cpp
#include <hip/hip_runtime.h>
#include <hip/hip_cooperative_groups.h>
#include <cstdio>
#include <cstdint>
namespace cg = cooperative_groups;
namespace pg8 {
#define PG8_LAS __attribute__((address_space(3)))
typedef unsigned short bf16_t;
typedef short bf16x8 __attribute__((ext_vector_type(8)));
typedef float f32x4 __attribute__((ext_vector_type(4)));
typedef unsigned u32x4 __attribute__((ext_vector_type(4)));
constexpr int BM = 256, BK = 64, HALF = 128, HTB = HALF * BK * 2  , STAGE_BYTES = 8 * HTB, NXCD = 8, WGM = 8;

__host__ __device__ __forceinline__ int lds_byte(int r, int c) { const int st = (r >> 4) * 2 + (c >> 5), rr = r & 15, cc = c & 31, ob = rr * 64 + cc * 2; return st * 1024 + (ob ^ (((ob >> 9) & 1) << 5)); }
__host__ __device__ __forceinline__ void stage_rc(int b, int& R, int& C) { const int st = b / 1024, sb = b % 1024, swz = sb ^ (((sb >> 9) & 1) << 5); R = (st >> 1) * 16 + swz / 64; C = (st & 1) * 32 + (swz % 64) / 2; }
__host__ __device__ __forceinline__ int perm32(int rho) { const int n = rho >> 4, i = rho & 15; return 8 * (i >> 2) + 4 * n + (i & 3); }

struct Unit { int pm, pn, kt0, nt, slot; };
struct Gemm { const bf16_t* A; const bf16_t* Bt; int M, N, K; };

struct StaticOrder {
    int nM, nN, nwg, G, c, ntk;
    __host__ __device__ __forceinline__ void init(int M, int N, int G_, int c_, int K_) { nM = M / BM; nN = N / BM; nwg = nM * nN; G = G_; c = c_; ntk = K_ / BK; }
    __host__ __device__ __forceinline__ bool next(int i, Unit& u) const {
        const long L = (long)i * G + c; if (L >= nwg) return false;
        int wgid = (int)L; { const int q = nwg / NXCD, r = nwg % NXCD, xcd = wgid % NXCD, off = wgid / NXCD; wgid = (xcd < r ? xcd * (q + 1) : r * (q + 1) + (xcd - r) * q) + off; }
        const int nig = WGM * nN, gid = wgid / nig, fm = gid * WGM, gsz = (nM - fm) < WGM ? (nM - fm) : WGM;
        u.pm = fm + ((wgid % nig) % gsz); u.pn = (wgid % nig) / gsz; u.kt0 = 0; u.nt = ntk; u.slot = -1; return true;
    }
    __device__ __forceinline__ void a_ready(const Unit&) const {}
    __device__ __forceinline__ void done(const Unit&) const {}
};


__host__ __device__ __forceinline__ void split_params(int nwg, int G, int ntk, int& nfull, int& P) {
    nfull = (nwg / G) * G; const int rem = nwg - nfull; P = 1;
    if (rem > 0) { int p = G / rem; p = p >= 8 ? 8 : (p >= 4 ? 4 : (p >= 2 ? 2 : 1)); while (p > 1 && ((ntk / p) < 4 || (ntk % (2 * p)) != 0)) p >>= 1; P = p; }
}
struct SplitOrder {
    int nN, nwg, G, c, ntk, nfull, P, perm;
    __host__ __device__ __forceinline__ void init(int M, int N, int G_, int c_, int K_) { nN = N / BM; nwg = (M / BM) * nN; G = G_; c = c_; ntk = K_ / BK; split_params(nwg, G, ntk, nfull, P);
        perm = (G % NXCD == 0) ? (c % NXCD) * (G / NXCD) + c / NXCD : c; }
    __host__ __device__ __forceinline__ bool next(int i, Unit& u) const {
        const int rounds = nfull / G;
        if (i < rounds) { const int T = i * G + perm; u.pm = T / nN; u.pn = T % nN; u.kt0 = 0; u.nt = ntk; u.slot = -1; return true; }
        int j = (i - rounds) * G + c; const int rem = nwg - nfull;
        if (j >= rem * P) return false;
        const int T = nfull + j / P, pc = j % P; u.pm = T / nN; u.pn = T % nN; u.nt = ntk / P; u.kt0 = pc * u.nt; u.slot = (P > 1) ? pc : -1; return true;
    }
    __device__ __forceinline__ void a_ready(const Unit&) const {}
    __device__ __forceinline__ void done(const Unit&) const {}
};
__device__ __forceinline__ unsigned cvt_pk_bf16(float lo, float hi) { unsigned r; asm volatile("v_cvt_pk_bf16_f32 %0, %1, %2" : "=v"(r) : "v"(lo), "v"(hi)); return r; }
struct EpiF32 {
    static constexpr bool PERM = false, AFTER_DRAIN = false;
    float* C; int ldc;
    __device__ __forceinline__ void operator()(const f32x4 (&acc)[2][2][4][2], const Unit& u, int wr, int wc, int fr, int fq) const {
        const int row0 = u.pm * BM + wr * 64 + fr, col0 = u.pn * BM + wc * 32 + 4 * fq;
#pragma unroll
        for (int ai = 0; ai < 2; ++ai)
#pragma unroll
            for (int m = 0; m < 4; ++m) { float* rowp = C + (size_t)(row0 + ai * HALF + m * 16) * ldc + col0;
#pragma unroll
                for (int bj = 0; bj < 2; ++bj)
#pragma unroll
                    for (int n = 0; n < 2; ++n) *(f32x4*)(rowp + bj * HALF + n * 16) = acc[ai][bj][m][n]; }
    }
};
struct EpiProj {
    static constexpr bool PERM = true, AFTER_DRAIN = false;
    bf16_t *PG, *PXL, *PZ, *PXBC;
    __device__ __forceinline__ void operator()(const f32x4 (&acc)[2][2][4][2], const Unit& u, int wr, int wc, int fr, int fq) const {
        const int row0 = u.pm * BM + wr * 64 + fr;
        bf16_t* base; int ldc, colt;
        if (u.pn < 8) { base = PG; ldc = 2048; colt = u.pn * 256; }
        else if (u.pn < 16) { base = PXL; ldc = 2048; colt = (u.pn - 8) * 256; }
        else if (u.pn < 24) { base = PZ; ldc = 2048; colt = (u.pn - 16) * 256; }
        else { base = PXBC; ldc = 3072; colt = (u.pn - 24) * 256; }
        const int col0 = colt + wc * 32 + 8 * fq;
#pragma unroll
        for (int ai = 0; ai < 2; ++ai)
#pragma unroll
            for (int m = 0; m < 4; ++m) { bf16_t* rowp = base + (size_t)(row0 + ai * HALF + m * 16) * ldc + col0;
#pragma unroll
                for (int bj = 0; bj < 2; ++bj) { const f32x4 v0 = acc[ai][bj][m][0], v1 = acc[ai][bj][m][1];
                    u32x4 w; w.x = cvt_pk_bf16(v0[0], v0[1]); w.y = cvt_pk_bf16(v0[2], v0[3]); w.z = cvt_pk_bf16(v1[0], v1[1]); w.w = cvt_pk_bf16(v1[2], v1[3]);
                    *(u32x4*)(rowp + bj * HALF) = w; } }
    }
};
struct EpiRelu2 {
    static constexpr bool PERM = true, AFTER_DRAIN = false;
    bf16_t* O; int ldc;
    __device__ __forceinline__ void operator()(const f32x4 (&acc)[2][2][4][2], const Unit& u, int wr, int wc, int fr, int fq) const {
        const int row0 = u.pm * BM + wr * 64 + fr, col0 = u.pn * BM + wc * 32 + 8 * fq;
#pragma unroll
        for (int ai = 0; ai < 2; ++ai)
#pragma unroll
            for (int m = 0; m < 4; ++m) { bf16_t* rowp = O + (size_t)(row0 + ai * HALF + m * 16) * ldc + col0;
#pragma unroll
                for (int bj = 0; bj < 2; ++bj) { f32x4 v0 = acc[ai][bj][m][0], v1 = acc[ai][bj][m][1];
#pragma unroll
                    for (int e = 0; e < 4; ++e) { const float p = fmaxf(v0[e], 0.f), q = fmaxf(v1[e], 0.f); v0[e] = p * p; v1[e] = q * q; }
                    u32x4 w; w.x = cvt_pk_bf16(v0[0], v0[1]); w.y = cvt_pk_bf16(v0[2], v0[3]); w.z = cvt_pk_bf16(v1[0], v1[1]); w.w = cvt_pk_bf16(v1[2], v1[3]);
                    *(u32x4*)(rowp + bj * HALF) = w; } }
    }
};

struct EpiF32S {
    static constexpr bool PERM = false, AFTER_DRAIN = false;
    float* C; int ldc; float* R2; int nN, nfull, P; int mode; const float* res; const float* xp; const float* xs; const float* meta;
    __device__ __forceinline__ const float* rrow(int r) const {
        if (mode == 1) return res + (size_t)r * ldc;
        if (r >= 8768) r = 8767;
        if (r < 8256) { const int b = r / 2064, t = r - b * 2064; return t < 16 ? meta + (size_t)t * 2048 : xp + ((size_t)b * 2048 + (t - 16)) * 2048; }
        return xs + (size_t)(r - 8256) * 2048;
    }
    __device__ __forceinline__ void operator()(const f32x4 (&acc)[2][2][4][2], const Unit& u, int wr, int wc, int fr, int fq) const {
        const int r0 = wr * 64 + fr, c0 = wc * 32 + 4 * fq;
        if (u.slot < 0) {
#pragma unroll
            for (int ai = 0; ai < 2; ++ai)
#pragma unroll
                for (int m = 0; m < 4; ++m) { const int row = u.pm * BM + r0 + ai * HALF + m * 16; float* rowp = C + (size_t)row * ldc + u.pn * BM + c0; const float* rp = rrow(row) + u.pn * BM + c0;
#pragma unroll
                    for (int bj = 0; bj < 2; ++bj)
#pragma unroll
                        for (int n = 0; n < 2; ++n) *(f32x4*)(rowp + bj * HALF + n * 16) = acc[ai][bj][m][n] + *(const f32x4*)(rp + bj * HALF + n * 16);
                    if (m & 1) asm volatile("" ::: "memory"); }
        } else {
            float* base = R2 + ((size_t)((u.pm * nN + u.pn - nfull) * P + u.slot)) * 65536;
#pragma unroll
            for (int ai = 0; ai < 2; ++ai)
#pragma unroll
                for (int m = 0; m < 4; ++m) { float* rowp = base + (size_t)(r0 + ai * HALF + m * 16) * 256 + c0;
#pragma unroll
                    for (int bj = 0; bj < 2; ++bj)
#pragma unroll
                        for (int n = 0; n < 2; ++n) *(f32x4*)(rowp + bj * HALF + n * 16) = acc[ai][bj][m][n]; }
        }
    }
};
template <class Epi, class Sched, bool ALIGN_EPI = false, bool SP2 = false>
__device__ __forceinline__ void gemm_phase(PG8_LAS unsigned char* lds, const Gemm g, const Sched& S, const Epi& E) {
    const int tid = threadIdx.x, wid = __builtin_amdgcn_readfirstlane(tid >> 6), lane = tid & 63, wr = wid >> 2, wc = wid & 3, fr = lane & 15, fq = lane >> 4;
    const int K = g.K;
    unsigned voffA[2], voffB[2];
#pragma unroll
    for (int i = 0; i < 2; ++i) { int R, C; stage_rc(tid * 16 + i * 8192, R, C); const int Rb = Epi::PERM ? ((R & ~31) + perm32(R & 31)) : R;
        voffA[i] = (unsigned)(R * K + C) * 2u; voffB[i] = (unsigned)(Rb * K + C) * 2u; }
    const size_t kstep = (size_t)(BK * 2);
    const size_t hstep = (size_t)HALF * K * 2;
    const size_t tstep = 2 * hstep;
    const unsigned ldsw = (unsigned)wid * 1024u;
    const int aoff = lds_byte(wr * 64 + fr, fq * 8), boff = lds_byte(wc * 32 + fr, fq * 8);
#define PG8_SA(b, h) (((b) * 2 + (h)) * HTB)
#define PG8_SB(b, h) ((4 + (b) * 2 + (h)) * HTB)
#define PG8_STAGE(bufoff, gbase, voff) do { _Pragma("unroll") for (int _i = 0; _i < 2; ++_i) \
        __builtin_amdgcn_global_load_lds((const unsigned*)((const char*)(gbase) + (voff)[_i]), (PG8_LAS unsigned*)(lds + (bufoff) + ldsw + _i * 8192), 16, 0, 0); } while (0)
#define PG8_LDA(dst, b, h) do { _Pragma("unroll") for (int m = 0; m < 4; ++m) _Pragma("unroll") for (int k = 0; k < 2; ++k) dst[m][k] = *(const PG8_LAS bf16x8*)(lds + PG8_SA(b, h) + aoff + m * 2048 + k * 1024); } while (0)
#define PG8_LDB(dst, b, h) do { _Pragma("unroll") for (int n = 0; n < 2; ++n) _Pragma("unroll") for (int k = 0; k < 2; ++k) dst[n][k] = *(const PG8_LAS bf16x8*)(lds + PG8_SB(b, h) + boff + n * 2048 + k * 1024); } while (0)
#define PG8_MMA(ai, bj, At, Bt) do { __builtin_amdgcn_s_setprio(1); _Pragma("unroll") for (int m = 0; m < 4; ++m) _Pragma("unroll") for (int n = 0; n < 2; ++n) _Pragma("unroll") for (int k = 0; k < 2; ++k) \
        acc[ai][bj][m][n] = __builtin_amdgcn_mfma_f32_16x16x32_bf16(Bt[n][k], At[m][k], acc[ai][bj][m][n], 0, 0, 0); __builtin_amdgcn_s_setprio(0); } while (0)
#define PG8_WAIT_V(n) asm volatile("s_waitcnt vmcnt(" #n ")" ::: "memory")
#define PG8_WAIT_L(n) asm volatile("s_waitcnt lgkmcnt(" #n ")" ::: "memory")
#define PG8_BAR __builtin_amdgcn_s_barrier()
#define PG8_SCHED __builtin_amdgcn_sched_barrier(0)
    Unit cur, nxt; int ui = 0;
    if (!S.next(0, cur)) return;
    f32x4 acc[2][2][4][2];
#pragma unroll
    for (int a = 0; a < 2; ++a)
#pragma unroll
        for (int b = 0; b < 2; ++b)
#pragma unroll
            for (int m = 0; m < 4; ++m)
#pragma unroll
                for (int n = 0; n < 2; ++n) acc[a][b][m][n] = (f32x4){0.f, 0.f, 0.f, 0.f};
    bf16x8 At[4][2], B0[2][2], B1[2][2];
    const char* cA = (const char*)g.A + (size_t)cur.pm * tstep + (size_t)cur.kt0 * kstep; const char* cB = (const char*)g.Bt + (size_t)cur.pn * tstep + (size_t)cur.kt0 * kstep;
    S.a_ready(cur);
    if constexpr (SP2) {
        PG8_STAGE(PG8_SB(0, 0), cB, voffB); PG8_STAGE(PG8_SB(0, 1), cB + hstep, voffB); PG8_STAGE(PG8_SA(0, 0), cA, voffA); PG8_STAGE(PG8_SA(0, 1), cA + hstep, voffA);
        if (wr == 1) PG8_BAR;
        PG8_WAIT_V(2); PG8_BAR;
        PG8_STAGE(PG8_SB(1, 0), cB + kstep, voffB); PG8_STAGE(PG8_SA(1, 0), cA + kstep, voffA); PG8_STAGE(PG8_SB(1, 1), cB + hstep + kstep, voffB);
        PG8_WAIT_V(6); PG8_BAR;
    } else {
        PG8_STAGE(PG8_SB(0, 0), cB, voffB); PG8_STAGE(PG8_SA(0, 0), cA, voffA); PG8_STAGE(PG8_SB(0, 1), cB + hstep, voffB); PG8_STAGE(PG8_SA(0, 1), cA + hstep, voffA);
        if (wr == 1) PG8_BAR;
        PG8_WAIT_V(4); PG8_BAR;
        PG8_STAGE(PG8_SB(1, 0), cB + kstep, voffB); PG8_STAGE(PG8_SA(1, 0), cA + kstep, voffA); PG8_STAGE(PG8_SB(1, 1), cB + hstep + kstep, voffB);
        PG8_WAIT_V(6); PG8_BAR;
    }
    for (;;) {
        const bool has_next = S.next(ui + 1, nxt);
        const char* nA = has_next ? (const char*)g.A + (size_t)nxt.pm * tstep + (size_t)nxt.kt0 * kstep : cA; const char* nB = has_next ? (const char*)g.Bt + (size_t)nxt.pn * tstep + (size_t)nxt.kt0 * kstep : cB;
        const int nt = cur.nt;
        for (int t = 0; t < nt; t += 2) {
            const bool last = (t == nt - 2);
            const char* a1 = cA + (size_t)(t + 1) * kstep;
            const char* a2 = last ? nA : cA + (size_t)(t + 2) * kstep; const char* b2 = last ? nB : cB + (size_t)(t + 2) * kstep;
            const char* a3 = a2 + kstep; const char* b3 = b2 + kstep;
            if (last && has_next) S.a_ready(nxt);
            if constexpr (SP2) {
            PG8_LDB(B0, 0, 0); PG8_LDB(B1, 0, 1); PG8_SCHED; PG8_LDA(At, 0, 0); PG8_STAGE(PG8_SA(1, 1), a1 + hstep, voffA);
            PG8_WAIT_V(8); PG8_WAIT_L(0); PG8_BAR; PG8_MMA(0, 0, At, B0); PG8_MMA(0, 1, At, B1); PG8_BAR; PG8_SCHED;
            PG8_LDA(At, 0, 1); PG8_STAGE(PG8_SB(0, 0), b2, voffB); PG8_STAGE(PG8_SB(0, 1), b2 + hstep, voffB); PG8_STAGE(PG8_SA(0, 0), a2, voffA);
            PG8_WAIT_V(8); PG8_WAIT_L(0); PG8_BAR; PG8_MMA(1, 0, At, B0); PG8_MMA(1, 1, At, B1); PG8_BAR; PG8_SCHED;
            PG8_LDB(B0, 1, 0); PG8_LDB(B1, 1, 1); PG8_SCHED; PG8_LDA(At, 1, 0); PG8_STAGE(PG8_SA(0, 1), a2 + hstep, voffA);
            PG8_WAIT_V(8); PG8_WAIT_L(0); PG8_BAR; PG8_MMA(0, 0, At, B0); PG8_MMA(0, 1, At, B1); PG8_BAR; PG8_SCHED;
            PG8_LDA(At, 1, 1); PG8_STAGE(PG8_SB(1, 0), b3, voffB); PG8_STAGE(PG8_SB(1, 1), b3 + hstep, voffB); PG8_STAGE(PG8_SA(1, 0), a3, voffA);
            PG8_WAIT_V(8); PG8_WAIT_L(0); PG8_BAR; PG8_MMA(1, 0, At, B0); PG8_MMA(1, 1, At, B1); PG8_BAR; PG8_SCHED;
            } else {
            PG8_LDB(B0, 0, 0); PG8_SCHED; PG8_LDA(At, 0, 0); PG8_STAGE(PG8_SA(1, 1), a1 + hstep, voffA);
            PG8_WAIT_L(8); PG8_BAR; PG8_WAIT_L(0); PG8_MMA(0, 0, At, B0); PG8_BAR; PG8_SCHED;
            PG8_LDB(B1, 0, 1); PG8_STAGE(PG8_SB(0, 0), b2, voffB);
            PG8_BAR; PG8_WAIT_L(0); PG8_MMA(0, 1, At, B1); PG8_BAR;
            PG8_LDA(At, 0, 1); PG8_STAGE(PG8_SA(0, 0), a2, voffA);
            PG8_BAR; PG8_WAIT_L(0); PG8_MMA(1, 0, At, B0); PG8_BAR; PG8_SCHED;
            PG8_STAGE(PG8_SB(0, 1), b2 + hstep, voffB);
            PG8_WAIT_V(6); PG8_BAR; PG8_MMA(1, 1, At, B1); PG8_BAR;
            PG8_LDB(B0, 1, 0); PG8_SCHED; PG8_LDA(At, 1, 0); PG8_STAGE(PG8_SA(0, 1), a2 + hstep, voffA);
            PG8_WAIT_L(8); PG8_BAR; PG8_WAIT_L(0); PG8_MMA(0, 0, At, B0); PG8_BAR; PG8_SCHED;
            PG8_LDB(B1, 1, 1); PG8_STAGE(PG8_SB(1, 0), b3, voffB);
            PG8_BAR; PG8_WAIT_L(0); PG8_MMA(0, 1, At, B1); PG8_BAR;
            PG8_LDA(At, 1, 1); PG8_STAGE(PG8_SA(1, 0), a3, voffA);
            PG8_BAR; PG8_WAIT_L(0); PG8_MMA(1, 0, At, B0); PG8_BAR; PG8_SCHED;
            PG8_STAGE(PG8_SB(1, 1), b3 + hstep, voffB);
            PG8_WAIT_V(6); PG8_BAR; PG8_MMA(1, 1, At, B1); PG8_BAR;
            }
        }
        if constexpr (ALIGN_EPI) { if (wr == 0) PG8_BAR; }
        if constexpr (!Epi::AFTER_DRAIN) { E(acc, cur, wr, wc, fr, fq); S.done(cur); }
        if (!has_next) break;
#pragma unroll
        for (int a = 0; a < 2; ++a)
#pragma unroll
            for (int b = 0; b < 2; ++b)
#pragma unroll
                for (int m = 0; m < 4; ++m)
#pragma unroll
                    for (int n = 0; n < 2; ++n) acc[a][b][m][n] = (f32x4){0.f, 0.f, 0.f, 0.f};
        cur = nxt; cA = nA; cB = nB; ++ui;
        if constexpr (ALIGN_EPI) { if (wr == 1) PG8_BAR; }
    }
    PG8_WAIT_V(0);
    if constexpr (!ALIGN_EPI) { if (wr == 0) PG8_BAR; }
    PG8_BAR;
    if constexpr (Epi::AFTER_DRAIN) { E.fused(acc, cur, wr, wc, fr, fq, lds, wid, lane); S.done(cur); }
#undef PG8_SA
#undef PG8_SB
#undef PG8_STAGE
#undef PG8_LDA
#undef PG8_LDB
#undef PG8_MMA
#undef PG8_WAIT_V
#undef PG8_WAIT_L
#undef PG8_BAR
#undef PG8_SCHED
}
}
#ifndef PG8_SP2
#define PG8_SP2 true
#endif
#ifndef PG8_ALIGN
#define PG8_ALIGN true
#endif

#define LAS __attribute__((address_space(3)))
typedef unsigned short bf16;
typedef unsigned v4u __attribute__((ext_vector_type(4)));
typedef unsigned v2u __attribute__((ext_vector_type(2)));
typedef float f32x4 __attribute__((ext_vector_type(4)));
typedef short bf16x8 __attribute__((ext_vector_type(8)));
constexpr int NWAVES = 8, NTHR = 512;
constexpr int DM = 2048, NB = 4, SEQ = 2048, NMETA = 16, LP = 2064, DB = 128, DS = 4;
constexpr int MP = NB * LP;
constexpr int MS = DB * DS;
constexpr int MR = MP + MS;
constexpr int MPAD = 8960;
constexpr int NH = 32, NPROJ = 9248, NMAIN = 9216, DFF = 8192, DMIX = 4096, DCONV = 3072;
constexpr int NSEG = 33;
constexpr float EPS = 1e-6f;
constexpr size_t MiB = 1u << 20;
constexpr size_t WS_WIN = 1 * MiB, WS_WOUT = 38 * MiB, WS_WUP = 54 * MiB, WS_WDN = 86 * MiB, WS_WG = 118 * MiB;
constexpr size_t WS_H = 120 * MiB, WS_XN = 120 * MiB, WS_MIX = 120 * MiB, WS_XS = 190 * MiB, WS_BC = 225 * MiB;
constexpr size_t WS_PART = 260 * MiB, WS_A = 260 * MiB, WS_BT = 330 * MiB, WS_PXL = 260 * MiB, WS_PXBC = 295 * MiB;
constexpr size_t WS_PG = 400 * MiB, WS_PZ = 435 * MiB, WS_X1 = 400 * MiB, WS_XL = 470 * MiB, WS_HP = 470 * MiB;
constexpr size_t WS_DT = 505 * MiB, WS_AGGA = 507 * MiB, WS_AGGH = 509 * MiB, WS_END = 512 * MiB;
constexpr size_t WS_R2 = 330 * MiB;
constexpr int LDS_BYTES = 147456;
constexpr int NPHASE = 12;

struct Args { const float* in[28]; float* out; unsigned char* ws; int ph_lo, ph_hi; };
constexpr size_t O_YP = 0, O_YS = 16777216, O_PLH = O_YS + 1048576, O_PLC = O_PLH + 8192, O_PSSD = O_PLC + 24576, O_PSC = O_PSSD + 1048576,
                 O_SLH = O_PSC + 36864, O_SLC = O_SLH + 262144, O_SSSD = O_SLC + 786432, O_SSC = O_SSSD + 33554432, O_END = O_SSC + 1179648;

struct Ctx {
    const float *xp, *xs, *st_lru_h, *st_lru_conv, *st_ssd, *st_ssd_conv, *meta, *g_mix, *w_in, *conv_lru_w, *conv_lru_b, *lru_wa, *lru_ba, *lru_wx, *lru_bx,
                *lru_lam, *g_lru_out, *conv_ssd_w, *conv_ssd_b, *dt_bias, *a_log, *d_skip, *g_ssd_out, *w_out, *g_mlp, *w_up, *w_down, *g_final;
    float* out; unsigned char* ws;
    LAS unsigned char* lds;
    int tid, lane, wave, blk, G;
};

__device__ __forceinline__ unsigned f2bf(float f) { unsigned u = __builtin_bit_cast(unsigned, f); return (u + 0x7fffu + ((u >> 16) & 1u)) >> 16; }
__device__ __forceinline__ unsigned pk2(float lo, float hi) { unsigned r; asm("v_cvt_pk_bf16_f32 %0, %1, %2" : "=v"(r) : "v"(lo), "v"(hi)); return r; }
__device__ __forceinline__ float bflo(unsigned w) { return __builtin_bit_cast(float, w << 16); }
__device__ __forceinline__ float bfhi(unsigned w) { return __builtin_bit_cast(float, w & 0xffff0000u); }
__device__ __forceinline__ float bf1(bf16 h) { return __builtin_bit_cast(float, ((unsigned)h) << 16); }
#define SUM_DPP_STEP(v, ctrl, rmask) do { const int t_ = __builtin_amdgcn_update_dpp(0, __builtin_bit_cast(int, v), ctrl, rmask, 0xf, false); v += __builtin_bit_cast(float, t_); } while (0)
__device__ __forceinline__ float wave_sum(float v) {
    SUM_DPP_STEP(v, 0x111, 0xf); SUM_DPP_STEP(v, 0x112, 0xf); SUM_DPP_STEP(v, 0x114, 0xf); SUM_DPP_STEP(v, 0x118, 0xf);
    SUM_DPP_STEP(v, 0x142, 0xa); SUM_DPP_STEP(v, 0x143, 0xc);
    return __builtin_bit_cast(float, __builtin_amdgcn_readlane(__builtin_bit_cast(int, v), 63));
}
__device__ __forceinline__ float sigmoidf_(float x) { return __builtin_amdgcn_rcpf(1.0f + __expf(-x)); }
__device__ __forceinline__ float siluf_(float x) { return x * __builtin_amdgcn_rcpf(1.0f + __expf(-x)); }
__device__ __forceinline__ float softplusf_(float x) { return x > 20.f ? x : log1pf(expf(x)); }
__device__ __forceinline__ float gelu_tanh(float x) { const float u = 0.7978845608028654f * (x + 0.044715f * x * x * x); const float t = 1.0f - 2.0f * __builtin_amdgcn_rcpf(__expf(2.0f * u) + 1.0f); return 0.5f * x * (1.0f + t); }

__device__ __forceinline__ const float* xrow_ptr(const Ctx& F, int r) {
    if (r < MP) { const int b = r / LP, t = r - b * LP; return t < NMETA ? F.meta + (size_t)t * DM : F.xp + ((size_t)b * SEQ + (t - NMETA)) * DM; }
    return F.xs + (size_t)(r - MP) * DM;
}

__device__ __forceinline__ void transpose_item(const float* W, int ldw, bf16* WT, int K, int k0, int n0, LAS float* scr, int lane) {
#pragma unroll 8
    for (int i = 0; i < 32; ++i) { const int kk = 2 * i + (lane >> 5); scr[kk * 33 + (lane & 31)] = W[(size_t)(k0 + kk) * ldw + n0 + (lane & 31)]; }
    asm volatile("s_waitcnt lgkmcnt(0)" ::: "memory");
    const int c = lane & 7;
#pragma unroll
    for (int j = 0; j < 4; ++j) { const int n = (lane >> 3) + 8 * j; const LAS float* s = scr + (8 * c) * 33 + n;
        v4u o; o.x = pk2(s[0 * 33], s[1 * 33]); o.y = pk2(s[2 * 33], s[3 * 33]); o.z = pk2(s[4 * 33], s[5 * 33]); o.w = pk2(s[6 * 33], s[7 * 33]);
        *(v4u*)(WT + (size_t)(n0 + n) * K + k0 + 8 * c) = o; }
    asm volatile("s_waitcnt lgkmcnt(0)" ::: "memory");
}
__device__ __forceinline__ void rms_row_store(const f32x4 (&v)[8], const float* g, bf16* orow, int lane) {
    float ss = 0.f;
#pragma unroll
    for (int j = 0; j < 8; ++j) ss += (v[j].x * v[j].x + v[j].y * v[j].y) + (v[j].z * v[j].z + v[j].w * v[j].w);
    const float rs = rsqrtf(wave_sum(ss) * (1.f / DM) + EPS);
#pragma unroll
    for (int j = 0; j < 8; ++j) { const f32x4 gg = *(const f32x4*)(g + 4 * lane + 256 * j); const f32x4 o = v[j] * rs * gg;
        v2u w; w.x = pk2(o.x, o.y); w.y = pk2(o.z, o.w); *(v2u*)(orow + 4 * lane + 256 * j) = w; }
}
constexpr int I_IN = 32 * 289, I_OUT = 64 * 64, I_UP = 32 * 256, I_DN = 128 * 64, I_G = 256, NITEMS = I_IN + I_OUT + I_UP + I_DN + I_G;
__device__ __forceinline__ void convert_range(const Ctx& F, int lo, int hi, int part, int nparts) {
    LAS float* scr = (LAS float*)(F.lds + F.wave * 16384);
    bf16* WIN = (bf16*)(F.ws + WS_WIN); bf16* WOUT = (bf16*)(F.ws + WS_WOUT); bf16* WUP = (bf16*)(F.ws + WS_WUP); bf16* WDN = (bf16*)(F.ws + WS_WDN); bf16* WG = (bf16*)(F.ws + WS_WG);
    for (int it = lo + part * NWAVES + F.wave; it < hi; it += nparts * NWAVES) {
        int r = it;
        if (r < I_IN) { transpose_item(F.w_in, NPROJ, WIN, 2048, 64 * (r / 289), 32 * (r % 289), scr, F.lane); continue; } r -= I_IN;
        if (r < I_OUT) { transpose_item(F.w_out, 2048, WOUT, 4096, 64 * (r / 64), 32 * (r % 64), scr, F.lane); continue; } r -= I_OUT;
        if (r < I_UP) { transpose_item(F.w_up, 8192, WUP, 2048, 64 * (r / 256), 32 * (r % 256), scr, F.lane); continue; } r -= I_UP;
        if (r < I_DN) { transpose_item(F.w_down, 2048, WDN, 8192, 64 * (r / 64), 32 * (r % 64), scr, F.lane); continue; } r -= I_DN;
        { const int mat = r >> 7, hd = (r >> 3) & 15, sub = r & 7;
          transpose_item((mat ? F.lru_wx : F.lru_wa) + (size_t)hd * 16384, 128, WG + (size_t)(hd * 256 + mat * 128) * 128, 128, 64 * (sub >> 2), 32 * (sub & 3), scr, F.lane); }
    }
}
__device__ __forceinline__ void slack_parts(int n, int G, int blk, int& part, int& nparts) {
    const int nmax = (n + G - 1) / G, cut = (n % G == 0) ? 0 : n - (nmax - 1) * G;
    part = blk - cut; nparts = G - cut;
}
__device__ __forceinline__ void phase_prologue(const Ctx& F) {
    const int gw = F.blk * NWAVES + F.wave, NGW = F.G * NWAVES;
    convert_range(F, 0, I_IN, F.blk, F.G);
    convert_range(F, I_IN + I_OUT + I_UP + I_DN, NITEMS, F.blk, F.G);
    bf16* XN = (bf16*)(F.ws + WS_XN);
    for (int m = gw; m < MPAD; m += NGW) {
        bf16* orow = XN + (size_t)m * DM;
        if (m >= MR) {
#pragma unroll
            for (int j = 0; j < 8; ++j) *(v2u*)(orow + 4 * F.lane + 256 * j) = (v2u){0u, 0u};
            continue; }
        const float* xr = xrow_ptr(F, m); f32x4 v[8];
#pragma unroll
        for (int j = 0; j < 8; ++j) v[j] = *(const f32x4*)(xr + 4 * F.lane + 256 * j);
        rms_row_store(v, F.g_mix, orow, F.lane);
    }
}

__device__ __forceinline__ void phase_dt(const Ctx& F) {
    const int fr = F.lane & 15, fq = F.lane >> 4;
    const bf16* XN = (const bf16*)(F.ws + WS_XN); const bf16* WD = (const bf16*)(F.ws + WS_WIN) + (size_t)NMAIN * 2048; float* DT = (float*)(F.ws + WS_DT);
    LAS float* red = (LAS float*)F.lds;
    for (int blk = F.blk; blk < MR / 16; blk += F.G) {
        f32x4 c0 = {0.f, 0.f, 0.f, 0.f}, c1 = {0.f, 0.f, 0.f, 0.f};
        const int kb = F.wave * 256;
        const bf16* ap = XN + (size_t)(blk * 16 + fr) * DM + kb + fq * 8; const bf16* b0p = WD + (size_t)fr * DM + kb + fq * 8; const bf16* b1p = WD + (size_t)(16 + fr) * DM + kb + fq * 8;
#pragma unroll
        for (int k0 = 0; k0 < 256; k0 += 32) {
            const bf16x8 a = *(const bf16x8*)(ap + k0), b0 = *(const bf16x8*)(b0p + k0), b1 = *(const bf16x8*)(b1p + k0);
            c0 = __builtin_amdgcn_mfma_f32_16x16x32_bf16(a, b0, c0, 0, 0, 0); c1 = __builtin_amdgcn_mfma_f32_16x16x32_bf16(a, b1, c1, 0, 0, 0);
        }
        *(LAS f32x4*)(red + (F.wave * 64 + F.lane) * 8) = c0; *(LAS f32x4*)(red + (F.wave * 64 + F.lane) * 8 + 4) = c1;
        __syncthreads();
        if (F.wave == 0) {
#pragma unroll
            for (int w = 1; w < 8; ++w) { c0 += *(const LAS f32x4*)(red + (w * 64 + F.lane) * 8); c1 += *(const LAS f32x4*)(red + (w * 64 + F.lane) * 8 + 4); }
            const float bb0 = F.dt_bias[fr], bb1 = F.dt_bias[16 + fr];
#pragma unroll
            for (int e = 0; e < 4; ++e) { const int row = blk * 16 + fq * 4 + e; DT[row * NH + fr] = softplusf_(c0[e] + bb0); DT[row * NH + 16 + fr] = softplusf_(c1[e] + bb1); }
        }
        __syncthreads();
    }
}

__device__ __forceinline__ void phase_conv(const Ctx& F) {
    const bf16* PXL = (const bf16*)(F.ws + WS_PXL); const bf16* PXBC = (const bf16*)(F.ws + WS_PXBC);
    bf16* XL = (bf16*)(F.ws + WS_XL); bf16* XS = (bf16*)(F.ws + WS_XS); bf16* BC = (bf16*)(F.ws + WS_BC);
    constexpr int NRB = MR / 4, NCG = 640;
    const int vblk = (F.G % 8 == 0) ? (F.blk & 7) * (F.G >> 3) + (F.blk >> 3) : F.blk;
    for (int idx = vblk * NTHR + F.tid; idx < NRB * NCG; idx += F.G * NTHR) {
        const int cg_ = idx % NCG, rb = idx / NCG; const bool lru = cg_ < 256;
        const int c0 = lru ? cg_ * 8 : (cg_ - 256) * 8, ld = lru ? 2048 : 3072;
        const bf16* src = lru ? PXL : PXBC; const float* cw = lru ? F.conv_lru_w : F.conv_ssd_w; const float* cb = lru ? F.conv_lru_b : F.conv_ssd_b;
        const int row0 = rb * 4; const bool prompt = row0 < MP;
        int b = 0, t0 = 0, s = 0; if (prompt) { b = row0 / LP; t0 = row0 - b * LP; } else s = (row0 - MP) >> 2;
        float win[7][8];
        if (prompt) {
            if (t0 == 0) {
#pragma unroll
                for (int i = 0; i < 3; ++i)
#pragma unroll
                    for (int e = 0; e < 8; ++e) win[i][e] = 0.f;
            } else {
#pragma unroll
                for (int i = 0; i < 3; ++i) { const v4u w = *(const v4u*)(src + (size_t)(row0 - 3 + i) * ld + c0);
                    win[i][0] = bflo(w.x); win[i][1] = bfhi(w.x); win[i][2] = bflo(w.y); win[i][3] = bfhi(w.y); win[i][4] = bflo(w.z); win[i][5] = bfhi(w.z); win[i][6] = bflo(w.w); win[i][7] = bfhi(w.w); }
            }
        } else {
            const float* st = (lru ? F.st_lru_conv : F.st_ssd_conv) + (size_t)s * 3 * ld + c0;
#pragma unroll
            for (int i = 0; i < 3; ++i) { const f32x4 u0 = *(const f32x4*)(st + (size_t)i * ld), u1 = *(const f32x4*)(st + (size_t)i * ld + 4);
                win[i][0] = u0.x; win[i][1] = u0.y; win[i][2] = u0.z; win[i][3] = u0.w; win[i][4] = u1.x; win[i][5] = u1.y; win[i][6] = u1.z; win[i][7] = u1.w; }
        }
#pragma unroll
        for (int i = 0; i < 4; ++i) { const v4u w = *(const v4u*)(src + (size_t)(row0 + i) * ld + c0);
            win[3 + i][0] = bflo(w.x); win[3 + i][1] = bfhi(w.x); win[3 + i][2] = bflo(w.y); win[3 + i][3] = bfhi(w.y); win[3 + i][4] = bflo(w.z); win[3 + i][5] = bfhi(w.z); win[3 + i][6] = bflo(w.w); win[3 + i][7] = bfhi(w.w); }
        float wk[4][8], bias[8];
#pragma unroll
        for (int k = 0; k < 4; ++k) { const f32x4 u0 = *(const f32x4*)(cw + (size_t)k * ld + c0), u1 = *(const f32x4*)(cw + (size_t)k * ld + c0 + 4);
            wk[k][0] = u0.x; wk[k][1] = u0.y; wk[k][2] = u0.z; wk[k][3] = u0.w; wk[k][4] = u1.x; wk[k][5] = u1.y; wk[k][6] = u1.z; wk[k][7] = u1.w; }
        { const f32x4 u0 = *(const f32x4*)(cb + c0), u1 = *(const f32x4*)(cb + c0 + 4); bias[0] = u0.x; bias[1] = u0.y; bias[2] = u0.z; bias[3] = u0.w; bias[4] = u1.x; bias[5] = u1.y; bias[6] = u1.z; bias[7] = u1.w; }
#pragma unroll
        for (int j = 0; j < 4; ++j) {
            float o[8];
#pragma unroll
            for (int e = 0; e < 8; ++e) { float v = bias[e] + win[j][e] * wk[0][e]; v += win[j + 1][e] * wk[1][e]; v += win[j + 2][e] * wk[2][e]; v += win[j + 3][e] * wk[3][e]; o[e] = v; }
            const size_t row = (size_t)(row0 + j);
            if (lru) { v4u w; w.x = pk2(o[0], o[1]); w.y = pk2(o[2], o[3]); w.z = pk2(o[4], o[5]); w.w = pk2(o[6], o[7]); *(v4u*)(XL + row * 2048 + c0) = w; }
            else {
#pragma unroll
                for (int e = 0; e < 8; ++e) o[e] = siluf_(o[e]);
                if (c0 < 2048) { v4u w; w.x = pk2(o[0], o[1]); w.y = pk2(o[2], o[3]); w.z = pk2(o[4], o[5]); w.w = pk2(o[6], o[7]); *(v4u*)(XS + row * 2048 + c0) = w; }
                else { v4u w; w.x = pk2(o[0], o[1]); w.y = pk2(o[2], o[3]); w.z = pk2(o[4], o[5]); w.w = pk2(o[6], o[7]); *(v4u*)(BC + row * 1024 + (c0 - 2048)) = w; }
            }
        }
        float* cst = nullptr;
        if (prompt) { if (t0 == LP - 4) cst = F.out + (lru ? O_PLC : O_PSC) + (size_t)b * 3 * ld + c0; }
        else cst = F.out + (lru ? O_SLC : O_SSC) + (size_t)s * 3 * ld + c0;
        if (cst) {
#pragma unroll
            for (int i = 0; i < 3; ++i) { *(f32x4*)(cst + (size_t)i * ld) = (f32x4){win[4 + i][0], win[4 + i][1], win[4 + i][2], win[4 + i][3]}; *(f32x4*)(cst + (size_t)i * ld + 4) = (f32x4){win[4 + i][4], win[4 + i][5], win[4 + i][6], win[4 + i][7]}; }
        }
    }
}

__device__ __forceinline__ void gate_unit(const Ctx& F, int pm, int head) {
    constexpr int RS = 272;
    LAS unsigned char* LA = F.lds; LAS unsigned char* LB = F.lds + 256 * RS;
    const bf16* XL = (const bf16*)(F.ws + WS_XL) + (size_t)pm * 256 * 2048 + head * 128; const bf16* WG = (const bf16*)(F.ws + WS_WG) + (size_t)head * 256 * 128;
    float* Ao = (float*)(F.ws + WS_A); float* Bo = (float*)(F.ws + WS_BT);
    { const int row = F.tid >> 4, cp = F.tid & 15;
      const bf16* ga = XL + (size_t)row * 2048 + cp * 8; const bf16* gb = WG + row * 128 + cp * 8; LAS unsigned char* la = LA + row * RS + cp * 16;
#pragma unroll 2
      for (int i = 0; i < 8; ++i) { const v4u va = *(const v4u*)(ga + (size_t)i * 32 * 2048), vb = *(const v4u*)(gb + i * 32 * 128);
          *(LAS v4u*)(la + i * 32 * RS) = va; *(LAS v4u*)(la + 256 * RS + i * 32 * RS) = vb; } }
    __syncthreads();
    const int wr = F.wave >> 2, wc = F.wave & 3, fr = F.lane & 15, fq = F.lane >> 4;
    float cba[2][4], cbx[2][4], csp[2][4];
#pragma unroll
    for (int n = 0; n < 2; ++n)
#pragma unroll
        for (int e = 0; e < 4; ++e) { const int ch = head * 128 + 32 * wc + 16 * n + 4 * fq + e; cba[n][e] = F.lru_ba[ch]; cbx[n][e] = F.lru_bx[ch]; csp[n][e] = 8.0f * softplusf_(-F.lru_lam[ch]); }
#pragma unroll 1
    for (int mh = 0; mh < 2; ++mh) {
        f32x4 accr[4][2], acci[4][2];
#pragma unroll
        for (int m = 0; m < 4; ++m)
#pragma unroll
            for (int n = 0; n < 2; ++n) { accr[m][n] = (f32x4){0.f, 0.f, 0.f, 0.f}; acci[m][n] = (f32x4){0.f, 0.f, 0.f, 0.f}; }
        const int rbase = 128 * wr + 64 * mh;
#pragma unroll
        for (int ks = 0; ks < 4; ++ks) {
            bf16x8 br[2], bi[2];
#pragma unroll
            for (int n = 0; n < 2; ++n) { br[n] = *(const LAS bf16x8*)(LB + (32 * wc + 16 * n + fr) * RS + (32 * ks + 8 * fq) * 2); bi[n] = *(const LAS bf16x8*)(LB + (128 + 32 * wc + 16 * n + fr) * RS + (32 * ks + 8 * fq) * 2); }
#pragma unroll
            for (int m = 0; m < 4; ++m) { const bf16x8 af = *(const LAS bf16x8*)(LA + (rbase + 16 * m + fr) * RS + (32 * ks + 8 * fq) * 2);
#pragma unroll
                for (int n = 0; n < 2; ++n) { accr[m][n] = __builtin_amdgcn_mfma_f32_16x16x32_bf16(br[n], af, accr[m][n], 0, 0, 0); acci[m][n] = __builtin_amdgcn_mfma_f32_16x16x32_bf16(bi[n], af, acci[m][n], 0, 0, 0); } }
        }
#pragma unroll
        for (int m = 0; m < 4; ++m) {
            const int rl = rbase + 16 * m + fr, row = pm * 256 + rl;
            if (row < MR) {
                const bool first = (row < MP) && (row % LP == 0);
                const float* h0p = (row >= MP && ((row - MP) & 3) == 0) ? F.st_lru_h + (size_t)((row - MP) >> 2) * 2048 : nullptr;
#pragma unroll
                for (int n = 0; n < 2; ++n) {
                    const int j0 = 32 * wc + 16 * n + 4 * fq, ch0 = head * 128 + j0;
                    const v2u xw = *(const LAS v2u*)(LA + rl * RS + j0 * 2);
                    const float xl[4] = {bflo(xw.x), bfhi(xw.x), bflo(xw.y), bfhi(xw.y)};
                    f32x4 h0v = {0.f, 0.f, 0.f, 0.f}; if (h0p) h0v = *(const f32x4*)(h0p + ch0);
                    f32x4 av, bv;
#pragma unroll
                    for (int e = 0; e < 4; ++e) {
                        const float r = sigmoidf_(accr[m][n][e] + cba[n][e]), ii = sigmoidf_(acci[m][n][e] + cbx[n][e]);
                        const float a = __expf(-csp[n][e] * r); const float mult = first ? 1.0f : __builtin_amdgcn_sqrtf(fmaxf(1.0f - a * a, 0.f));
                        av[e] = a; bv[e] = mult * ii * xl[e] + a * h0v[e];
                    }
                    *(f32x4*)(Ao + (size_t)row * 2048 + ch0) = av; *(f32x4*)(Bo + (size_t)row * 2048 + ch0) = bv;
                }
            }
        }
    }
    __syncthreads();
}
__device__ __forceinline__ void phase_gates(const Ctx& F) {
    for (int u = F.blk; u < 35 * 16; u += F.G) gate_unit(F, u >> 4, u & 15);
#ifdef PROBE_G2
    for (int u = F.blk; u < 35 * 16; u += F.G) gate_unit(F, u >> 4, u & 15);
#endif
    int part, nparts; slack_parts(35 * 16, F.G, F.blk, part, nparts);
    if (part >= 0) convert_range(F, I_IN, I_IN + I_OUT + I_UP, part, nparts);
#ifdef PROBE_C2
    __syncthreads();
    if (part >= 0) convert_range(F, I_IN, I_IN + I_OUT + I_UP, part, nparts);
#endif
}

__device__ __forceinline__ void ssd_unit(const Ctx& F, int row0, int T, int head, const float* h0, float* hout) {
    const float* DT = (const float*)(F.ws + WS_DT); const bf16* XS = (const bf16*)(F.ws + WS_XS); const float* BC = (const float*)(F.ws + WS_BC); const bf16* PZ = (const bf16*)(F.ws + WS_PZ);
    bf16* MIX = (bf16*)(F.ws + WS_MIX);
    LAS float* xch = (LAS float*)F.lds;
    const int g = head >> 3, wave = F.wave, lane = F.lane;
    const float Ah = -expf(F.a_log[head]), Dh = F.d_skip[head];
    f32x4 h[4];
#pragma unroll
    for (int q = 0; q < 4; ++q) h[q] = h0 ? *(const f32x4*)(h0 + ((size_t)head * 64 + lane) * 128 + 16 * wave + 4 * q) : (f32x4){0.f, 0.f, 0.f, 0.f};
    for (int tb = 0; tb < T; tb += 4) {
        float part[4];
#pragma unroll
        for (int tt = 0; tt < 4; ++tt) {
            const size_t row = (size_t)(row0 + tb + tt);
            const float dt = DT[row * NH + head]; const float dA = __expf(dt * Ah);
            const float dtx = dt * bf1(XS[row * 2048 + head * 64 + lane]);
            const f32x4* Bp = (const f32x4*)(BC + row * 1024 + g * 128 + 16 * wave); const f32x4* Cp = (const f32x4*)(BC + row * 1024 + 512 + g * 128 + 16 * wave);
            float acc = 0.f;
#pragma unroll
            for (int q = 0; q < 4; ++q) { const f32x4 b4 = Bp[q], c4 = Cp[q];
#pragma unroll
                for (int e = 0; e < 4; ++e) { h[q][e] = dA * h[q][e] + dtx * b4[e]; acc += h[q][e] * c4[e]; } }
            part[tt] = acc;
        }
        const int buf = (tb >> 2) & 1;
#pragma unroll
        for (int tt = 0; tt < 4; ++tt) xch[buf * 2048 + (wave * 4 + tt) * 64 + lane] = part[tt];
        __syncthreads();
        if (F.tid < 256) {
            const int tt = F.tid >> 6, p = F.tid & 63; float y = 0.f;
#pragma unroll
            for (int w = 0; w < 8; ++w) y += xch[buf * 2048 + (w * 4 + tt) * 64 + p];
            const size_t row = (size_t)(row0 + tb + tt);
            const float x = bf1(XS[row * 2048 + head * 64 + p]), z = bf1(PZ[row * 2048 + head * 64 + p]);
            MIX[row * 4096 + 2048 + head * 64 + p] = (bf16)f2bf((y + Dh * x) * siluf_(z));
        }
    }
#pragma unroll
    for (int q = 0; q < 4; ++q) *(f32x4*)(hout + ((size_t)head * 64 + lane) * 128 + 16 * wave + 4 * q) = h[q];
    __syncthreads();
}

__device__ __forceinline__ void ssd_sample_wave(const Ctx& F, int part, int nparts) {
    const float* DT = (const float*)(F.ws + WS_DT); const bf16* XS = (const bf16*)(F.ws + WS_XS); const float* BC = (const float*)(F.ws + WS_BC); const bf16* PZ = (const bf16*)(F.ws + WS_PZ);
    bf16* MIX = (bf16*)(F.ws + WS_MIX);
    const int gw = part * NWAVES + F.wave, NGW = nparts * NWAVES, lane = F.lane, pl = lane >> 3, no = lane & 7;
    constexpr int NU = DB * NH * 8;
    f32x4 hn[4];
    if (gw < NU) { const float* hp = F.st_ssd + ((size_t)(gw >> 3) * 64 + (gw & 7) * 8 + pl) * 128 + 16 * no;
#pragma unroll
        for (int q = 0; q < 4; ++q) hn[q] = *(const f32x4*)(hp + 4 * q); }
    for (int u = gw; u < NU; u += NGW) {
        const int po = u & 7, head = (u >> 3) & 31, s_ = u >> 8, g = head >> 3, p = po * 8 + pl;
        f32x4 h[4];
#pragma unroll
        for (int q = 0; q < 4; ++q) h[q] = hn[q];
        const int un = u + NGW;
        if (un < NU) { const float* hp = F.st_ssd + ((size_t)(un >> 3) * 64 + (un & 7) * 8 + pl) * 128 + 16 * no;
#pragma unroll
            for (int q = 0; q < 4; ++q) hn[q] = *(const f32x4*)(hp + 4 * q); }
        const float Ah = -expf(F.a_log[head]), Dh = F.d_skip[head];
        float dtv[4], xv[4], zv[4]; f32x4 bv[4][4], cv[4][4];
#pragma unroll
        for (int j = 0; j < 4; ++j) { const size_t row = (size_t)(MP + 4 * s_ + j);
            dtv[j] = DT[row * NH + head]; xv[j] = bf1(XS[row * 2048 + head * 64 + p]); zv[j] = bf1(PZ[row * 2048 + head * 64 + p]);
            const float* bp = BC + row * 1024 + g * 128 + 16 * no;
#pragma unroll
            for (int q = 0; q < 4; ++q) { bv[j][q] = *(const f32x4*)(bp + 4 * q); cv[j][q] = *(const f32x4*)(bp + 512 + 4 * q); } }
#pragma unroll
        for (int j = 0; j < 4; ++j) {
            const float dA = __expf(dtv[j] * Ah), dtx = dtv[j] * xv[j]; float acc = 0.f;
#pragma unroll
            for (int q = 0; q < 4; ++q)
#pragma unroll
                for (int e = 0; e < 4; ++e) { h[q][e] = dA * h[q][e] + dtx * bv[j][q][e]; acc += h[q][e] * cv[j][q][e]; }
            acc += __shfl_xor(acc, 1); acc += __shfl_xor(acc, 2); acc += __shfl_xor(acc, 4);
            if (no == 0) MIX[(size_t)(MP + 4 * s_ + j) * 4096 + 2048 + head * 64 + p] = (bf16)f2bf((acc + Dh * xv[j]) * siluf_(zv[j]));
        }
        float* op = F.out + O_SSSD + ((size_t)(u >> 3) * 64 + po * 8 + pl) * 128 + 16 * no;
#pragma unroll
        for (int q = 0; q < 4; ++q) *(f32x4*)(op + 4 * q) = h[q];
    }
}

__device__ __forceinline__ void ssd_sample_blk(const Ctx& F, int part, int nparts) {
    const float* DT = (const float*)(F.ws + WS_DT); const bf16* XS = (const bf16*)(F.ws + WS_XS); const bf16* BC = (const bf16*)(F.ws + WS_BC); const bf16* PZ = (const bf16*)(F.ws + WS_PZ);
    bf16* MIX = (bf16*)(F.ws + WS_MIX);
    LAS float* sb = (LAS float*)F.lds;
    LAS bf16* xl = (LAS bf16*)(F.lds + 4096); LAS bf16* zl = (LAS bf16*)(F.lds + 8192);
    LAS float* dl = (LAS float*)(F.lds + 12288);
    const int lane = F.lane, pl = lane >> 3, no = lane & 7, p = F.wave * 8 + pl;
    constexpr int NIT = DB * 4;
    f32x4 hn[4];
#define SMP_LOAD(it_, hh_) do { const float* hp = F.st_ssd + (((size_t)((it_) >> 2) * NH + 8 * ((it_) & 3) + (hh_)) * 64 + p) * 128 + 4 * no;   \
        _Pragma("unroll") for (int q = 0; q < 4; ++q) hn[q] = *(const f32x4*)(hp + 32 * q); } while (0)
    if (part < NIT) SMP_LOAD(part, 0);
#pragma unroll 1
    for (int it = part; it < NIT; it += nparts) {
        const int s_ = it >> 2, g = it & 3;
        if (F.tid < 256) { const int tok = F.tid >> 6, r = F.tid & 63, which = r >> 5, n4 = r & 31;
            const v2u w = *(const v2u*)(BC + (size_t)(MP + 4 * s_ + tok) * 1024 + which * 512 + g * 128 + 4 * n4);
            *(LAS f32x4*)(sb + (tok * 2 + which) * 128 + 4 * n4) = (f32x4){bflo(w.x), bfhi(w.x), bflo(w.y), bfhi(w.y)}; }
        { const int tok = F.tid >> 7, which = (F.tid >> 6) & 1, piece = F.tid & 63;
          const v4u w = *(const v4u*)((which ? PZ : XS) + (size_t)(MP + 4 * s_ + tok) * 2048 + g * 512 + piece * 8);
          *(LAS v4u*)((which ? zl : xl) + tok * 512 + piece * 8) = w; }
        if (F.tid < 32) dl[F.tid] = DT[(size_t)(MP + 4 * s_ + (F.tid >> 3)) * NH + 8 * g + (F.tid & 7)];
        __syncthreads();
#pragma unroll 1
        for (int hh = 0; hh < 8; ++hh) {
            const int head = 8 * g + hh;
            f32x4 h[4];
#pragma unroll
            for (int q = 0; q < 4; ++q) h[q] = hn[q];
            if (hh < 7) SMP_LOAD(it, hh + 1); else if (it + nparts < NIT) SMP_LOAD(it + nparts, 0);
            const float Ah = -expf(F.a_log[head]), Dh = F.d_skip[head];
#pragma unroll
            for (int j = 0; j < 4; ++j) {
                const float xv = bf1(xl[j * 512 + hh * 64 + p]), zv = bf1(zl[j * 512 + hh * 64 + p]), dtv = dl[j * 8 + hh];
                const float dA = __expf(dtv * Ah), dtx = dtv * xv; float acc = 0.f;
#pragma unroll
                for (int q = 0; q < 4; ++q) { const f32x4 b4 = *(const LAS f32x4*)(sb + (j * 2) * 128 + 32 * q + 4 * no), c4 = *(const LAS f32x4*)(sb + (j * 2 + 1) * 128 + 32 * q + 4 * no);
#pragma unroll
                    for (int e = 0; e < 4; ++e) { h[q][e] = dA * h[q][e] + dtx * b4[e]; acc += h[q][e] * c4[e]; } }
                acc += __shfl_xor(acc, 1); acc += __shfl_xor(acc, 2); acc += __shfl_xor(acc, 4);
                if (no == 0) MIX[(size_t)(MP + 4 * s_ + j) * 4096 + 2048 + head * 64 + p] = (bf16)f2bf((acc + Dh * xv) * siluf_(zv));
            }
            float* op = F.out + O_SSSD + (((size_t)s_ * NH + head) * 64 + p) * 128 + 4 * no;
#pragma unroll
            for (int q = 0; q < 4; ++q) *(f32x4*)(op + 32 * q) = h[q];
        }
        __syncthreads();
    }
#undef SMP_LOAD
}
__device__ __forceinline__ void lru_aggregate(const Ctx& F, int part, int nparts) {
    const float* Ai = (const float*)(F.ws + WS_A); const float* Bi = (const float*)(F.ws + WS_BT); float* GA = (float*)(F.ws + WS_AGGA); float* GH = (float*)(F.ws + WS_AGGH);
    for (int idx = part * NTHR + F.tid; idx < NB * NSEG * 2048; idx += nparts * NTHR) {
        const int ch = idx & 2047, sg = (idx >> 11) % NSEG, b = idx / (2048 * NSEG);
        const int t0 = sg * 64, t1 = min(t0 + 64, LP);
        float ap = 1.f, hh = 0.f;
        if (t1 - t0 == 64) {
            for (int t = t0; t < t1; t += 32) { float av[32], bv[32];
#pragma unroll
                for (int k = 0; k < 32; ++k) { const size_t o = (size_t)(b * LP + t + k) * 2048 + ch; av[k] = Ai[o]; bv[k] = Bi[o]; }
#pragma unroll
                for (int k = 0; k < 32; ++k) { hh = av[k] * hh + bv[k]; ap *= av[k]; } }
        } else {
            for (int t = t0; t < t1; t += 16) { float av[16], bv[16];
#pragma unroll
                for (int k = 0; k < 16; ++k) { const size_t o = (size_t)(b * LP + t + k) * 2048 + ch; av[k] = Ai[o]; bv[k] = Bi[o]; }
#pragma unroll
                for (int k = 0; k < 16; ++k) { hh = av[k] * hh + bv[k]; ap *= av[k]; } }
        }
        GA[idx] = ap; GH[idx] = hh;
    }
}

constexpr int NCH = 33;
constexpr size_t WS_S = 260 * MiB;
constexpr size_t WS_DC = 506 * MiB + 512 * 1024;
__device__ __forceinline__ float dpp_add_(float v, float src_shifted_default0, int) { return v + src_shifted_default0; }
#define SCAN_DPP_STEP(v, ctrl, rmask) do { const int t_ = __builtin_amdgcn_update_dpp(0, __builtin_bit_cast(int, v), ctrl, rmask, 0xf, false); v += __builtin_bit_cast(float, t_); } while (0)
__device__ __forceinline__ float wave_scan_incl(float v, int lane) {
    (void)lane;
    SCAN_DPP_STEP(v, 0x111, 0xf); SCAN_DPP_STEP(v, 0x112, 0xf); SCAN_DPP_STEP(v, 0x114, 0xf); SCAN_DPP_STEP(v, 0x118, 0xf);
    SCAN_DPP_STEP(v, 0x142, 0xa); SCAN_DPP_STEP(v, 0x143, 0xc);
    return v;
}
__device__ __forceinline__ void ssdA_unit(const Ctx& F, int b, int c, int g) {
    const float* DT = (const float*)(F.ws + WS_DT); const bf16* XS = (const bf16*)(F.ws + WS_XS); const float* BC = (const float*)(F.ws + WS_BC);
    float* S = (float*)(F.ws + WS_S); float* DC = (float*)(F.ws + WS_DC);
    const int row0 = b * LP + 64 * c, nq = min(64, LP - 64 * c), lane = F.lane, wave = F.wave, fr = lane & 15, fq = lane >> 4;
    LAS unsigned char* BT = F.lds; LAS unsigned char* XT = F.lds + 18432;
    { const int n = F.tid & 127, jq = F.tid >> 7; unsigned w[8];
#pragma unroll
      for (int jj = 0; jj < 8; ++jj) { const int j0 = 16 * jq + 2 * jj;
          const float v0 = j0 < nq ? BC[(size_t)(row0 + j0) * 1024 + g * 128 + n] : 0.f, v1 = (j0 + 1) < nq ? BC[(size_t)(row0 + j0 + 1) * 1024 + g * 128 + n] : 0.f; w[jj] = pk2(v0, v1); }
      *(LAS v4u*)(BT + n * 144 + jq * 32) = (v4u){w[0], w[1], w[2], w[3]}; *(LAS v4u*)(BT + n * 144 + jq * 32 + 16) = (v4u){w[4], w[5], w[6], w[7]}; }
    float dt_n = lane < nq ? DT[(size_t)(row0 + lane) * NH + 8 * g] : 0.f; unsigned xr_n[8];
#pragma unroll
    for (int jj = 0; jj < 8; ++jj) { const int j0 = 8 * wave + jj; xr_n[jj] = j0 < nq ? (unsigned)XS[(size_t)(row0 + j0) * 2048 + (8 * g) * 64 + lane] : 0u; }
#pragma unroll 1
    for (int hh = 0; hh < 8; ++hh) {
        const int head = 8 * g + hh; const float Ah = -expf(F.a_log[head]);
        const float dtj = dt_n; unsigned xr[8];
#pragma unroll
        for (int jj = 0; jj < 8; ++jj) xr[jj] = xr_n[jj];
        if (hh < 7) { dt_n = lane < nq ? DT[(size_t)(row0 + lane) * NH + head + 1] : 0.f;
#pragma unroll
            for (int jj = 0; jj < 8; ++jj) { const int j0 = 8 * wave + jj; xr_n[jj] = j0 < nq ? (unsigned)XS[(size_t)(row0 + j0) * 2048 + (head + 1) * 64 + lane] : 0u; } }
        const float acum = wave_scan_incl(dtj * Ah, lane), aend = __shfl(acum, 63), wj = __expf(aend - acum) * dtj;
        LAS unsigned char* XTb = XT + (hh & 1) * 9216;
        { unsigned w[4];
#pragma unroll
          for (int jj = 0; jj < 4; ++jj) { const int j0 = 8 * wave + 2 * jj;
              w[jj] = pk2(bflo(xr[2 * jj]) * __shfl(wj, j0), bflo(xr[2 * jj + 1]) * __shfl(wj, j0 + 1)); }
          *(LAS v4u*)(XTb + lane * 144 + wave * 16) = (v4u){w[0], w[1], w[2], w[3]}; }
        __syncthreads();
        f32x4 acc[4];
#pragma unroll
        for (int pb = 0; pb < 4; ++pb) acc[pb] = (f32x4){0.f, 0.f, 0.f, 0.f};
#pragma unroll
        for (int ks = 0; ks < 2; ++ks) { const bf16x8 wf = *(const LAS bf16x8*)(BT + (16 * wave + fr) * 144 + (32 * ks + 8 * fq) * 2);
#pragma unroll
            for (int pb = 0; pb < 4; ++pb) { const bf16x8 af = *(const LAS bf16x8*)(XTb + (16 * pb + fr) * 144 + (32 * ks + 8 * fq) * 2); acc[pb] = __builtin_amdgcn_mfma_f32_16x16x32_bf16(wf, af, acc[pb], 0, 0, 0); } }
        float* Sp = S + ((((size_t)b * NCH + c) * NH + head) * 64) * 128;
#pragma unroll
        for (int pb = 0; pb < 4; ++pb) *(f32x4*)(Sp + (size_t)(16 * pb + fr) * 128 + 16 * wave + 4 * fq) = acc[pb];
        if (F.tid == 0) DC[(b * NCH + c) * NH + head] = __expf(aend);
    }
    __syncthreads();
}
__device__ __forceinline__ void phase_ssdA(const Ctx& F) { for (int u = F.blk; u < NB * NCH * 4; u += F.G) { const int g = u & 3, bc = u >> 2; ssdA_unit(F, bc / NCH, bc % NCH, g); } }
__device__ __forceinline__ void phase_ssdB(const Ctx& F) {
    float* S = (float*)(F.ws + WS_S); const float* DC = (const float*)(F.ws + WS_DC);
    for (int idx = F.blk * NTHR + F.tid; idx < NB * NH * 64 * 32; idx += F.G * NTHR) {
        const int e4 = idx & 2047, head = (idx >> 11) & 31, b = idx >> 16;
        f32x4 H = {0.f, 0.f, 0.f, 0.f};
        float* sp = S + ((size_t)b * NCH * NH + head) * 8192 + 4 * e4; const float* dp = DC + b * NCH * NH + head;
        f32x4 v0 = *(const f32x4*)sp, v1 = *(const f32x4*)(sp + (size_t)NH * 8192);
        for (int c = 0; c < NCH; ++c) { const f32x4 v2 = (c + 2 < NCH) ? *(const f32x4*)(sp + (size_t)(c + 2) * NH * 8192) : (f32x4){0.f, 0.f, 0.f, 0.f}; const float d = dp[c * NH];
            *(f32x4*)(sp + (size_t)c * NH * 8192) = H; H = H * d + v0; v0 = v1; v1 = v2; }
        *(f32x4*)(F.out + O_PSSD + ((size_t)b * NH + head) * 8192 + 4 * e4) = H;
    }
}
__device__ __forceinline__ void ssdC_unit(const Ctx& F, int b, int c, int g) {
    const float* DT = (const float*)(F.ws + WS_DT); const bf16* XS = (const bf16*)(F.ws + WS_XS); const float* BC = (const float*)(F.ws + WS_BC); const bf16* PZ = (const bf16*)(F.ws + WS_PZ);
    const float* S = (const float*)(F.ws + WS_S); bf16* MIX = (bf16*)(F.ws + WS_MIX);
    const int row0 = b * LP + 64 * c, nq = min(64, LP - 64 * c), lane = F.lane, wave = F.wave, fr = lane & 15, fq = lane >> 4;
    LAS unsigned char* Cs = F.lds; LAS unsigned char* Bs = F.lds + 17408; LAS unsigned char* HB = F.lds + 34816;
    { const int r = F.tid >> 3, n0 = (F.tid & 7) * 16; const bool ok = r < nq; const float* src = BC + (size_t)(row0 + r) * 1024 + g * 128 + n0;
#pragma unroll
      for (int m = 0; m < 2; ++m) {
          f32x4 v[4];
#pragma unroll
          for (int q = 0; q < 4; ++q) v[q] = ok ? *(const f32x4*)(src + m * 512 + 4 * q) : (f32x4){0.f, 0.f, 0.f, 0.f};
          LAS unsigned char* d = (m ? Cs : Bs) + r * 272 + n0 * 2;
          *(LAS v4u*)d = (v4u){pk2(v[0].x, v[0].y), pk2(v[0].z, v[0].w), pk2(v[1].x, v[1].y), pk2(v[1].z, v[1].w)};
          *(LAS v4u*)(d + 16) = (v4u){pk2(v[2].x, v[2].y), pk2(v[2].z, v[2].w), pk2(v[3].x, v[3].y), pk2(v[3].z, v[3].w)}; } }
    __syncthreads();
    const int ib = wave >> 1, tb0 = 2 * (wave & 1);
    f32x4 cb[2] = {{0.f, 0.f, 0.f, 0.f}, {0.f, 0.f, 0.f, 0.f}};
#pragma unroll
    for (int ks = 0; ks < 4; ++ks) { const bf16x8 af = *(const LAS bf16x8*)(Cs + (16 * ib + fr) * 272 + (32 * ks + 8 * fq) * 2);
#pragma unroll
        for (int t = 0; t < 2; ++t) { const bf16x8 wf = *(const LAS bf16x8*)(Bs + (16 * (tb0 + t) + fr) * 272 + (32 * ks + 8 * fq) * 2); cb[t] = __builtin_amdgcn_mfma_f32_16x16x32_bf16(wf, af, cb[t], 0, 0, 0); } }
    const int irow = 16 * ib + fr;
    const int hp_ = F.tid >> 3, hn0 = (F.tid & 7) * 16;
    float dt_n = lane < nq ? DT[(size_t)(row0 + lane) * NH + 8 * g] : 0.f; unsigned xr_n[8]; f32x4 hv_n[4];
#pragma unroll
    for (int jj = 0; jj < 8; ++jj) { const int j0 = 8 * wave + jj; xr_n[jj] = j0 < nq ? (unsigned)XS[(size_t)(row0 + j0) * 2048 + (8 * g) * 64 + lane] : 0u; }
    { const float* hp = S + ((((size_t)b * NCH + c) * NH + 8 * g) * 64 + hp_) * 128 + hn0;
#pragma unroll
      for (int q = 0; q < 4; ++q) hv_n[q] = *(const f32x4*)(hp + 4 * q); }
#pragma unroll 1
    for (int hh = 0; hh < 8; ++hh) {
        const int head = 8 * g + hh; const float Ah = -expf(F.a_log[head]), Dh = F.d_skip[head];
        const float dtj = dt_n; unsigned xr[8]; f32x4 v[4];
#pragma unroll
        for (int jj = 0; jj < 8; ++jj) xr[jj] = xr_n[jj];
#pragma unroll
        for (int q = 0; q < 4; ++q) v[q] = hv_n[q];
        if (hh < 7) { dt_n = lane < nq ? DT[(size_t)(row0 + lane) * NH + head + 1] : 0.f;
#pragma unroll
            for (int jj = 0; jj < 8; ++jj) { const int j0 = 8 * wave + jj; xr_n[jj] = j0 < nq ? (unsigned)XS[(size_t)(row0 + j0) * 2048 + (head + 1) * 64 + lane] : 0u; }
            const float* hp = S + ((((size_t)b * NCH + c) * NH + head + 1) * 64 + hp_) * 128 + hn0;
#pragma unroll
            for (int q = 0; q < 4; ++q) hv_n[q] = *(const f32x4*)(hp + 4 * q); }
        v2u xw[2] = {{0u, 0u}, {0u, 0u}}, zw[2] = {{0u, 0u}, {0u, 0u}};
        if (irow < nq) {
#pragma unroll
            for (int t = 0; t < 2; ++t) { const size_t o = (size_t)(row0 + irow) * 2048 + head * 64 + 16 * (tb0 + t) + 4 * fq; xw[t] = *(const v2u*)(XS + o); zw[t] = *(const v2u*)(PZ + o); } }
        const float acum = wave_scan_incl(dtj * Ah, lane);
        LAS unsigned char* Ms = HB + (hh & 1) * 35840; LAS unsigned char* XT = Ms + 9216; LAS unsigned char* Hs = Ms + 18432;
        const float mi = __shfl(acum, irow);
#pragma unroll
        for (int t = 0; t < 2; ++t) { float mv[4];
#pragma unroll
            for (int e = 0; e < 4; ++e) { const int j = 16 * (tb0 + t) + 4 * fq + e; const float aj = __shfl(acum, j), dj = __shfl(dtj, j);
                mv[e] = (j <= irow) ? cb[t][e] * __expf(fminf(mi - aj, 0.f)) * dj : 0.f; }
            *(LAS v2u*)(Ms + irow * 144 + (16 * (tb0 + t) + 4 * fq) * 2) = (v2u){pk2(mv[0], mv[1]), pk2(mv[2], mv[3])}; }
        *(LAS v4u*)(XT + lane * 144 + wave * 16) = (v4u){xr[0] | (xr[1] << 16), xr[2] | (xr[3] << 16), xr[4] | (xr[5] << 16), xr[6] | (xr[7] << 16)};
        { LAS unsigned char* d = Hs + hp_ * 272 + hn0 * 2;
          *(LAS v4u*)d = (v4u){pk2(v[0].x, v[0].y), pk2(v[0].z, v[0].w), pk2(v[1].x, v[1].y), pk2(v[1].z, v[1].w)};
          *(LAS v4u*)(d + 16) = (v4u){pk2(v[2].x, v[2].y), pk2(v[2].z, v[2].w), pk2(v[3].x, v[3].y), pk2(v[3].z, v[3].w)}; }
        __syncthreads();
        f32x4 acc[2] = {{0.f, 0.f, 0.f, 0.f}, {0.f, 0.f, 0.f, 0.f}};
#pragma unroll
        for (int ks = 0; ks < 4; ++ks) { const bf16x8 af = *(const LAS bf16x8*)(Cs + irow * 272 + (32 * ks + 8 * fq) * 2);
#pragma unroll
            for (int t = 0; t < 2; ++t) { const bf16x8 wf = *(const LAS bf16x8*)(Hs + (16 * (tb0 + t) + fr) * 272 + (32 * ks + 8 * fq) * 2); acc[t] = __builtin_amdgcn_mfma_f32_16x16x32_bf16(wf, af, acc[t], 0, 0, 0); } }
        const float ei = __expf(mi);
#pragma unroll
        for (int t = 0; t < 2; ++t) acc[t] = acc[t] * ei;
#pragma unroll
        for (int ks = 0; ks < 2; ++ks) { const bf16x8 af = *(const LAS bf16x8*)(Ms + irow * 144 + (32 * ks + 8 * fq) * 2);
#pragma unroll
            for (int t = 0; t < 2; ++t) { const bf16x8 wf = *(const LAS bf16x8*)(XT + (16 * (tb0 + t) + fr) * 144 + (32 * ks + 8 * fq) * 2); acc[t] = __builtin_amdgcn_mfma_f32_16x16x32_bf16(wf, af, acc[t], 0, 0, 0); } }
        if (irow < nq) {
#pragma unroll
            for (int t = 0; t < 2; ++t) {
                const float y0 = (acc[t][0] + Dh * bflo(xw[t].x)) * siluf_(bflo(zw[t].x)), y1 = (acc[t][1] + Dh * bfhi(xw[t].x)) * siluf_(bfhi(zw[t].x));
                const float y2 = (acc[t][2] + Dh * bflo(xw[t].y)) * siluf_(bflo(zw[t].y)), y3 = (acc[t][3] + Dh * bfhi(xw[t].y)) * siluf_(bfhi(zw[t].y));
                *(v2u*)(MIX + (size_t)(row0 + irow) * 4096 + 2048 + head * 64 + 16 * (tb0 + t) + 4 * fq) = (v2u){pk2(y0, y1), pk2(y2, y3)}; }
        }
    }
    __syncthreads();
}
__device__ __forceinline__ void phase_ssdC(const Ctx& F) { for (int u = F.blk; u < NB * NCH * 4; u += F.G) { const int g = u & 3, bc = u >> 2; ssdC_unit(F, bc / NCH, bc % NCH, g); } }


#define SEQ_LOAD(cn) do { const int row0n = b * LP + 64 * (cn), nqn = min(64, LP - 64 * (cn)), lastn = nqn - 1;   \
        { const float d_ = DT[(size_t)(row0n + min(lane, lastn)) * NH + head]; pdt = lane < nqn ? d_ : 0.f; } \
        _Pragma("unroll") for (int jj = 0; jj < 8; ++jj) px[jj] = (unsigned)XS[(size_t)(row0n + min(8 * wave + jj, lastn)) * 2048 + head * 64 + lane]; \
        { const bf16* src = BC + (size_t)(row0n + min(sr, lastn)) * 1024 + g * 128 + sn0; \
          pB[0] = *(const v4u*)src; pB[1] = *(const v4u*)(src + 8); pC[0] = *(const v4u*)(src + 512); pC[1] = *(const v4u*)(src + 520); } \
        _Pragma("unroll") for (int t = 0; t < 2; ++t) { const size_t o = (size_t)(row0n + min(irow, lastn)) * 2048 + head * 64 + 16 * (tb0 + t) + 4 * fq; pxw[t] = *(const v2u*)(XS + o); pzw[t] = *(const v2u*)(PZ + o); } \
    } while (0)
#define SEQ_LOAD_FULL(cn) do { const int row0n = b * LP + 64 * (cn); \
        pdt = DT[(size_t)(row0n + lane) * NH + head]; \
        _Pragma("unroll") for (int jj = 0; jj < 8; ++jj) px[jj] = (unsigned)XS[(size_t)(row0n + 8 * wave + jj) * 2048 + head * 64 + lane]; \
        { const float* src = BC + (size_t)(row0n + sr) * 1024 + g * 128 + sn0; \
          _Pragma("unroll") for (int q = 0; q < 4; ++q) { pB[q] = *(const f32x4*)(src + 4 * q); pC[q] = *(const f32x4*)(src + 512 + 4 * q); } } \
        _Pragma("unroll") for (int t = 0; t < 2; ++t) { const size_t o = (size_t)(row0n + irow) * 2048 + head * 64 + 16 * (tb0 + t) + 4 * fq; pxw[t] = *(const v2u*)(XS + o); pzw[t] = *(const v2u*)(PZ + o); } \
    } while (0)
__device__ __forceinline__ void ssd_seq_unit(const Ctx& F, int b, int head) {
    const float* DT = (const float*)(F.ws + WS_DT); const bf16* XS = (const bf16*)(F.ws + WS_XS); const bf16* BC = (const bf16*)(F.ws + WS_BC); const bf16* PZ = (const bf16*)(F.ws + WS_PZ);
    bf16* MIX = (bf16*)(F.ws + WS_MIX);
    const int g = head >> 3, lane = F.lane, wave = F.wave, fr = lane & 15, fq = lane >> 4, ib = wave >> 1, tb0 = 2 * (wave & 1), irow = 16 * ib + fr;
    const int sr = F.tid >> 3, sn0 = (F.tid & 7) * 16;
    const float Ah = -expf(F.a_log[head]), Dh = F.d_skip[head];
    LAS unsigned char* Hs = F.lds + 106496; LAS unsigned char* Ms = F.lds + 123904;
    LAS float* tabA = (LAS float*)(F.lds + 133120); LAS float* tabD = (LAS float*)(F.lds + 133376);
    f32x4 Hacc[4];
#pragma unroll
    for (int pb = 0; pb < 4; ++pb) Hacc[pb] = (f32x4){0.f, 0.f, 0.f, 0.f};
    v4u pB[2], pC[2]; unsigned px[8]; float pdt; v2u pxw[2], pzw[2];
    SEQ_LOAD(0);
#pragma unroll 1
    for (int c = 0; c < NCH; ++c) {
        const int row0 = b * LP + 64 * c, nq = min(64, LP - 64 * c);
        LAS unsigned char* Cs = F.lds + (c & 1) * 53248; LAS unsigned char* Bs = Cs + 17408; LAS unsigned char* XT1 = Cs + 34816; LAS unsigned char* XT2 = Cs + 44032;
        const float dtj = pdt; const float acum = wave_scan_incl(dtj * Ah, lane), aend = __builtin_bit_cast(float, __builtin_amdgcn_readlane(__builtin_bit_cast(int, acum), 63)), wj = __expf(aend - acum) * dtj;
        if (wave == 0) { tabA[lane] = acum; tabD[lane] = dtj; }
        { LAS unsigned char* d = Bs + sr * 272 + sn0 * 2; *(LAS v4u*)d = pB[0]; *(LAS v4u*)(d + 16) = pB[1];
          d = Cs + sr * 272 + sn0 * 2; *(LAS v4u*)d = pC[0]; *(LAS v4u*)(d + 16) = pC[1]; }
        *(LAS v4u*)(XT1 + lane * 144 + wave * 16) = (v4u){px[0] | (px[1] << 16), px[2] | (px[3] << 16), px[4] | (px[5] << 16), px[6] | (px[7] << 16)};
        { unsigned w[4];
#pragma unroll
          for (int jj = 0; jj < 4; ++jj) { const int j0 = 8 * wave + 2 * jj; w[jj] = pk2(bflo(px[2 * jj]) * __builtin_bit_cast(float, __builtin_amdgcn_readlane(__builtin_bit_cast(int, wj), j0)), bflo(px[2 * jj + 1]) * __builtin_bit_cast(float, __builtin_amdgcn_readlane(__builtin_bit_cast(int, wj), j0 + 1))); }
          *(LAS v4u*)(XT2 + lane * 144 + wave * 16) = (v4u){w[0], w[1], w[2], w[3]}; }
        v2u xw[2], zw[2];
#pragma unroll
        for (int t = 0; t < 2; ++t) { xw[t] = pxw[t]; zw[t] = pzw[t]; }
        SEQ_LOAD(min(c + 1, NCH - 1));
        asm volatile("s_waitcnt lgkmcnt(0)" ::: "memory"); __builtin_amdgcn_s_barrier(); asm volatile("" ::: "memory");
        f32x4 cb[2] = {{0.f, 0.f, 0.f, 0.f}, {0.f, 0.f, 0.f, 0.f}}; bf16x8 afr[4];
#pragma unroll
        for (int ks = 0; ks < 4; ++ks) { afr[ks] = *(const LAS bf16x8*)(Cs + irow * 272 + (32 * ks + 8 * fq) * 2);
#pragma unroll
            for (int t = 0; t < 2; ++t) { const bf16x8 wf = *(const LAS bf16x8*)(Bs + (16 * (tb0 + t) + fr) * 272 + (32 * ks + 8 * fq) * 2); cb[t] = __builtin_amdgcn_mfma_f32_16x16x32_bf16(wf, afr[ks], cb[t], 0, 0, 0); } }
        const float mi = tabA[irow];
#pragma unroll
        for (int t = 0; t < 2; ++t) { float mv[4];
            const f32x4 aj4 = *(const LAS f32x4*)(tabA + 16 * (tb0 + t) + 4 * fq), dj4 = *(const LAS f32x4*)(tabD + 16 * (tb0 + t) + 4 * fq);
#pragma unroll
            for (int e = 0; e < 4; ++e) { const int j = 16 * (tb0 + t) + 4 * fq + e;
                mv[e] = (j <= irow) ? cb[t][e] * __expf(fminf(mi - aj4[e], 0.f)) * dj4[e] : 0.f; }
            *(LAS v2u*)(Ms + irow * 144 + (16 * (tb0 + t) + 4 * fq) * 2) = (v2u){pk2(mv[0], mv[1]), pk2(mv[2], mv[3])}; }
#pragma unroll
        for (int pb = 0; pb < 4; ++pb) *(LAS v2u*)(Hs + (16 * pb + fr) * 272 + (16 * wave + 4 * fq) * 2) = (v2u){pk2(Hacc[pb][0], Hacc[pb][1]), pk2(Hacc[pb][2], Hacc[pb][3])};
        asm volatile("s_waitcnt lgkmcnt(0)" ::: "memory"); __builtin_amdgcn_s_barrier(); asm volatile("" ::: "memory");
        f32x4 acc[2] = {{0.f, 0.f, 0.f, 0.f}, {0.f, 0.f, 0.f, 0.f}};
#pragma unroll
        for (int ks = 0; ks < 4; ++ks) {
#pragma unroll
            for (int t = 0; t < 2; ++t) { const bf16x8 wf = *(const LAS bf16x8*)(Hs + (16 * (tb0 + t) + fr) * 272 + (32 * ks + 8 * fq) * 2); acc[t] = __builtin_amdgcn_mfma_f32_16x16x32_bf16(wf, afr[ks], acc[t], 0, 0, 0); } }
        const float ei = __expf(mi);
#pragma unroll
        for (int t = 0; t < 2; ++t) acc[t] = acc[t] * ei;
#pragma unroll
        for (int ks = 0; ks < 2; ++ks) { const bf16x8 af = *(const LAS bf16x8*)(Ms + irow * 144 + (32 * ks + 8 * fq) * 2);
#pragma unroll
            for (int t = 0; t < 2; ++t) { const bf16x8 wf = *(const LAS bf16x8*)(XT1 + (16 * (tb0 + t) + fr) * 144 + (32 * ks + 8 * fq) * 2); acc[t] = __builtin_amdgcn_mfma_f32_16x16x32_bf16(wf, af, acc[t], 0, 0, 0); } }
        if (irow < nq) {
#pragma unroll
            for (int t = 0; t < 2; ++t) {
                const float y0 = (acc[t][0] + Dh * bflo(xw[t].x)) * siluf_(bflo(zw[t].x)), y1 = (acc[t][1] + Dh * bfhi(xw[t].x)) * siluf_(bfhi(zw[t].x));
                const float y2 = (acc[t][2] + Dh * bflo(xw[t].y)) * siluf_(bflo(zw[t].y)), y3 = (acc[t][3] + Dh * bfhi(xw[t].y)) * siluf_(bfhi(zw[t].y));
                *(v2u*)(MIX + (size_t)(row0 + irow) * 4096 + 2048 + head * 64 + 16 * (tb0 + t) + 4 * fq) = (v2u){pk2(y0, y1), pk2(y2, y3)}; }
        }
        const float dec = __expf(aend);
#pragma unroll
        for (int pb = 0; pb < 4; ++pb) Hacc[pb] = Hacc[pb] * dec;
#pragma unroll
        for (int ks = 0; ks < 2; ++ks) {
            unsigned wv[4];
#pragma unroll
            for (int jj = 0; jj < 4; ++jj) { const LAS unsigned char* q = Bs + (32 * ks + 8 * fq + 2 * jj) * 272 + (16 * wave + fr) * 2;
                wv[jj] = (unsigned)*(const LAS unsigned short*)q | ((unsigned)*(const LAS unsigned short*)(q + 272) << 16); }
            const bf16x8 wf = __builtin_bit_cast(bf16x8, (v4u){wv[0], wv[1], wv[2], wv[3]});
#pragma unroll
            for (int pb = 0; pb < 4; ++pb) { const bf16x8 af = *(const LAS bf16x8*)(XT2 + (16 * pb + fr) * 144 + (32 * ks + 8 * fq) * 2); Hacc[pb] = __builtin_amdgcn_mfma_f32_16x16x32_bf16(wf, af, Hacc[pb], 0, 0, 0); }
        }
    }
    float* op = F.out + O_PSSD + ((size_t)b * NH + head) * 8192;
#pragma unroll
    for (int pb = 0; pb < 4; ++pb) *(f32x4*)(op + (size_t)(16 * pb + fr) * 128 + 16 * wave + 4 * fq) = Hacc[pb];
    __syncthreads();
}

__device__ __forceinline__ void phase_scan1(const Ctx& F) {
    constexpr int NPU = NB * NH;
    if (F.G >= 2 * NPU) {
        if (F.blk < NPU) { const int v_ = (F.blk & 7) * (NPU / 8) + (F.blk >> 3);
            ssd_seq_unit(F, v_ >> 5, v_ & 31);
        } else { ssd_sample_blk(F, F.blk - NPU, F.G - NPU);
#ifdef PROBE_S2
            ssd_sample_blk(F, F.blk - NPU, F.G - NPU);
#endif
            lru_aggregate(F, F.blk - NPU, F.G - NPU); }
    } else {
        for (int u = F.blk; u < NPU; u += F.G) ssd_seq_unit(F, u >> 5, u & 31);
        ssd_sample_blk(F, F.blk, F.G); lru_aggregate(F, F.blk, F.G);
    }
}

__device__ __forceinline__ void phase_scan2(const Ctx& F) {
    const float* Ai = (const float*)(F.ws + WS_A); const float* Bi = (const float*)(F.ws + WS_BT); const float* GA = (const float*)(F.ws + WS_AGGA); const float* GH = (const float*)(F.ws + WS_AGGH);
    const bf16* PG = (const bf16*)(F.ws + WS_PG); bf16* MIX = (bf16*)(F.ws + WS_MIX);
    constexpr int NPI = NB * NSEG * 2048, NSI = DB * 2048;
    for (int idx = F.blk * NTHR + F.tid; idx < NPI + NSI; idx += F.G * NTHR) {
        if (idx < NPI) {
            const int ch = idx & 2047, sg = (idx >> 11) % NSEG, b = idx / (2048 * NSEG);
            float hh = 0.f;
            for (int s2 = 0; s2 < sg; s2 += 8) { float ga[8], gh[8];
#pragma unroll
                for (int k = 0; k < 8; ++k) { const int sk = (s2 + k < sg) ? s2 + k : 0; const int o = (b * NSEG + sk) * 2048 + ch; ga[k] = GA[o]; gh[k] = GH[o]; }
#pragma unroll
                for (int k = 0; k < 8; ++k) if (s2 + k < sg) hh = ga[k] * hh + gh[k]; }
            const int t0 = sg * 64, t1 = min(t0 + 64, LP);
            if (t1 - t0 == 64) {
                for (int t = t0; t < t1; t += 32) { float av[32], bv[32]; bf16 gv[32];
#pragma unroll
                    for (int k = 0; k < 32; ++k) { const size_t o = (size_t)(b * LP + t + k) * 2048 + ch; av[k] = Ai[o]; bv[k] = Bi[o]; gv[k] = PG[o]; }
#pragma unroll
                    for (int k = 0; k < 32; ++k) { hh = av[k] * hh + bv[k]; MIX[(size_t)(b * LP + t + k) * 4096 + ch] = (bf16)f2bf(hh * gelu_tanh(bf1(gv[k]))); } }
            } else {
                for (int t = t0; t < t1; t += 16) { float av[16], bv[16]; bf16 gv[16];
#pragma unroll
                    for (int k = 0; k < 16; ++k) { const size_t o = (size_t)(b * LP + t + k) * 2048 + ch; av[k] = Ai[o]; bv[k] = Bi[o]; gv[k] = PG[o]; }
#pragma unroll
                    for (int k = 0; k < 16; ++k) { hh = av[k] * hh + bv[k]; MIX[(size_t)(b * LP + t + k) * 4096 + ch] = (bf16)f2bf(hh * gelu_tanh(bf1(gv[k]))); } }
            }
            if (sg == NSEG - 1) F.out[O_PLH + (size_t)b * 2048 + ch] = hh;
        } else {
            const int i2 = idx - NPI, ch = i2 & 2047, s = i2 >> 11; float hh = 0.f;
#pragma unroll
            for (int j = 0; j < 4; ++j) { const size_t r = (size_t)(MP + 4 * s + j); const size_t o = r * 2048 + ch; hh = Ai[o] * hh + Bi[o];
                MIX[r * 4096 + ch] = (bf16)f2bf(hh * gelu_tanh(bf1(PG[o]))); }
            F.out[O_SLH + (size_t)s * 2048 + ch] = hh;
        }
    }
}

__device__ __forceinline__ void phase_mixnorm(const Ctx& F, bool dry = false) {
    const int gw = F.blk * NWAVES + F.wave, NGW = F.G * NWAVES; bf16* MIX = (bf16*)(F.ws + WS_MIX); bf16* DST = dry ? (bf16*)(F.ws + WS_PART) : MIX;
    for (int m = gw; m < MR; m += NGW) {
        bf16* rowp = MIX + (size_t)m * 4096 + 8 * F.lane; bf16* dstp = DST + (size_t)m * 4096 + 8 * F.lane; v4u w[8]; float ss[8];
#pragma unroll
        for (int j = 0; j < 8; ++j) { w[j] = *(const v4u*)(rowp + 512 * j);
            const float a0 = bflo(w[j].x), a1 = bfhi(w[j].x), a2 = bflo(w[j].y), a3 = bfhi(w[j].y), a4 = bflo(w[j].z), a5 = bfhi(w[j].z), a6 = bflo(w[j].w), a7 = bfhi(w[j].w);
            ss[j] = (a0 * a0 + a1 * a1) + (a2 * a2 + a3 * a3) + (a4 * a4 + a5 * a5) + (a6 * a6 + a7 * a7); }
        const float sl = wave_sum((ss[0] + ss[1]) + (ss[2] + ss[3])); const float rl = rsqrtf(sl * (1.f / 2048) + EPS);
#pragma unroll
        for (int j = 0; j < 8; ++j) {
            float rs = rl; if (j >= 4) rs = rsqrtf(wave_sum(ss[j]) * (1.f / 512) + EPS);
            const float* gp = (j < 4 ? F.g_lru_out + 512 * j : F.g_ssd_out + 512 * (j - 4)) + 8 * F.lane; const f32x4 g0 = *(const f32x4*)gp, g1 = *(const f32x4*)(gp + 4);
            v4u o; o.x = pk2(bflo(w[j].x) * rs * g0.x, bfhi(w[j].x) * rs * g0.y); o.y = pk2(bflo(w[j].y) * rs * g0.z, bfhi(w[j].y) * rs * g0.w);
            o.z = pk2(bflo(w[j].z) * rs * g1.x, bfhi(w[j].z) * rs * g1.y); o.w = pk2(bflo(w[j].w) * rs * g1.z, bfhi(w[j].w) * rs * g1.w);
            *(v4u*)(dstp + 512 * j) = o; }
    }
}


__device__ __forceinline__ f32x4 gemm_out4(const Ctx& F, int m, int j, int nfull, int P, bool& has_res) {
    const int T = (m >> 8) * 8 + j;
    if (T < nfull || P == 1) { has_res = true; return *(const f32x4*)((const float*)(F.ws + WS_PART) + (size_t)m * DM + 4 * F.lane + 256 * j); }
    has_res = false;
    const float* r = (const float*)(F.ws + WS_R2) + (size_t)(T - nfull) * P * 65536 + (size_t)(m & 255) * 256 + 4 * F.lane;
    f32x4 v = *(const f32x4*)r;
    for (int k = 1; k < P; ++k) v += *(const f32x4*)(r + (size_t)k * 65536);
    return v;
}
__device__ __forceinline__ void phase_resid1(const Ctx& F) {
    const int gw = F.blk * NWAVES + F.wave, NGW = F.G * NWAVES; float* X1 = (float*)(F.ws + WS_PART); bf16* HP = (bf16*)(F.ws + WS_HP);
    int nfull, P; pg8::split_params(35 * 8, F.G, 4096 / 64, nfull, P);
    for (int m = gw; m < MR; m += NGW) {
        const float* xr = xrow_ptr(F, m); f32x4 v[8];
#pragma unroll
        for (int j = 0; j < 8; ++j) { bool hr; v[j] = gemm_out4(F, m, j, nfull, P, hr); if (!hr) { v[j] += *(const f32x4*)(xr + 4 * F.lane + 256 * j); *(f32x4*)(X1 + (size_t)m * DM + 4 * F.lane + 256 * j) = v[j]; } }
        rms_row_store(v, F.g_mlp, HP + (size_t)m * DM, F.lane);
    }
}
__device__ __forceinline__ void phase_final(const Ctx& F) {
    const int gw = F.blk * NWAVES + F.wave, NGW = F.G * NWAVES; const float* X1 = (const float*)(F.ws + WS_PART);
    int nfull, P; pg8::split_params(35 * 8, F.G, DFF / 64, nfull, P);
    for (int m = gw; m < MR; m += NGW) {
        float* orow;
        if (m < MP) { const int b = m / LP, t = m - b * LP; if (t < NMETA) continue; orow = F.out + O_YP + ((size_t)b * SEQ + (t - NMETA)) * DM; } else orow = F.out + O_YS + (size_t)(m - MP) * DM;
        f32x4 v[8]; float ss = 0.f;
#pragma unroll
        for (int j = 0; j < 8; ++j) { bool hr; v[j] = gemm_out4(F, m, j, nfull, P, hr); if (!hr) v[j] += *(const f32x4*)(X1 + (size_t)m * DM + 4 * F.lane + 256 * j); ss += (v[j].x * v[j].x + v[j].y * v[j].y) + (v[j].z * v[j].z + v[j].w * v[j].w); }
        const float rs = rsqrtf(wave_sum(ss) * (1.f / DM) + EPS);
#pragma unroll
        for (int j = 0; j < 8; ++j) { const f32x4 gg = *(const f32x4*)(F.g_final + 4 * F.lane + 256 * j); *(f32x4*)(orow + 4 * F.lane + 256 * j) = v[j] * rs * gg; }
    }
}

#define RLX_AGENT __ATOMIC_RELAXED, __HIP_MEMORY_SCOPE_AGENT
constexpr size_t WS_BAR = 4096 * 4;
#define XB_TMO      128
#define XB_XCNT(j)  (256  + 64 * (j))
#define XB_XSUB(j)  (1280 + 64 * (j))
#define XB_XGEN(j)  (2304 + 64 * (j))
#define XB_TOP      3328
#define XB_TOPGEN   3392
#define XCD_BAR_WORDS 3456
#define XB_SPIN_CAP (1u << 18)

__device__ __forceinline__ unsigned xb_ld(unsigned* p)              { return __hip_atomic_load(p, __ATOMIC_RELAXED, __HIP_MEMORY_SCOPE_AGENT); }
__device__ __forceinline__ unsigned xb_add(unsigned* p, unsigned v) { return __hip_atomic_fetch_add(p, v, __ATOMIC_RELAXED, __HIP_MEMORY_SCOPE_AGENT); }
__device__ __forceinline__ unsigned xb_xcc_id() { return (unsigned)__builtin_amdgcn_s_getreg((3 << 11) | 20) & 0xFu; }
#define XB_SPIN(cond, bar) do { unsigned _sp = 0; while (cond) { __builtin_amdgcn_s_sleep(1); \
    if ((++_sp & 255u) == 0u) { if (xb_ld(&(bar)[XB_TMO])) break; if (_sp > XB_SPIN_CAP) { atomicAdd(&(bar)[XB_TMO], 1u); break; } } } } while (0)

struct XcdBarrier {
    unsigned* bar; unsigned x;
    volatile LAS unsigned* st;
};

__device__ __forceinline__ XcdBarrier xcd_barrier_post(unsigned* bar, volatile LAS unsigned* st) {
    XcdBarrier b; b.bar = bar; b.x = xb_xcc_id(); b.st = st;
    if (threadIdx.x == 0) (void)xb_add(&bar[XB_XCNT(b.x)], 1u);
    return b;
}
__device__ __forceinline__ void xcd_barrier_complete(unsigned* bar, unsigned x, unsigned& nloc, unsigned& nx) {
    const unsigned G = gridDim.x * gridDim.y * gridDim.z;
    unsigned sum, cnt, mine, sp = 0u;
    for (;;) {
        sum = 0u; cnt = 0u; mine = 0u;
#pragma unroll
        for (unsigned j = 0; j < 16; ++j) { const unsigned c = xb_ld(&bar[XB_XCNT(j)]); sum += c; cnt += (c > 0u) ? 1u : 0u; mine = (j == x) ? c : mine; }
        if (sum == G) break;
        __builtin_amdgcn_s_sleep(1);
        if ((++sp & 255u) == 0u) { if (xb_ld(&bar[XB_TMO])) break; if (sp > XB_SPIN_CAP) { atomicAdd(&bar[XB_TMO], 1u); break; } }
    }
    nloc = mine > 0u ? mine : 1u; nx = cnt > 0u ? cnt : 1u;
}

__device__ __forceinline__ void xcd_barrier(const XcdBarrier& b) {
    asm volatile("s_waitcnt vmcnt(0)" ::: "memory");
    __syncthreads();
    if (threadIdx.x == 0) {
        unsigned* bar = b.bar;
        __builtin_amdgcn_s_waitcnt(0);
        unsigned nloc = b.st[0], nx = b.st[1];
        if (nloc == 0u) { xcd_barrier_complete(bar, b.x, nloc, nx); b.st[0] = nloc; b.st[1] = nx; }
        const unsigned old = xb_add(&bar[XB_XSUB(b.x)], 1u);
        const unsigned gen = old / nloc;
        if (old + 1u == (gen + 1u) * nloc) {
            __builtin_amdgcn_fence(__ATOMIC_RELEASE, "agent");
            asm volatile("s_waitcnt vmcnt(0)" ::: "memory");
            const unsigned og = xb_add(&bar[XB_TOP], 1u);
            const unsigned tg = og / nx;
            if (og + 1u == (tg + 1u) * nx) xb_add(&bar[XB_TOPGEN], 1u);
            else XB_SPIN(xb_ld(&bar[XB_TOPGEN]) == tg, bar);
            __builtin_amdgcn_fence(__ATOMIC_ACQUIRE, "agent");
            xb_add(&bar[XB_XGEN(b.x)], 1u);
            asm volatile("s_waitcnt vmcnt(0)" ::: "memory");
        } else {
            XB_SPIN(xb_ld(&bar[XB_XGEN(b.x)]) == gen, bar);
            __builtin_amdgcn_fence(__ATOMIC_ACQUIRE, "agent");
            asm volatile("s_waitcnt vmcnt(0)" ::: "memory");
        }
    }
    __syncthreads();
}

__global__ void __launch_bounds__(NTHR, 2) hymba_fwd(Args args) {
    extern __shared__ __attribute__((aligned(16))) unsigned char lds_raw[];
    cg::grid_group grid = cg::this_grid();
    Ctx F;
    F.xp = args.in[0]; F.xs = args.in[1]; F.st_lru_h = args.in[2]; F.st_lru_conv = args.in[3]; F.st_ssd = args.in[4]; F.st_ssd_conv = args.in[5]; F.meta = args.in[6]; F.g_mix = args.in[7];
    F.w_in = args.in[8]; F.conv_lru_w = args.in[9]; F.conv_lru_b = args.in[10]; F.lru_wa = args.in[11]; F.lru_ba = args.in[12]; F.lru_wx = args.in[13]; F.lru_bx = args.in[14]; F.lru_lam = args.in[15];
    F.g_lru_out = args.in[16]; F.conv_ssd_w = args.in[17]; F.conv_ssd_b = args.in[18]; F.dt_bias = args.in[19]; F.a_log = args.in[20]; F.d_skip = args.in[21]; F.g_ssd_out = args.in[22];
    F.w_out = args.in[23]; F.g_mlp = args.in[24]; F.w_up = args.in[25]; F.w_down = args.in[26]; F.g_final = args.in[27];
    F.out = args.out; F.ws = args.ws; F.lds = (LAS unsigned char*)lds_raw;
    F.tid = threadIdx.x; F.lane = F.tid & 63; F.wave = __builtin_amdgcn_readfirstlane(F.tid >> 6); F.blk = blockIdx.x; F.G = gridDim.x;
    const int lo = args.ph_lo, hi = args.ph_hi;
    volatile LAS unsigned* bst = (volatile LAS unsigned*)(F.lds + LDS_BYTES - 64);
    if (F.tid < 16) bst[F.tid] = 0u;
    __syncthreads();
    XcdBarrier xbar; xbar.bar = (unsigned*)(F.ws + WS_BAR); xbar.x = 0; xbar.st = bst;
    if (hi - lo > 1) xbar = xcd_barrier_post((unsigned*)(F.ws + WS_BAR), bst);
    if (hi - lo > 1) grid.sync();
#define IN(k) (lo <= (k) && (k) < hi)
#ifndef PROBE_PH
#define PROBE_PH -1
#endif
#define REPS(k) for (int rep_ = 0; rep_ < (PROBE_PH == (k) ? 2 : 1); ++rep_)
#ifndef PROBE_SYNC
#define PROBE_SYNC 1
#endif
#define SEAM(k) do { if (IN(k) && IN((k) + 1)) { for (int s_ = 0; s_ < PROBE_SYNC; ++s_) { xcd_barrier(xbar); } } } while (0)
    if (IN(0)) REPS(0) phase_prologue(F);
    SEAM(0);
    if (IN(1)) {
        {
        pg8::Gemm g{(const pg8::bf16_t*)(F.ws + WS_XN), (const pg8::bf16_t*)(F.ws + WS_WIN), MPAD, NMAIN, 2048}; pg8::StaticOrder S; S.init(MPAD, NMAIN, F.G, F.blk, 2048);
        pg8::EpiProj E{(bf16*)(F.ws + WS_PG), (bf16*)(F.ws + WS_PXL), (bf16*)(F.ws + WS_PZ), (bf16*)(F.ws + WS_PXBC)};
        pg8::gemm_phase<pg8::EpiProj, pg8::StaticOrder, PG8_ALIGN, PG8_SP2>(F.lds, g, S, E);
        phase_dt(F);
            }
        if (PROBE_PH == 1) {
        pg8::Gemm g{(const pg8::bf16_t*)(F.ws + WS_XN), (const pg8::bf16_t*)(F.ws + WS_WIN), MPAD, NMAIN, 2048}; pg8::StaticOrder S; S.init(MPAD, NMAIN, F.G, F.blk, 2048);
        pg8::EpiProj E{(bf16*)(F.ws + WS_PG), (bf16*)(F.ws + WS_PXL), (bf16*)(F.ws + WS_PZ), (bf16*)(F.ws + WS_PXBC)};
        pg8::gemm_phase<pg8::EpiProj, pg8::StaticOrder, PG8_ALIGN, PG8_SP2>(F.lds, g, S, E);
        phase_dt(F);
            }
    }
    SEAM(1);
    if (IN(2)) REPS(2) phase_conv(F);
    SEAM(2);
    if (IN(3)) REPS(3) { phase_gates(F); __syncthreads(); }
    SEAM(3);
    if (IN(4)) REPS(4) phase_scan1(F);
    SEAM(4);
    if (IN(5)) REPS(5) phase_scan2(F);
    SEAM(5);
    if (IN(6)) { if (PROBE_PH == 6) phase_mixnorm(F, true); phase_mixnorm(F); }
    SEAM(6);
    if (IN(7)) {
        {
        pg8::Gemm g{(const pg8::bf16_t*)(F.ws + WS_MIX), (const pg8::bf16_t*)(F.ws + WS_WOUT), MPAD, 2048, 4096}; pg8::SplitOrder S; S.init(MPAD, 2048, F.G, F.blk, 4096);
        pg8::EpiF32S E{(float*)(F.ws + WS_PART), 2048, (float*)(F.ws + WS_R2), S.nN, S.nfull, S.P, 2, nullptr, F.xp, F.xs, F.meta};
        pg8::gemm_phase<pg8::EpiF32S, pg8::SplitOrder, PG8_ALIGN, PG8_SP2>(F.lds, g, S, E);
            }
        if (PROBE_PH == 7) {
        pg8::Gemm g{(const pg8::bf16_t*)(F.ws + WS_MIX), (const pg8::bf16_t*)(F.ws + WS_WOUT), MPAD, 2048, 4096}; pg8::SplitOrder S; S.init(MPAD, 2048, F.G, F.blk, 4096);
        pg8::EpiF32S E{(float*)(F.ws + WS_PART), 2048, (float*)(F.ws + WS_R2), S.nN, S.nfull, S.P, 2, nullptr, F.xp, F.xs, F.meta};
        pg8::gemm_phase<pg8::EpiF32S, pg8::SplitOrder, PG8_ALIGN, PG8_SP2>(F.lds, g, S, E);
            }
    }
    SEAM(7);
    if (IN(8)) REPS(8) phase_resid1(F);
    SEAM(8);
    if (IN(9)) {
        {
        pg8::Gemm g{(const pg8::bf16_t*)(F.ws + WS_HP), (const pg8::bf16_t*)(F.ws + WS_WUP), MPAD, DFF, 2048}; pg8::StaticOrder S; S.init(MPAD, DFF, F.G, F.blk, 2048);
        pg8::EpiRelu2 E{(bf16*)(F.ws + WS_H), DFF};
        pg8::gemm_phase<pg8::EpiRelu2, pg8::StaticOrder, PG8_ALIGN, PG8_SP2>(F.lds, g, S, E);
        { int part, nparts; slack_parts(35 * 32, F.G, F.blk, part, nparts); if (part >= 0) convert_range(F, I_IN + I_OUT + I_UP, I_IN + I_OUT + I_UP + I_DN, part, nparts); }
            }
        if (PROBE_PH == 9) { __syncthreads();
        pg8::Gemm g{(const pg8::bf16_t*)(F.ws + WS_HP), (const pg8::bf16_t*)(F.ws + WS_WUP), MPAD, DFF, 2048}; pg8::StaticOrder S; S.init(MPAD, DFF, F.G, F.blk, 2048);
        pg8::EpiRelu2 E{(bf16*)(F.ws + WS_H), DFF};
        pg8::gemm_phase<pg8::EpiRelu2, pg8::StaticOrder, PG8_ALIGN, PG8_SP2>(F.lds, g, S, E);
        { int part, nparts; slack_parts(35 * 32, F.G, F.blk, part, nparts); if (part >= 0) convert_range(F, I_IN + I_OUT + I_UP, I_IN + I_OUT + I_UP + I_DN, part, nparts); }
            }
    }
    SEAM(9);
    if (IN(10)) {
        {
        pg8::Gemm g{(const pg8::bf16_t*)(F.ws + WS_H), (const pg8::bf16_t*)(F.ws + WS_WDN), MPAD, 2048, DFF}; pg8::SplitOrder S; S.init(MPAD, 2048, F.G, F.blk, DFF);
        pg8::EpiF32S E{(float*)(F.ws + WS_PART), 2048, (float*)(F.ws + WS_R2), S.nN, S.nfull, S.P, 1, (const float*)(F.ws + WS_PART), nullptr, nullptr, nullptr};
        pg8::gemm_phase<pg8::EpiF32S, pg8::SplitOrder, PG8_ALIGN, PG8_SP2>(F.lds, g, S, E);
            }
        if (PROBE_PH == 10) {
        pg8::Gemm g{(const pg8::bf16_t*)(F.ws + WS_H), (const pg8::bf16_t*)(F.ws + WS_WDN), MPAD, 2048, DFF}; pg8::SplitOrder S; S.init(MPAD, 2048, F.G, F.blk, DFF);
        pg8::EpiF32S E{(float*)(F.ws + WS_PART), 2048, (float*)(F.ws + WS_R2), S.nN, S.nfull, S.P, 1, (const float*)(F.ws + WS_PART), nullptr, nullptr, nullptr};
        pg8::gemm_phase<pg8::EpiF32S, pg8::SplitOrder, PG8_ALIGN, PG8_SP2>(F.lds, g, S, E);
            }
    }
    SEAM(10);
    if (IN(11)) REPS(11) phase_final(F);
#undef IN
#undef SEAM
}

#ifndef N_LAUNCH_MODE
#define N_LAUNCH_MODE 1
#endif
extern "C" void kernel_launch(void* const* d_in, const int* in_sizes, int n_in, void* d_out, int out_size, void* d_ws, size_t ws_size, hipStream_t stream) {
    static int grid = 0;
    if (grid == 0) {
        if (n_in != 28 || (size_t)out_size != O_END || ws_size < WS_END) { fprintf(stderr, "kernel_launch: unexpected shapes: n_in %d out %d ws %zu\n", n_in, out_size, ws_size); grid = -1; return; }
        int dev = 0, cus = 0, per_cu = 0;
        (void)hipGetDevice(&dev); (void)hipDeviceGetAttribute(&cus, hipDeviceAttributeMultiprocessorCount, dev);
        if (hipFuncSetAttribute((const void*)hymba_fwd, hipFuncAttributeMaxDynamicSharedMemorySize, LDS_BYTES) != hipSuccess) { fprintf(stderr, "kernel_launch: hipFuncSetAttribute failed\n"); grid = -1; return; }
        if (hipOccupancyMaxActiveBlocksPerMultiprocessor(&per_cu, (const void*)hymba_fwd, NTHR, LDS_BYTES) != hipSuccess || per_cu < 1) { fprintf(stderr, "kernel_launch: occupancy query says %d\n", per_cu); per_cu = 1; }
        (void)hipGetLastError();
        grid = cus * 1;
        if (grid <= 0) grid = 256;
    }
    if (grid < 0) return;
    Args a{};
    for (int i = 0; i < 28; ++i) a.in[i] = (const float*)d_in[i];
    a.out = (float*)d_out; a.ws = (unsigned char*)d_ws;
#if N_LAUNCH_MODE == 1
    (void)hipMemsetAsync((char*)d_ws + WS_BAR, 0, XCD_BAR_WORDS * 4, stream);
    a.ph_lo = 0; a.ph_hi = NPHASE;
    void* kargs[] = {&a};
    hipError_t e = hipLaunchCooperativeKernel((const void*)hymba_fwd, dim3(grid), dim3(NTHR), kargs, LDS_BYTES, stream);
    if (e != hipSuccess) fprintf(stderr, "cooperative launch failed: %s (grid %d)\n", hipGetErrorString(e), grid);
#else
    for (int p = 0; p < NPHASE; ++p) { a.ph_lo = p; a.ph_hi = p + 1; hipLaunchKernelGGL(hymba_fwd, dim3(grid), dim3(NTHR), LDS_BYTES, stream, a); }
#endif
}
```

```cpp
#include <hip/hip_runtime.h>
#include <hip/hip_cooperative_groups.h>
#include <cstdio>
#include <cstdint>
namespace cg = cooperative_groups;
namespace pg8 {
#define PG8_LAS __attribute__((address_space(3)))
typedef unsigned short bf16_t;
typedef short bf16x8 __attribute__((ext_vector_type(8)));
typedef float f32x4 __attribute__((ext_vector_type(4)));
typedef unsigned u32x4 __attribute__((ext_vector_type(4)));
constexpr int BM = 256, BK = 64, HALF = 128, HTB = HALF * BK * 2  , STAGE_BYTES = 8 * HTB, NXCD = 8, WGM = 8;

__host__ __device__ __forceinline__ int lds_byte(int r, int c) { const int st = (r >> 4) * 2 + (c >> 5), rr = r & 15, cc = c & 31, ob = rr * 64 + cc * 2; return st * 1024 + (ob ^ (((ob >> 9) & 1) << 5)); }
__host__ __device__ __forceinline__ void stage_rc(int b, int& R, int& C) { const int st = b / 1024, sb = b % 1024, swz = sb ^ (((sb >> 9) & 1) << 5); R = (st >> 1) * 16 + swz / 64; C = (st & 1) * 32 + (swz % 64) / 2; }
__host__ __device__ __forceinline__ int perm32(int rho) { const int n = rho >> 4, i = rho & 15; return 8 * (i >> 2) + 4 * n + (i & 3); }

struct Unit { int pm, pn, kt0, nt, slot; };
struct Gemm { const bf16_t* A; const bf16_t* Bt; int M, N, K; };

struct StaticOrder {
    int nM, nN, nwg, G, c, ntk;
    __host__ __device__ __forceinline__ void init(int M, int N, int G_, int c_, int K_) { nM = M / BM; nN = N / BM; nwg = nM * nN; G = G_; c = c_; ntk = K_ / BK; }
    __host__ __device__ __forceinline__ bool next(int i, Unit& u) const {
        const long L = (long)i * G + c; if (L >= nwg) return false;
        int wgid = (int)L; { const int q = nwg / NXCD, r = nwg % NXCD, xcd = wgid % NXCD, off = wgid / NXCD; wgid = (xcd < r ? xcd * (q + 1) : r * (q + 1) + (xcd - r) * q) + off; }
        const int nig = WGM * nN, gid = wgid / nig, fm = gid * WGM, gsz = (nM - fm) < WGM ? (nM - fm) : WGM;
        u.pm = fm + ((wgid % nig) % gsz); u.pn = (wgid % nig) / gsz; u.kt0 = 0; u.nt = ntk; u.slot = -1; return true;
    }
    __device__ __forceinline__ void a_ready(const Unit&) const {}
    __device__ __forceinline__ void done(const Unit&) const {}
};


__host__ __device__ __forceinline__ void split_params(int nwg, int G, int ntk, int& nfull, int& P) {
    nfull = (nwg / G) * G; const int rem = nwg - nfull; P = 1;
    if (rem > 0) { int p = G / rem; p = p >= 8 ? 8 : (p >= 4 ? 4 : (p >= 2 ? 2 : 1)); while (p > 1 && ((ntk / p) < 4 || (ntk % (2 * p)) != 0)) p >>= 1; P = p; }
}
struct SplitOrder {
    int nN, nwg, G, c, ntk, nfull, P, perm;
    __host__ __device__ __forceinline__ void init(int M, int N, int G_, int c_, int K_) { nN = N / BM; nwg = (M / BM) * nN; G = G_; c = c_; ntk = K_ / BK; split_params(nwg, G, ntk, nfull, P);
        perm = (G % NXCD == 0) ? (c % NXCD) * (G / NXCD) + c / NXCD : c; }
    __host__ __device__ __forceinline__ bool next(int i, Unit& u) const {
        const int rounds = nfull / G;
        if (i < rounds) { const int T = i * G + perm; u.pm = T / nN; u.pn = T % nN; u.kt0 = 0; u.nt = ntk; u.slot = -1; return true; }
        int j = (i - rounds) * G + c; const int rem = nwg - nfull;
        if (j >= rem * P) return false;
        const int T = nfull + j / P, pc = j % P; u.pm = T / nN; u.pn = T % nN; u.nt = ntk / P; u.kt0 = pc * u.nt; u.slot = (P > 1) ? pc : -1; return true;
    }
    __device__ __forceinline__ void a_ready(const Unit&) const {}
    __device__ __forceinline__ void done(const Unit&) const {}
};
__device__ __forceinline__ unsigned cvt_pk_bf16(float lo, float hi) { unsigned r; asm volatile("v_cvt_pk_bf16_f32 %0, %1, %2" : "=v"(r) : "v"(lo), "v"(hi)); return r; }
struct EpiF32 {
    static constexpr bool PERM = false, AFTER_DRAIN = false;
    float* C; int ldc;
    __device__ __forceinline__ void operator()(const f32x4 (&acc)[2][2][4][2], const Unit& u, int wr, int wc, int fr, int fq) const {
        const int row0 = u.pm * BM + wr * 64 + fr, col0 = u.pn * BM + wc * 32 + 4 * fq;
#pragma unroll
        for (int ai = 0; ai < 2; ++ai)
#pragma unroll
            for (int m = 0; m < 4; ++m) { float* rowp = C + (size_t)(row0 + ai * HALF + m * 16) * ldc + col0;
#pragma unroll
                for (int bj = 0; bj < 2; ++bj)
#pragma unroll
                    for (int n = 0; n < 2; ++n) *(f32x4*)(rowp + bj * HALF + n * 16) = acc[ai][bj][m][n]; }
    }
};
struct EpiProj {
    static constexpr bool PERM = true, AFTER_DRAIN = false;
    bf16_t *PG, *PXL, *PZ, *PXBC;
    __device__ __forceinline__ void operator()(const f32x4 (&acc)[2][2][4][2], const Unit& u, int wr, int wc, int fr, int fq) const {
        const int row0 = u.pm * BM + wr * 64 + fr;
        bf16_t* base; int ldc, colt;
        if (u.pn < 8) { base = PG; ldc = 2048; colt = u.pn * 256; }
        else if (u.pn < 16) { base = PXL; ldc = 2048; colt = (u.pn - 8) * 256; }
        else if (u.pn < 24) { base = PZ; ldc = 2048; colt = (u.pn - 16) * 256; }
        else { base = PXBC; ldc = 3072; colt = (u.pn - 24) * 256; }
        const int col0 = colt + wc * 32 + 8 * fq;
#pragma unroll
        for (int ai = 0; ai < 2; ++ai)
#pragma unroll
            for (int m = 0; m < 4; ++m) { bf16_t* rowp = base + (size_t)(row0 + ai * HALF + m * 16) * ldc + col0;
#pragma unroll
                for (int bj = 0; bj < 2; ++bj) { const f32x4 v0 = acc[ai][bj][m][0], v1 = acc[ai][bj][m][1];
                    u32x4 w; w.x = cvt_pk_bf16(v0[0], v0[1]); w.y = cvt_pk_bf16(v0[2], v0[3]); w.z = cvt_pk_bf16(v1[0], v1[1]); w.w = cvt_pk_bf16(v1[2], v1[3]);
                    *(u32x4*)(rowp + bj * HALF) = w; } }
    }
};
struct EpiRelu2 {
    static constexpr bool PERM = true, AFTER_DRAIN = false;
    bf16_t* O; int ldc;
    __device__ __forceinline__ void operator()(const f32x4 (&acc)[2][2][4][2], const Unit& u, int wr, int wc, int fr, int fq) const {
        const int row0 = u.pm * BM + wr * 64 + fr, col0 = u.pn * BM + wc * 32 + 8 * fq;
#pragma unroll
        for (int ai = 0; ai < 2; ++ai)
#pragma unroll
            for (int m = 0; m < 4; ++m) { bf16_t* rowp = O + (size_t)(row0 + ai * HALF + m * 16) * ldc + col0;
#pragma unroll
                for (int bj = 0; bj < 2; ++bj) { f32x4 v0 = acc[ai][bj][m][0], v1 = acc[ai][bj][m][1];
#pragma unroll
                    for (int e = 0; e < 4; ++e) { const float p = fmaxf(v0[e], 0.f), q = fmaxf(v1[e], 0.f); v0[e] = p * p; v1[e] = q * q; }
                    u32x4 w; w.x = cvt_pk_bf16(v0[0], v0[1]); w.y = cvt_pk_bf16(v0[2], v0[3]); w.z = cvt_pk_bf16(v1[0], v1[1]); w.w = cvt_pk_bf16(v1[2], v1[3]);
                    *(u32x4*)(rowp + bj * HALF) = w; } }
    }
};

struct EpiF32S {
    static constexpr bool PERM = false, AFTER_DRAIN = false;
    float* C; int ldc; float* R2; int nN, nfull, P; int mode; const float* res; const float* xp; const float* xs; const float* meta;
    __device__ __forceinline__ const float* rrow(int r) const {
        if (mode == 1) return res + (size_t)r * ldc;
        if (r >= 8768) r = 8767;
        if (r < 8256) { const int b = r / 2064, t = r - b * 2064; return t < 16 ? meta + (size_t)t * 2048 : xp + ((size_t)b * 2048 + (t - 16)) * 2048; }
        return xs + (size_t)(r - 8256) * 2048;
    }
    __device__ __forceinline__ void operator()(const f32x4 (&acc)[2][2][4][2], const Unit& u, int wr, int wc, int fr, int fq) const {
        const int r0 = wr * 64 + fr, c0 = wc * 32 + 4 * fq;
        if (u.slot < 0) {
#pragma unroll
            for (int ai = 0; ai < 2; ++ai)
#pragma unroll
                for (int m = 0; m < 4; ++m) { const int row = u.pm * BM + r0 + ai * HALF + m * 16; float* rowp = C + (size_t)row * ldc + u.pn * BM + c0; const float* rp = rrow(row) + u.pn * BM + c0;
#pragma unroll
                    for (int bj = 0; bj < 2; ++bj)
#pragma unroll
                        for (int n = 0; n < 2; ++n) *(f32x4*)(rowp + bj * HALF + n * 16) = acc[ai][bj][m][n] + *(const f32x4*)(rp + bj * HALF + n * 16);
                    if (m & 1) asm volatile("" ::: "memory"); }
        } else {
            float* base = R2 + ((size_t)((u.pm * nN + u.pn - nfull) * P + u.slot)) * 65536;
#pragma unroll
            for (int ai = 0; ai < 2; ++ai)
#pragma unroll
                for (int m = 0; m < 4; ++m) { float* rowp = base + (size_t)(r0 + ai * HALF + m * 16) * 256 + c0;
#pragma unroll
                    for (int bj = 0; bj < 2; ++bj)
#pragma unroll
                        for (int n = 0; n < 2; ++n) *(f32x4*)(rowp + bj * HALF + n * 16) = acc[ai][bj][m][n]; }
        }
    }
};
template <class Epi, class Sched, bool ALIGN_EPI = false, bool SP2 = false>
__device__ __forceinline__ void gemm_phase(PG8_LAS unsigned char* lds, const Gemm g, const Sched& S, const Epi& E) {
    const int tid = threadIdx.x, wid = __builtin_amdgcn_readfirstlane(tid >> 6), lane = tid & 63, wr = wid >> 2, wc = wid & 3, fr = lane & 15, fq = lane >> 4;
    const int K = g.K;
    unsigned voffA[2], voffB[2];
#pragma unroll
    for (int i = 0; i < 2; ++i) { int R, C; stage_rc(tid * 16 + i * 8192, R, C); const int Rb = Epi::PERM ? ((R & ~31) + perm32(R & 31)) : R;
        voffA[i] = (unsigned)(R * K + C) * 2u; voffB[i] = (unsigned)(Rb * K + C) * 2u; }
    const size_t kstep = (size_t)(BK * 2);
    const size_t hstep = (size_t)HALF * K * 2;
    const size_t tstep = 2 * hstep;
    const unsigned ldsw = (unsigned)wid * 1024u;
    const int aoff = lds_byte(wr * 64 + fr, fq * 8), boff = lds_byte(wc * 32 + fr, fq * 8);
#define PG8_SA(b, h) (((b) * 2 + (h)) * HTB)
#define PG8_SB(b, h) ((4 + (b) * 2 + (h)) * HTB)
#define PG8_STAGE(bufoff, gbase, voff) do { _Pragma("unroll") for (int _i = 0; _i < 2; ++_i) \
        __builtin_amdgcn_global_load_lds((const unsigned*)((const char*)(gbase) + (voff)[_i]), (PG8_LAS unsigned*)(lds + (bufoff) + ldsw + _i * 8192), 16, 0, 0); } while (0)
#define PG8_LDA(dst, b, h) do { _Pragma("unroll") for (int m = 0; m < 4; ++m) _Pragma("unroll") for (int k = 0; k < 2; ++k) dst[m][k] = *(const PG8_LAS bf16x8*)(lds + PG8_SA(b, h) + aoff + m * 2048 + k * 1024); } while (0)
#define PG8_LDB(dst, b, h) do { _Pragma("unroll") for (int n = 0; n < 2; ++n) _Pragma("unroll") for (int k = 0; k < 2; ++k) dst[n][k] = *(const PG8_LAS bf16x8*)(lds + PG8_SB(b, h) + boff + n * 2048 + k * 1024); } while (0)
#define PG8_MMA(ai, bj, At, Bt) do { __builtin_amdgcn_s_setprio(1); _Pragma("unroll") for (int m = 0; m < 4; ++m) _Pragma("unroll") for (int n = 0; n < 2; ++n) _Pragma("unroll") for (int k = 0; k < 2; ++k) \
        acc[ai][bj][m][n] = __builtin_amdgcn_mfma_f32_16x16x32_bf16(Bt[n][k], At[m][k], acc[ai][bj][m][n], 0, 0, 0); __builtin_amdgcn_s_setprio(0); } while (0)
#define PG8_WAIT_V(n) asm volatile("s_waitcnt vmcnt(" #n ")" ::: "memory")
#define PG8_WAIT_L(n) asm volatile("s_waitcnt lgkmcnt(" #n ")" ::: "memory")
#define PG8_BAR __builtin_amdgcn_s_barrier()
#define PG8_SCHED __builtin_amdgcn_sched_barrier(0)
    Unit cur, nxt; int ui = 0;
    if (!S.next(0, cur)) return;
    f32x4 acc[2][2][4][2];
#pragma unroll
    for (int a = 0; a < 2; ++a)
#pragma unroll
        for (int b = 0; b < 2; ++b)
#pragma unroll
            for (int m = 0; m < 4; ++m)
#pragma unroll
                for (int n = 0; n < 2; ++n) acc[a][b][m][n] = (f32x4){0.f, 0.f, 0.f, 0.f};
    bf16x8 At[4][2], B0[2][2], B1[2][2];
    const char* cA = (const char*)g.A + (size_t)cur.pm * tstep + (size_t)cur.kt0 * kstep; const char* cB = (const char*)g.Bt + (size_t)cur.pn * tstep + (size_t)cur.kt0 * kstep;
    S.a_ready(cur);
    if constexpr (SP2) {
        PG8_STAGE(PG8_SB(0, 0), cB, voffB); PG8_STAGE(PG8_SB(0, 1), cB + hstep, voffB); PG8_STAGE(PG8_SA(0, 0), cA, voffA); PG8_STAGE(PG8_SA(0, 1), cA + hstep, voffA);
        if (wr == 1) PG8_BAR;
        PG8_WAIT_V(2); PG8_BAR;
        PG8_STAGE(PG8_SB(1, 0), cB + kstep, voffB); PG8_STAGE(PG8_SA(1, 0), cA + kstep, voffA); PG8_STAGE(PG8_SB(1, 1), cB + hstep + kstep, voffB);
        PG8_WAIT_V(6); PG8_BAR;
    } else {
        PG8_STAGE(PG8_SB(0, 0), cB, voffB); PG8_STAGE(PG8_SA(0, 0), cA, voffA); PG8_STAGE(PG8_SB(0, 1), cB + hstep, voffB); PG8_STAGE(PG8_SA(0, 1), cA + hstep, voffA);
        if (wr == 1) PG8_BAR;
        PG8_WAIT_V(4); PG8_BAR;
        PG8_STAGE(PG8_SB(1, 0), cB + kstep, voffB); PG8_STAGE(PG8_SA(1, 0), cA + kstep, voffA); PG8_STAGE(PG8_SB(1, 1), cB + hstep + kstep, voffB);
        PG8_WAIT_V(6); PG8_BAR;
    }
    for (;;) {
        const bool has_next = S.next(ui + 1, nxt);
        const char* nA = has_next ? (const char*)g.A + (size_t)nxt.pm * tstep + (size_t)nxt.kt0 * kstep : cA; const char* nB = has_next ? (const char*)g.Bt + (size_t)nxt.pn * tstep + (size_t)nxt.kt0 * kstep : cB;
        const int nt = cur.nt;
        for (int t = 0; t < nt; t += 2) {
            const bool last = (t == nt - 2);
            const char* a1 = cA + (size_t)(t + 1) * kstep;
            const char* a2 = last ? nA : cA + (size_t)(t + 2) * kstep; const char* b2 = last ? nB : cB + (size_t)(t + 2) * kstep;
            const char* a3 = a2 + kstep; const char* b3 = b2 + kstep;
            if (last && has_next) S.a_ready(nxt);
            if constexpr (SP2) {
            PG8_LDB(B0, 0, 0); PG8_LDB(B1, 0, 1); PG8_SCHED; PG8_LDA(At, 0, 0); PG8_STAGE(PG8_SA(1, 1), a1 + hstep, voffA);
            PG8_WAIT_V(8); PG8_WAIT_L(0); PG8_BAR; PG8_MMA(0, 0, At, B0); PG8_MMA(0, 1, At, B1); PG8_BAR; PG8_SCHED;
            PG8_LDA(At, 0, 1); PG8_STAGE(PG8_SB(0, 0), b2, voffB); PG8_STAGE(PG8_SB(0, 1), b2 + hstep, voffB); PG8_STAGE(PG8_SA(0, 0), a2, voffA);
            PG8_WAIT_V(8); PG8_WAIT_L(0); PG8_BAR; PG8_MMA(1, 0, At, B0); PG8_MMA(1, 1, At, B1); PG8_BAR; PG8_SCHED;
            PG8_LDB(B0, 1, 0); PG8_LDB(B1, 1, 1); PG8_SCHED; PG8_LDA(At, 1, 0); PG8_STAGE(PG8_SA(0, 1), a2 + hstep, voffA);
            PG8_WAIT_V(8); PG8_WAIT_L(0); PG8_BAR; PG8_MMA(0, 0, At, B0); PG8_MMA(0, 1, At, B1); PG8_BAR; PG8_SCHED;
            PG8_LDA(At, 1, 1); PG8_STAGE(PG8_SB(1, 0), b3, voffB); PG8_STAGE(PG8_SB(1, 1), b3 + hstep, voffB); PG8_STAGE(PG8_SA(1, 0), a3, voffA);
            PG8_WAIT_V(8); PG8_WAIT_L(0); PG8_BAR; PG8_MMA(1, 0, At, B0); PG8_MMA(1, 1, At, B1); PG8_BAR; PG8_SCHED;
            } else {
            PG8_LDB(B0, 0, 0); PG8_SCHED; PG8_LDA(At, 0, 0); PG8_STAGE(PG8_SA(1, 1), a1 + hstep, voffA);
            PG8_WAIT_L(8); PG8_BAR; PG8_WAIT_L(0); PG8_MMA(0, 0, At, B0); PG8_BAR; PG8_SCHED;
            PG8_LDB(B1, 0, 1); PG8_STAGE(PG8_SB(0, 0), b2, voffB);
            PG8_BAR; PG8_WAIT_L(0); PG8_MMA(0, 1, At, B1); PG8_BAR;
            PG8_LDA(At, 0, 1); PG8_STAGE(PG8_SA(0, 0), a2, voffA);
            PG8_BAR; PG8_WAIT_L(0); PG8_MMA(1, 0, At, B0); PG8_BAR; PG8_SCHED;
            PG8_STAGE(PG8_SB(0, 1), b2 + hstep, voffB);
            PG8_WAIT_V(6); PG8_BAR; PG8_MMA(1, 1, At, B1); PG8_BAR;
            PG8_LDB(B0, 1, 0); PG8_SCHED; PG8_LDA(At, 1, 0); PG8_STAGE(PG8_SA(0, 1), a2 + hstep, voffA);
            PG8_WAIT_L(8); PG8_BAR; PG8_WAIT_L(0); PG8_MMA(0, 0, At, B0); PG8_BAR; PG8_SCHED;
            PG8_LDB(B1, 1, 1); PG8_STAGE(PG8_SB(1, 0), b3, voffB);
            PG8_BAR; PG8_WAIT_L(0); PG8_MMA(0, 1, At, B1); PG8_BAR;
            PG8_LDA(At, 1, 1); PG8_STAGE(PG8_SA(1, 0), a3, voffA);
            PG8_BAR; PG8_WAIT_L(0); PG8_MMA(1, 0, At, B0); PG8_BAR; PG8_SCHED;
            PG8_STAGE(PG8_SB(1, 1), b3 + hstep, voffB);
            PG8_WAIT_V(6); PG8_BAR; PG8_MMA(1, 1, At, B1); PG8_BAR;
            }
        }
        if constexpr (ALIGN_EPI) { if (wr == 0) PG8_BAR; }
        if constexpr (!Epi::AFTER_DRAIN) { E(acc, cur, wr, wc, fr, fq); S.done(cur); }
        if (!has_next) break;
#pragma unroll
        for (int a = 0; a < 2; ++a)
#pragma unroll
            for (int b = 0; b < 2; ++b)
#pragma unroll
                for (int m = 0; m < 4; ++m)
#pragma unroll
                    for (int n = 0; n < 2; ++n) acc[a][b][m][n] = (f32x4){0.f, 0.f, 0.f, 0.f};
        cur = nxt; cA = nA; cB = nB; ++ui;
        if constexpr (ALIGN_EPI) { if (wr == 1) PG8_BAR; }
    }
    PG8_WAIT_V(0);
    if constexpr (!ALIGN_EPI) { if (wr == 0) PG8_BAR; }
    PG8_BAR;
    if constexpr (Epi::AFTER_DRAIN) { E.fused(acc, cur, wr, wc, fr, fq, lds, wid, lane); S.done(cur); }
#undef PG8_SA
#undef PG8_SB
#undef PG8_STAGE
#undef PG8_LDA
#undef PG8_LDB
#undef PG8_MMA
#undef PG8_WAIT_V
#undef PG8_WAIT_L
#undef PG8_BAR
#undef PG8_SCHED
}
}
#ifndef PG8_SP2
#define PG8_SP2 true
#endif
#ifndef PG8_ALIGN
#define PG8_ALIGN true
#endif

#define LAS __attribute__((address_space(3)))
typedef unsigned short bf16;
typedef unsigned v4u __attribute__((ext_vector_type(4)));
typedef unsigned v2u __attribute__((ext_vector_type(2)));
typedef float f32x4 __attribute__((ext_vector_type(4)));
typedef short bf16x8 __attribute__((ext_vector_type(8)));
constexpr int NWAVES = 8, NTHR = 512;
constexpr int DM = 2048, NB = 4, SEQ = 2048, NMETA = 16, LP = 2064, DB = 128, DS = 4;
constexpr int MP = NB * LP;
constexpr int MS = DB * DS;
constexpr int MR = MP + MS;
constexpr int MPAD = 8960;
constexpr int NH = 32, NPROJ = 9248, NMAIN = 9216, DFF = 8192, DMIX = 4096, DCONV = 3072;
constexpr int NSEG = 33;
constexpr float EPS = 1e-6f;
constexpr size_t MiB = 1u << 20;
constexpr size_t WS_WIN = 1 * MiB, WS_WOUT = 38 * MiB, WS_WUP = 54 * MiB, WS_WDN = 86 * MiB, WS_WG = 118 * MiB;
constexpr size_t WS_H = 120 * MiB, WS_XN = 120 * MiB, WS_MIX = 120 * MiB, WS_XS = 190 * MiB, WS_BC = 225 * MiB;
constexpr size_t WS_PART = 260 * MiB, WS_A = 260 * MiB, WS_BT = 330 * MiB, WS_PXL = 260 * MiB, WS_PXBC = 295 * MiB;
constexpr size_t WS_PG = 400 * MiB, WS_PZ = 435 * MiB, WS_X1 = 400 * MiB, WS_XL = 470 * MiB, WS_HP = 470 * MiB;
constexpr size_t WS_DT = 505 * MiB, WS_AGGA = 507 * MiB, WS_AGGH = 509 * MiB, WS_END = 512 * MiB;
constexpr size_t WS_R2 = 330 * MiB;
constexpr int LDS_BYTES = 147456;
constexpr int NPHASE = 12;

struct Args { const float* in[28]; float* out; unsigned char* ws; int ph_lo, ph_hi; };
constexpr size_t O_YP = 0, O_YS = 16777216, O_PLH = O_YS + 1048576, O_PLC = O_PLH + 8192, O_PSSD = O_PLC + 24576, O_PSC = O_PSSD + 1048576,
                 O_SLH = O_PSC + 36864, O_SLC = O_SLH + 262144, O_SSSD = O_SLC + 786432, O_SSC = O_SSSD + 33554432, O_END = O_SSC + 1179648;

struct Ctx {
    const float *xp, *xs, *st_lru_h, *st_lru_conv, *st_ssd, *st_ssd_conv, *meta, *g_mix, *w_in, *conv_lru_w, *conv_lru_b, *lru_wa, *lru_ba, *lru_wx, *lru_bx,
                *lru_lam, *g_lru_out, *conv_ssd_w, *conv_ssd_b, *dt_bias, *a_log, *d_skip, *g_ssd_out, *w_out, *g_mlp, *w_up, *w_down, *g_final;
    float* out; unsigned char* ws;
    LAS unsigned char* lds;
    int tid, lane, wave, blk, G;
};

__device__ __forceinline__ unsigned f2bf(float f) { unsigned u = __builtin_bit_cast(unsigned, f); return (u + 0x7fffu + ((u >> 16) & 1u)) >> 16; }
__device__ __forceinline__ unsigned pk2(float lo, float hi) { unsigned r; asm("v_cvt_pk_bf16_f32 %0, %1, %2" : "=v"(r) : "v"(lo), "v"(hi)); return r; }
__device__ __forceinline__ float bflo(unsigned w) { return __builtin_bit_cast(float, w << 16); }
__device__ __forceinline__ float bfhi(unsigned w) { return __builtin_bit_cast(float, w & 0xffff0000u); }
__device__ __forceinline__ float bf1(bf16 h) { return __builtin_bit_cast(float, ((unsigned)h) << 16); }
#define SUM_DPP_STEP(v, ctrl, rmask) do { const int t_ = __builtin_amdgcn_update_dpp(0, __builtin_bit_cast(int, v), ctrl, rmask, 0xf, false); v += __builtin_bit_cast(float, t_); } while (0)
__device__ __forceinline__ float wave_sum(float v) {
    SUM_DPP_STEP(v, 0x111, 0xf); SUM_DPP_STEP(v, 0x112, 0xf); SUM_DPP_STEP(v, 0x114, 0xf); SUM_DPP_STEP(v, 0x118, 0xf);
    SUM_DPP_STEP(v, 0x142, 0xa); SUM_DPP_STEP(v, 0x143, 0xc);
    return __builtin_bit_cast(float, __builtin_amdgcn_readlane(__builtin_bit_cast(int, v), 63));
}
__device__ __forceinline__ float sigmoidf_(float x) { return __builtin_amdgcn_rcpf(1.0f + __expf(-x)); }
__device__ __forceinline__ float siluf_(float x) { return x * __builtin_amdgcn_rcpf(1.0f + __expf(-x)); }
__device__ __forceinline__ float softplusf_(float x) { return x > 20.f ? x : log1pf(expf(x)); }
__device__ __forceinline__ float gelu_tanh(float x) { const float u = 0.7978845608028654f * (x + 0.044715f * x * x * x); const float t = 1.0f - 2.0f * __builtin_amdgcn_rcpf(__expf(2.0f * u) + 1.0f); return 0.5f * x * (1.0f + t); }

__device__ __forceinline__ const float* xrow_ptr(const Ctx& F, int r) {
    if (r < MP) { const int b = r / LP, t = r - b * LP; return t < NMETA ? F.meta + (size_t)t * DM : F.xp + ((size_t)b * SEQ + (t - NMETA)) * DM; }
    return F.xs + (size_t)(r - MP) * DM;
}

__device__ __forceinline__ void transpose_item(const float* W, int ldw, bf16* WT, int K, int k0, int n0, LAS float* scr, int lane) {
#pragma unroll 8
    for (int i = 0; i < 32; ++i) { const int kk = 2 * i + (lane >> 5); scr[kk * 33 + (lane & 31)] = W[(size_t)(k0 + kk) * ldw + n0 + (lane & 31)]; }
    asm volatile("s_waitcnt lgkmcnt(0)" ::: "memory");
    const int c = lane & 7;
#pragma unroll
    for (int j = 0; j < 4; ++j) { const int n = (lane >> 3) + 8 * j; const LAS float* s = scr + (8 * c) * 33 + n;
        v4u o; o.x = pk2(s[0 * 33], s[1 * 33]); o.y = pk2(s[2 * 33], s[3 * 33]); o.z = pk2(s[4 * 33], s[5 * 33]); o.w = pk2(s[6 * 33], s[7 * 33]);
        *(v4u*)(WT + (size_t)(n0 + n) * K + k0 + 8 * c) = o; }
    asm volatile("s_waitcnt lgkmcnt(0)" ::: "memory");
}
__device__ __forceinline__ void rms_row_store(const f32x4 (&v)[8], const float* g, bf16* orow, int lane) {
    float ss = 0.f;
#pragma unroll
    for (int j = 0; j < 8; ++j) ss += (v[j].x * v[j].x + v[j].y * v[j].y) + (v[j].z * v[j].z + v[j].w * v[j].w);
    const float rs = rsqrtf(wave_sum(ss) * (1.f / DM) + EPS);
#pragma unroll
    for (int j = 0; j < 8; ++j) { const f32x4 gg = *(const f32x4*)(g + 4 * lane + 256 * j); const f32x4 o = v[j] * rs * gg;
        v2u w; w.x = pk2(o.x, o.y); w.y = pk2(o.z, o.w); *(v2u*)(orow + 4 * lane + 256 * j) = w; }
}
constexpr int I_IN = 32 * 289, I_OUT = 64 * 64, I_UP = 32 * 256, I_DN = 128 * 64, I_G = 256, NITEMS = I_IN + I_OUT + I_UP + I_DN + I_G;
__device__ __forceinline__ void convert_range(const Ctx& F, int lo, int hi, int part, int nparts) {
    LAS float* scr = (LAS float*)(F.lds + F.wave * 16384);
    bf16* WIN = (bf16*)(F.ws + WS_WIN); bf16* WOUT = (bf16*)(F.ws + WS_WOUT); bf16* WUP = (bf16*)(F.ws + WS_WUP); bf16* WDN = (bf16*)(F.ws + WS_WDN); bf16* WG = (bf16*)(F.ws + WS_WG);
    for (int it = lo + part * NWAVES + F.wave; it < hi; it += nparts * NWAVES) {
        int r = it;
        if (r < I_IN) { transpose_item(F.w_in, NPROJ, WIN, 2048, 64 * (r / 289), 32 * (r % 289), scr, F.lane); continue; } r -= I_IN;
        if (r < I_OUT) { transpose_item(F.w_out, 2048, WOUT, 4096, 64 * (r / 64), 32 * (r % 64), scr, F.lane); continue; } r -= I_OUT;
        if (r < I_UP) { transpose_item(F.w_up, 8192, WUP, 2048, 64 * (r / 256), 32 * (r % 256), scr, F.lane); continue; } r -= I_UP;
        if (r < I_DN) { transpose_item(F.w_down, 2048, WDN, 8192, 64 * (r / 64), 32 * (r % 64), scr, F.lane); continue; } r -= I_DN;
        { const int mat = r >> 7, hd = (r >> 3) & 15, sub = r & 7;
          transpose_item((mat ? F.lru_wx : F.lru_wa) + (size_t)hd * 16384, 128, WG + (size_t)(hd * 256 + mat * 128) * 128, 128, 64 * (sub >> 2), 32 * (sub & 3), scr, F.lane); }
    }
}
__device__ __forceinline__ void slack_parts(int n, int G, int blk, int& part, int& nparts) {
    const int nmax = (n + G - 1) / G, cut = (n % G == 0) ? 0 : n - (nmax - 1) * G;
    part = blk - cut; nparts = G - cut;
}
__device__ __forceinline__ void phase_prologue(const Ctx& F) {
    const int gw = F.blk * NWAVES + F.wave, NGW = F.G * NWAVES;
    convert_range(F, 0, I_IN, F.blk, F.G);
    convert_range(F, I_IN + I_OUT + I_UP + I_DN, NITEMS, F.blk, F.G);
    bf16* XN = (bf16*)(F.ws + WS_XN);
    for (int m = gw; m < MPAD; m += NGW) {
        bf16* orow = XN + (size_t)m * DM;
        if (m >= MR) {
#pragma unroll
            for (int j = 0; j < 8; ++j) *(v2u*)(orow + 4 * F.lane + 256 * j) = (v2u){0u, 0u};
            continue; }
        const float* xr = xrow_ptr(F, m); f32x4 v[8];
#pragma unroll
        for (int j = 0; j < 8; ++j) v[j] = *(const f32x4*)(xr + 4 * F.lane + 256 * j);
        rms_row_store(v, F.g_mix, orow, F.lane);
    }
}

__device__ __forceinline__ void phase_dt(const Ctx& F) {
    const int fr = F.lane & 15, fq = F.lane >> 4;
    const bf16* XN = (const bf16*)(F.ws + WS_XN); const bf16* WD = (const bf16*)(F.ws + WS_WIN) + (size_t)NMAIN * 2048; float* DT = (float*)(F.ws + WS_DT);
    LAS float* red = (LAS float*)F.lds;
    for (int blk = F.blk; blk < MR / 16; blk += F.G) {
        f32x4 c0 = {0.f, 0.f, 0.f, 0.f}, c1 = {0.f, 0.f, 0.f, 0.f};
        const int kb = F.wave * 256;
        const bf16* ap = XN + (size_t)(blk * 16 + fr) * DM + kb + fq * 8; const bf16* b0p = WD + (size_t)fr * DM + kb + fq * 8; const bf16* b1p = WD + (size_t)(16 + fr) * DM + kb + fq * 8;
#pragma unroll
        for (int k0 = 0; k0 < 256; k0 += 32) {
            const bf16x8 a = *(const bf16x8*)(ap + k0), b0 = *(const bf16x8*)(b0p + k0), b1 = *(const bf16x8*)(b1p + k0);
            c0 = __builtin_amdgcn_mfma_f32_16x16x32_bf16(a, b0, c0, 0, 0, 0); c1 = __builtin_amdgcn_mfma_f32_16x16x32_bf16(a, b1, c1, 0, 0, 0);
        }
        *(LAS f32x4*)(red + (F.wave * 64 + F.lane) * 8) = c0; *(LAS f32x4*)(red + (F.wave * 64 + F.lane) * 8 + 4) = c1;
        __syncthreads();
        if (F.wave == 0) {
#pragma unroll
            for (int w = 1; w < 8; ++w) { c0 += *(const LAS f32x4*)(red + (w * 64 + F.lane) * 8); c1 += *(const LAS f32x4*)(red + (w * 64 + F.lane) * 8 + 4); }
            const float bb0 = F.dt_bias[fr], bb1 = F.dt_bias[16 + fr];
#pragma unroll
            for (int e = 0; e < 4; ++e) { const int row = blk * 16 + fq * 4 + e; DT[row * NH + fr] = softplusf_(c0[e] + bb0); DT[row * NH + 16 + fr] = softplusf_(c1[e] + bb1); }
        }
        __syncthreads();
    }
}

__device__ __forceinline__ void phase_conv(const Ctx& F) {
    const bf16* PXL = (const bf16*)(F.ws + WS_PXL); const bf16* PXBC = (const bf16*)(F.ws + WS_PXBC);
    bf16* XL = (bf16*)(F.ws + WS_XL); bf16* XS = (bf16*)(F.ws + WS_XS); bf16* BC = (bf16*)(F.ws + WS_BC);
    constexpr int NRB = MR / 4, NCG = 640;
    const int vblk = (F.G % 8 == 0) ? (F.blk & 7) * (F.G >> 3) + (F.blk >> 3) : F.blk;
    for (int idx = vblk * NTHR + F.tid; idx < NRB * NCG; idx += F.G * NTHR) {
        const int cg_ = idx % NCG, rb = idx / NCG; const bool lru = cg_ < 256;
        const int c0 = lru ? cg_ * 8 : (cg_ - 256) * 8, ld = lru ? 2048 : 3072;
        const bf16* src = lru ? PXL : PXBC; const float* cw = lru ? F.conv_lru_w : F.conv_ssd_w; const float* cb = lru ? F.conv_lru_b : F.conv_ssd_b;
        const int row0 = rb * 4; const bool prompt = row0 < MP;
        int b = 0, t0 = 0, s = 0; if (prompt) { b = row0 / LP; t0 = row0 - b * LP; } else s = (row0 - MP) >> 2;
        float win[7][8];
        if (prompt) {
            if (t0 == 0) {
#pragma unroll
                for (int i = 0; i < 3; ++i)
#pragma unroll
                    for (int e = 0; e < 8; ++e) win[i][e] = 0.f;
            } else {
#pragma unroll
                for (int i = 0; i < 3; ++i) { const v4u w = *(const v4u*)(src + (size_t)(row0 - 3 + i) * ld + c0);
                    win[i][0] = bflo(w.x); win[i][1] = bfhi(w.x); win[i][2] = bflo(w.y); win[i][3] = bfhi(w.y); win[i][4] = bflo(w.z); win[i][5] = bfhi(w.z); win[i][6] = bflo(w.w); win[i][7] = bfhi(w.w); }
            }
        } else {
            const float* st = (lru ? F.st_lru_conv : F.st_ssd_conv) + (size_t)s * 3 * ld + c0;
#pragma unroll
            for (int i = 0; i < 3; ++i) { const f32x4 u0 = *(const f32x4*)(st + (size_t)i * ld), u1 = *(const f32x4*)(st + (size_t)i * ld + 4);
                win[i][0] = u0.x; win[i][1] = u0.y; win[i][2] = u0.z; win[i][3] = u0.w; win[i][4] = u1.x; win[i][5] = u1.y; win[i][6] = u1.z; win[i][7] = u1.w; }
        }
#pragma unroll
        for (int i = 0; i < 4; ++i) { const v4u w = *(const v4u*)(src + (size_t)(row0 + i) * ld + c0);
            win[3 + i][0] = bflo(w.x); win[3 + i][1] = bfhi(w.x); win[3 + i][2] = bflo(w.y); win[3 + i][3] = bfhi(w.y); win[3 + i][4] = bflo(w.z); win[3 + i][5] = bfhi(w.z); win[3 + i][6] = bflo(w.w); win[3 + i][7] = bfhi(w.w); }
        float wk[4][8], bias[8];
#pragma unroll
        for (int k = 0; k < 4; ++k) { const f32x4 u0 = *(const f32x4*)(cw + (size_t)k * ld + c0), u1 = *(const f32x4*)(cw + (size_t)k * ld + c0 + 4);
            wk[k][0] = u0.x; wk[k][1] = u0.y; wk[k][2] = u0.z; wk[k][3] = u0.w; wk[k][4] = u1.x; wk[k][5] = u1.y; wk[k][6] = u1.z; wk[k][7] = u1.w; }
        { const f32x4 u0 = *(const f32x4*)(cb + c0), u1 = *(const f32x4*)(cb + c0 + 4); bias[0] = u0.x; bias[1] = u0.y; bias[2] = u0.z; bias[3] = u0.w; bias[4] = u1.x; bias[5] = u1.y; bias[6] = u1.z; bias[7] = u1.w; }
#pragma unroll
        for (int j = 0; j < 4; ++j) {
            float o[8];
#pragma unroll
            for (int e = 0; e < 8; ++e) { float v = bias[e] + win[j][e] * wk[0][e]; v += win[j + 1][e] * wk[1][e]; v += win[j + 2][e] * wk[2][e]; v += win[j + 3][e] * wk[3][e]; o[e] = v; }
            const size_t row = (size_t)(row0 + j);
            if (lru) { v4u w; w.x = pk2(o[0], o[1]); w.y = pk2(o[2], o[3]); w.z = pk2(o[4], o[5]); w.w = pk2(o[6], o[7]); *(v4u*)(XL + row * 2048 + c0) = w; }
            else {
#pragma unroll
                for (int e = 0; e < 8; ++e) o[e] = siluf_(o[e]);
                if (c0 < 2048) { v4u w; w.x = pk2(o[0], o[1]); w.y = pk2(o[2], o[3]); w.z = pk2(o[4], o[5]); w.w = pk2(o[6], o[7]); *(v4u*)(XS + row * 2048 + c0) = w; }
                else { v4u w; w.x = pk2(o[0], o[1]); w.y = pk2(o[2], o[3]); w.z = pk2(o[4], o[5]); w.w = pk2(o[6], o[7]); *(v4u*)(BC + row * 1024 + (c0 - 2048)) = w; }
            }
        }
        float* cst = nullptr;
        if (prompt) { if (t0 == LP - 4) cst = F.out + (lru ? O_PLC : O_PSC) + (size_t)b * 3 * ld + c0; }
        else cst = F.out + (lru ? O_SLC : O_SSC) + (size_t)s * 3 * ld + c0;
        if (cst) {
#pragma unroll
            for (int i = 0; i < 3; ++i) { *(f32x4*)(cst + (size_t)i * ld) = (f32x4){win[4 + i][0], win[4 + i][1], win[4 + i][2], win[4 + i][3]}; *(f32x4*)(cst + (size_t)i * ld + 4) = (f32x4){win[4 + i][4], win[4 + i][5], win[4 + i][6], win[4 + i][7]}; }
        }
    }
}

__device__ __forceinline__ void gate_unit(const Ctx& F, int pm, int head) {
    constexpr int RS = 272;
    LAS unsigned char* LA = F.lds; LAS unsigned char* LB = F.lds + 256 * RS;
    const bf16* XL = (const bf16*)(F.ws + WS_XL) + (size_t)pm * 256 * 2048 + head * 128; const bf16* WG = (const bf16*)(F.ws + WS_WG) + (size_t)head * 256 * 128;
    float* Ao = (float*)(F.ws + WS_A); float* Bo = (float*)(F.ws + WS_BT);
    { const int row = F.tid >> 4, cp = F.tid & 15;
      const bf16* ga = XL + (size_t)row * 2048 + cp * 8; const bf16* gb = WG + row * 128 + cp * 8; LAS unsigned char* la = LA + row * RS + cp * 16;
#pragma unroll 2
      for (int i = 0; i < 8; ++i) { const v4u va = *(const v4u*)(ga + (size_t)i * 32 * 2048), vb = *(const v4u*)(gb + i * 32 * 128);
          *(LAS v4u*)(la + i * 32 * RS) = va; *(LAS v4u*)(la + 256 * RS + i * 32 * RS) = vb; } }
    __syncthreads();
    const int wr = F.wave >> 2, wc = F.wave & 3, fr = F.lane & 15, fq = F.lane >> 4;
    float cba[2][4], cbx[2][4], csp[2][4];
#pragma unroll
    for (int n = 0; n < 2; ++n)
#pragma unroll
        for (int e = 0; e < 4; ++e) { const int ch = head * 128 + 32 * wc + 16 * n + 4 * fq + e; cba[n][e] = F.lru_ba[ch]; cbx[n][e] = F.lru_bx[ch]; csp[n][e] = 8.0f * softplusf_(-F.lru_lam[ch]); }
#pragma unroll 1
    for (int mh = 0; mh < 2; ++mh) {
        f32x4 accr[4][2], acci[4][2];
#pragma unroll
        for (int m = 0; m < 4; ++m)
#pragma unroll
            for (int n = 0; n < 2; ++n) { accr[m][n] = (f32x4){0.f, 0.f, 0.f, 0.f}; acci[m][n] = (f32x4){0.f, 0.f, 0.f, 0.f}; }
        const int rbase = 128 * wr + 64 * mh;
#pragma unroll
        for (int ks = 0; ks < 4; ++ks) {
            bf16x8 br[2], bi[2];
#pragma unroll
            for (int n = 0; n < 2; ++n) { br[n] = *(const LAS bf16x8*)(LB + (32 * wc + 16 * n + fr) * RS + (32 * ks + 8 * fq) * 2); bi[n] = *(const LAS bf16x8*)(LB + (128 + 32 * wc + 16 * n + fr) * RS + (32 * ks + 8 * fq) * 2); }
#pragma unroll
            for (int m = 0; m < 4; ++m) { const bf16x8 af = *(const LAS bf16x8*)(LA + (rbase + 16 * m + fr) * RS + (32 * ks + 8 * fq) * 2);
#pragma unroll
                for (int n = 0; n < 2; ++n) { accr[m][n] = __builtin_amdgcn_mfma_f32_16x16x32_bf16(br[n], af, accr[m][n], 0, 0, 0); acci[m][n] = __builtin_amdgcn_mfma_f32_16x16x32_bf16(bi[n], af, acci[m][n], 0, 0, 0); } }
        }
#pragma unroll
        for (int m = 0; m < 4; ++m) {
            const int rl = rbase + 16 * m + fr, row = pm * 256 + rl;
            if (row < MR) {
                const bool first = (row < MP) && (row % LP == 0);
                const float* h0p = (row >= MP && ((row - MP) & 3) == 0) ? F.st_lru_h + (size_t)((row - MP) >> 2) * 2048 : nullptr;
#pragma unroll
                for (int n = 0; n < 2; ++n) {
                    const int j0 = 32 * wc + 16 * n + 4 * fq, ch0 = head * 128 + j0;
                    const v2u xw = *(const LAS v2u*)(LA + rl * RS + j0 * 2);
                    const float xl[4] = {bflo(xw.x), bfhi(xw.x), bflo(xw.y), bfhi(xw.y)};
                    f32x4 h0v = {0.f, 0.f, 0.f, 0.f}; if (h0p) h0v = *(const f32x4*)(h0p + ch0);
                    f32x4 av, bv;
#pragma unroll
                    for (int e = 0; e < 4; ++e) {
                        const float r = sigmoidf_(accr[m][n][e] + cba[n][e]), ii = sigmoidf_(acci[m][n][e] + cbx[n][e]);
                        const float a = __expf(-csp[n][e] * r); const float mult = first ? 1.0f : __builtin_amdgcn_sqrtf(fmaxf(1.0f - a * a, 0.f));
                        av[e] = a; bv[e] = mult * ii * xl[e] + a * h0v[e];
                    }
                    *(f32x4*)(Ao + (size_t)row * 2048 + ch0) = av; *(f32x4*)(Bo + (size_t)row * 2048 + ch0) = bv;
                }
            }
        }
    }
    __syncthreads();
}
__device__ __forceinline__ void phase_gates(const Ctx& F) {
    for (int u = F.blk; u < 35 * 16; u += F.G) gate_unit(F, u >> 4, u & 15);
#ifdef PROBE_G2
    for (int u = F.blk; u < 35 * 16; u += F.G) gate_unit(F, u >> 4, u & 15);
#endif
    int part, nparts; slack_parts(35 * 16, F.G, F.blk, part, nparts);
    if (part >= 0) convert_range(F, I_IN, I_IN + I_OUT + I_UP, part, nparts);
#ifdef PROBE_C2
    __syncthreads();
    if (part >= 0) convert_range(F, I_IN, I_IN + I_OUT + I_UP, part, nparts);
#endif
}

__device__ __forceinline__ void ssd_unit(const Ctx& F, int row0, int T, int head, const float* h0, float* hout) {
    const float* DT = (const float*)(F.ws + WS_DT); const bf16* XS = (const bf16*)(F.ws + WS_XS); const float* BC = (const float*)(F.ws + WS_BC); const bf16* PZ = (const bf16*)(F.ws + WS_PZ);
    bf16* MIX = (bf16*)(F.ws + WS_MIX);
    LAS float* xch = (LAS float*)F.lds;
    const int g = head >> 3, wave = F.wave, lane = F.lane;
    const float Ah = -expf(F.a_log[head]), Dh = F.d_skip[head];
    f32x4 h[4];
#pragma unroll
    for (int q = 0; q < 4; ++q) h[q] = h0 ? *(const f32x4*)(h0 + ((size_t)head * 64 + lane) * 128 + 16 * wave + 4 * q) : (f32x4){0.f, 0.f, 0.f, 0.f};
    for (int tb = 0; tb < T; tb += 4) {
        float part[4];
#pragma unroll
        for (int tt = 0; tt < 4; ++tt) {
            const size_t row = (size_t)(row0 + tb + tt);
            const float dt = DT[row * NH + head]; const float dA = __expf(dt * Ah);
            const float dtx = dt * bf1(XS[row * 2048 + head * 64 + lane]);
            const f32x4* Bp = (const f32x4*)(BC + row * 1024 + g * 128 + 16 * wave); const f32x4* Cp = (const f32x4*)(BC + row * 1024 + 512 + g * 128 + 16 * wave);
            float acc = 0.f;
#pragma unroll
            for (int q = 0; q < 4; ++q) { const f32x4 b4 = Bp[q], c4 = Cp[q];
#pragma unroll
                for (int e = 0; e < 4; ++e) { h[q][e] = dA * h[q][e] + dtx * b4[e]; acc += h[q][e] * c4[e]; } }
            part[tt] = acc;
        }
        const int buf = (tb >> 2) & 1;
#pragma unroll
        for (int tt = 0; tt < 4; ++tt) xch[buf * 2048 + (wave * 4 + tt) * 64 + lane] = part[tt];
        __syncthreads();
        if (F.tid < 256) {
            const int tt = F.tid >> 6, p = F.tid & 63; float y = 0.f;
#pragma unroll
            for (int w = 0; w < 8; ++w) y += xch[buf * 2048 + (w * 4 + tt) * 64 + p];
            const size_t row = (size_t)(row0 + tb + tt);
            const float x = bf1(XS[row * 2048 + head * 64 + p]), z = bf1(PZ[row * 2048 + head * 64 + p]);
            MIX[row * 4096 + 2048 + head * 64 + p] = (bf16)f2bf((y + Dh * x) * siluf_(z));
        }
    }
#pragma unroll
    for (int q = 0; q < 4; ++q) *(f32x4*)(hout + ((size_t)head * 64 + lane) * 128 + 16 * wave + 4 * q) = h[q];
    __syncthreads();
}

__device__ __forceinline__ void ssd_sample_wave(const Ctx& F, int part, int nparts) {
    const float* DT = (const float*)(F.ws + WS_DT); const bf16* XS = (const bf16*)(F.ws + WS_XS); const float* BC = (const float*)(F.ws + WS_BC); const bf16* PZ = (const bf16*)(F.ws + WS_PZ);
    bf16* MIX = (bf16*)(F.ws + WS_MIX);
    const int gw = part * NWAVES + F.wave, NGW = nparts * NWAVES, lane = F.lane, pl = lane >> 3, no = lane & 7;
    constexpr int NU = DB * NH * 8;
    f32x4 hn[4];
    if (gw < NU) { const float* hp = F.st_ssd + ((size_t)(gw >> 3) * 64 + (gw & 7) * 8 + pl) * 128 + 16 * no;
#pragma unroll
        for (int q = 0; q < 4; ++q) hn[q] = *(const f32x4*)(hp + 4 * q); }
    for (int u = gw; u < NU; u += NGW) {
        const int po = u & 7, head = (u >> 3) & 31, s_ = u >> 8, g = head >> 3, p = po * 8 + pl;
        f32x4 h[4];
#pragma unroll
        for (int q = 0; q < 4; ++q) h[q] = hn[q];
        const int un = u + NGW;
        if (un < NU) { const float* hp = F.st_ssd + ((size_t)(un >> 3) * 64 + (un & 7) * 8 + pl) * 128 + 16 * no;
#pragma unroll
            for (int q = 0; q < 4; ++q) hn[q] = *(const f32x4*)(hp + 4 * q); }
        const float Ah = -expf(F.a_log[head]), Dh = F.d_skip[head];
        float dtv[4], xv[4], zv[4]; f32x4 bv[4][4], cv[4][4];
#pragma unroll
        for (int j = 0; j < 4; ++j) { const size_t row = (size_t)(MP + 4 * s_ + j);
            dtv[j] = DT[row * NH + head]; xv[j] = bf1(XS[row * 2048 + head * 64 + p]); zv[j] = bf1(PZ[row * 2048 + head * 64 + p]);
            const float* bp = BC + row * 1024 + g * 128 + 16 * no;
#pragma unroll
            for (int q = 0; q < 4; ++q) { bv[j][q] = *(const f32x4*)(bp + 4 * q); cv[j][q] = *(const f32x4*)(bp + 512 + 4 * q); } }
#pragma unroll
        for (int j = 0; j < 4; ++j) {
            const float dA = __expf(dtv[j] * Ah), dtx = dtv[j] * xv[j]; float acc = 0.f;
#pragma unroll
            for (int q = 0; q < 4; ++q)
#pragma unroll
                for (int e = 0; e < 4; ++e) { h[q][e] = dA * h[q][e] + dtx * bv[j][q][e]; acc += h[q][e] * cv[j][q][e]; }
            acc += __shfl_xor(acc, 1); acc += __shfl_xor(acc, 2); acc += __shfl_xor(acc, 4);
            if (no == 0) MIX[(size_t)(MP + 4 * s_ + j) * 4096 + 2048 + head * 64 + p] = (bf16)f2bf((acc + Dh * xv[j]) * siluf_(zv[j]));
        }
        float* op = F.out + O_SSSD + ((size_t)(u >> 3) * 64 + po * 8 + pl) * 128 + 16 * no;
#pragma unroll
        for (int q = 0; q < 4; ++q) *(f32x4*)(op + 4 * q) = h[q];
    }
}

__device__ __forceinline__ void ssd_sample_blk(const Ctx& F, int part, int nparts) {
    const float* DT = (const float*)(F.ws + WS_DT); const bf16* XS = (const bf16*)(F.ws + WS_XS); const bf16* BC = (const bf16*)(F.ws + WS_BC); const bf16* PZ = (const bf16*)(F.ws + WS_PZ);
    bf16* MIX = (bf16*)(F.ws + WS_MIX);
    LAS float* sb = (LAS float*)F.lds;
    LAS bf16* xl = (LAS bf16*)(F.lds + 4096); LAS bf16* zl = (LAS bf16*)(F.lds + 8192);
    LAS float* dl = (LAS float*)(F.lds + 12288);
    const int lane = F.lane, pl = lane >> 3, no = lane & 7, p = F.wave * 8 + pl;
    constexpr int NIT = DB * 4;
    f32x4 hn[4];
#define SMP_LOAD(it_, hh_) do { const float* hp = F.st_ssd + (((size_t)((it_) >> 2) * NH + 8 * ((it_) & 3) + (hh_)) * 64 + p) * 128 + 4 * no;   \
        _Pragma("unroll") for (int q = 0; q < 4; ++q) hn[q] = *(const f32x4*)(hp + 32 * q); } while (0)
    if (part < NIT) SMP_LOAD(part, 0);
#pragma unroll 1
    for (int it = part; it < NIT; it += nparts) {
        const int s_ = it >> 2, g = it & 3;
        if (F.tid < 256) { const int tok = F.tid >> 6, r = F.tid & 63, which = r >> 5, n4 = r & 31;
            const v2u w = *(const v2u*)(BC + (size_t)(MP + 4 * s_ + tok) * 1024 + which * 512 + g * 128 + 4 * n4);
            *(LAS f32x4*)(sb + (tok * 2 + which) * 128 + 4 * n4) = (f32x4){bflo(w.x), bfhi(w.x), bflo(w.y), bfhi(w.y)}; }
        { const int tok = F.tid >> 7, which = (F.tid >> 6) & 1, piece = F.tid & 63;
          const v4u w = *(const v4u*)((which ? PZ : XS) + (size_t)(MP + 4 * s_ + tok) * 2048 + g * 512 + piece * 8);
          *(LAS v4u*)((which ? zl : xl) + tok * 512 + piece * 8) = w; }
        if (F.tid < 32) dl[F.tid] = DT[(size_t)(MP + 4 * s_ + (F.tid >> 3)) * NH + 8 * g + (F.tid & 7)];
        __syncthreads();
#pragma unroll 1
        for (int hh = 0; hh < 8; ++hh) {
            const int head = 8 * g + hh;
            f32x4 h[4];
#pragma unroll
            for (int q = 0; q < 4; ++q) h[q] = hn[q];
            if (hh < 7) SMP_LOAD(it, hh + 1); else if (it + nparts < NIT) SMP_LOAD(it + nparts, 0);
            const float Ah = -expf(F.a_log[head]), Dh = F.d_skip[head];
#pragma unroll
            for (int j = 0; j < 4; ++j) {
                const float xv = bf1(xl[j * 512 + hh * 64 + p]), zv = bf1(zl[j * 512 + hh * 64 + p]), dtv = dl[j * 8 + hh];
                const float dA = __expf(dtv * Ah), dtx = dtv * xv; float acc = 0.f;
#pragma unroll
                for (int q = 0; q < 4; ++q) { const f32x4 b4 = *(const LAS f32x4*)(sb + (j * 2) * 128 + 32 * q + 4 * no), c4 = *(const LAS f32x4*)(sb + (j * 2 + 1) * 128 + 32 * q + 4 * no);
#pragma unroll
                    for (int e = 0; e < 4; ++e) { h[q][e] = dA * h[q][e] + dtx * b4[e]; acc += h[q][e] * c4[e]; } }
                acc += __shfl_xor(acc, 1); acc += __shfl_xor(acc, 2); acc += __shfl_xor(acc, 4);
                if (no == 0) MIX[(size_t)(MP + 4 * s_ + j) * 4096 + 2048 + head * 64 + p] = (bf16)f2bf((acc + Dh * xv) * siluf_(zv));
            }
            float* op = F.out + O_SSSD + (((size_t)s_ * NH + head) * 64 + p) * 128 + 4 * no;
#pragma unroll
            for (int q = 0; q < 4; ++q) *(f32x4*)(op + 32 * q) = h[q];
        }
        __syncthreads();
    }
#undef SMP_LOAD
}
__device__ __forceinline__ void lru_aggregate(const Ctx& F, int part, int nparts) {
    const float* Ai = (const float*)(F.ws + WS_A); const float* Bi = (const float*)(F.ws + WS_BT); float* GA = (float*)(F.ws + WS_AGGA); float* GH = (float*)(F.ws + WS_AGGH);
    for (int idx = part * NTHR + F.tid; idx < NB * NSEG * 2048; idx += nparts * NTHR) {
        const int ch = idx & 2047, sg = (idx >> 11) % NSEG, b = idx / (2048 * NSEG);
        const int t0 = sg * 64, t1 = min(t0 + 64, LP);
        float ap = 1.f, hh = 0.f;
        if (t1 - t0 == 64) {
            for (int t = t0; t < t1; t += 32) { float av[32], bv[32];
#pragma unroll
                for (int k = 0; k < 32; ++k) { const size_t o = (size_t)(b * LP + t + k) * 2048 + ch; av[k] = Ai[o]; bv[k] = Bi[o]; }
#pragma unroll
                for (int k = 0; k < 32; ++k) { hh = av[k] * hh + bv[k]; ap *= av[k]; } }
        } else {
            for (int t = t0; t < t1; t += 16) { float av[16], bv[16];
#pragma unroll
                for (int k = 0; k < 16; ++k) { const size_t o = (size_t)(b * LP + t + k) * 2048 + ch; av[k] = Ai[o]; bv[k] = Bi[o]; }
#pragma unroll
                for (int k = 0; k < 16; ++k) { hh = av[k] * hh + bv[k]; ap *= av[k]; } }
        }
        GA[idx] = ap; GH[idx] = hh;
    }
}

constexpr int NCH = 33;
constexpr size_t WS_S = 260 * MiB;
constexpr size_t WS_DC = 506 * MiB + 512 * 1024;
__device__ __forceinline__ float dpp_add_(float v, float src_shifted_default0, int) { return v + src_shifted_default0; }
#define SCAN_DPP_STEP(v, ctrl, rmask) do { const int t_ = __builtin_amdgcn_update_dpp(0, __builtin_bit_cast(int, v), ctrl, rmask, 0xf, false); v += __builtin_bit_cast(float, t_); } while (0)
__device__ __forceinline__ float wave_scan_incl(float v, int lane) {
    (void)lane;
    SCAN_DPP_STEP(v, 0x111, 0xf); SCAN_DPP_STEP(v, 0x112, 0xf); SCAN_DPP_STEP(v, 0x114, 0xf); SCAN_DPP_STEP(v, 0x118, 0xf);
    SCAN_DPP_STEP(v, 0x142, 0xa); SCAN_DPP_STEP(v, 0x143, 0xc);
    return v;
}
__device__ __forceinline__ void ssdA_unit(const Ctx& F, int b, int c, int g) {
    const float* DT = (const float*)(F.ws + WS_DT); const bf16* XS = (const bf16*)(F.ws + WS_XS); const float* BC = (const float*)(F.ws + WS_BC);
    float* S = (float*)(F.ws + WS_S); float* DC = (float*)(F.ws + WS_DC);
    const int row0 = b * LP + 64 * c, nq = min(64, LP - 64 * c), lane = F.lane, wave = F.wave, fr = lane & 15, fq = lane >> 4;
    LAS unsigned char* BT = F.lds; LAS unsigned char* XT = F.lds + 18432;
    { const int n = F.tid & 127, jq = F.tid >> 7; unsigned w[8];
#pragma unroll
      for (int jj = 0; jj < 8; ++jj) { const int j0 = 16 * jq + 2 * jj;
          const float v0 = j0 < nq ? BC[(size_t)(row0 + j0) * 1024 + g * 128 + n] : 0.f, v1 = (j0 + 1) < nq ? BC[(size_t)(row0 + j0 + 1) * 1024 + g * 128 + n] : 0.f; w[jj] = pk2(v0, v1); }
      *(LAS v4u*)(BT + n * 144 + jq * 32) = (v4u){w[0], w[1], w[2], w[3]}; *(LAS v4u*)(BT + n * 144 + jq * 32 + 16) = (v4u){w[4], w[5], w[6], w[7]}; }
    float dt_n = lane < nq ? DT[(size_t)(row0 + lane) * NH + 8 * g] : 0.f; unsigned xr_n[8];
#pragma unroll
    for (int jj = 0; jj < 8; ++jj) { const int j0 = 8 * wave + jj; xr_n[jj] = j0 < nq ? (unsigned)XS[(size_t)(row0 + j0) * 2048 + (8 * g) * 64 + lane] : 0u; }
#pragma unroll 1
    for (int hh = 0; hh < 8; ++hh) {
        const int head = 8 * g + hh; const float Ah = -expf(F.a_log[head]);
        const float dtj = dt_n; unsigned xr[8];
#pragma unroll
        for (int jj = 0; jj < 8; ++jj) xr[jj] = xr_n[jj];
        if (hh < 7) { dt_n = lane < nq ? DT[(size_t)(row0 + lane) * NH + head + 1] : 0.f;
#pragma unroll
            for (int jj = 0; jj < 8; ++jj) { const int j0 = 8 * wave + jj; xr_n[jj] = j0 < nq ? (unsigned)XS[(size_t)(row0 + j0) * 2048 + (head + 1) * 64 + lane] : 0u; } }
        const float acum = wave_scan_incl(dtj * Ah, lane), aend = __shfl(acum, 63), wj = __expf(aend - acum) * dtj;
        LAS unsigned char* XTb = XT + (hh & 1) * 9216;
        { unsigned w[4];
#pragma unroll
          for (int jj = 0; jj < 4; ++jj) { const int j0 = 8 * wave + 2 * jj;
              w[jj] = pk2(bflo(xr[2 * jj]) * __shfl(wj, j0), bflo(xr[2 * jj + 1]) * __shfl(wj, j0 + 1)); }
          *(LAS v4u*)(XTb + lane * 144 + wave * 16) = (v4u){w[0], w[1], w[2], w[3]}; }
        __syncthreads();
        f32x4 acc[4];
#pragma unroll
        for (int pb = 0; pb < 4; ++pb) acc[pb] = (f32x4){0.f, 0.f, 0.f, 0.f};
#pragma unroll
        for (int ks = 0; ks < 2; ++ks) { const bf16x8 wf = *(const LAS bf16x8*)(BT + (16 * wave + fr) * 144 + (32 * ks + 8 * fq) * 2);
#pragma unroll
            for (int pb = 0; pb < 4; ++pb) { const bf16x8 af = *(const LAS bf16x8*)(XTb + (16 * pb + fr) * 144 + (32 * ks + 8 * fq) * 2); acc[pb] = __builtin_amdgcn_mfma_f32_16x16x32_bf16(wf, af, acc[pb], 0, 0, 0); } }
        float* Sp = S + ((((size_t)b * NCH + c) * NH + head) * 64) * 128;
#pragma unroll
        for (int pb = 0; pb < 4; ++pb) *(f32x4*)(Sp + (size_t)(16 * pb + fr) * 128 + 16 * wave + 4 * fq) = acc[pb];
        if (F.tid == 0) DC[(b * NCH + c) * NH + head] = __expf(aend);
    }
    __syncthreads();
}
__device__ __forceinline__ void phase_ssdA(const Ctx& F) { for (int u = F.blk; u < NB * NCH * 4; u += F.G) { const int g = u & 3, bc = u >> 2; ssdA_unit(F, bc / NCH, bc % NCH, g); } }
__device__ __forceinline__ void phase_ssdB(const Ctx& F) {
    float* S = (float*)(F.ws + WS_S); const float* DC = (const float*)(F.ws + WS_DC);
    for (int idx = F.blk * NTHR + F.tid; idx < NB * NH * 64 * 32; idx += F.G * NTHR) {
        const int e4 = idx & 2047, head = (idx >> 11) & 31, b = idx >> 16;
        f32x4 H = {0.f, 0.f, 0.f, 0.f};
        float* sp = S + ((size_t)b * NCH * NH + head) * 8192 + 4 * e4; const float* dp = DC + b * NCH * NH + head;
        f32x4 v0 = *(const f32x4*)sp, v1 = *(const f32x4*)(sp + (size_t)NH * 8192);
        for (int c = 0; c < NCH; ++c) { const f32x4 v2 = (c + 2 < NCH) ? *(const f32x4*)(sp + (size_t)(c + 2) * NH * 8192) : (f32x4){0.f, 0.f, 0.f, 0.f}; const float d = dp[c * NH];
            *(f32x4*)(sp + (size_t)c * NH * 8192) = H; H = H * d + v0; v0 = v1; v1 = v2; }
        *(f32x4*)(F.out + O_PSSD + ((size_t)b * NH + head) * 8192 + 4 * e4) = H;
    }
}
__device__ __forceinline__ void ssdC_unit(const Ctx& F, int b, int c, int g) {
    const float* DT = (const float*)(F.ws + WS_DT); const bf16* XS = (const bf16*)(F.ws + WS_XS); const float* BC = (const float*)(F.ws + WS_BC); const bf16* PZ = (const bf16*)(F.ws + WS_PZ);
    const float* S = (const float*)(F.ws + WS_S); bf16* MIX = (bf16*)(F.ws + WS_MIX);
    const int row0 = b * LP + 64 * c, nq = min(64, LP - 64 * c), lane = F.lane, wave = F.wave, fr = lane & 15, fq = lane >> 4;
    LAS unsigned char* Cs = F.lds; LAS unsigned char* Bs = F.lds + 17408; LAS unsigned char* HB = F.lds + 34816;
    { const int r = F.tid >> 3, n0 = (F.tid & 7) * 16; const bool ok = r < nq; const float* src = BC + (size_t)(row0 + r) * 1024 + g * 128 + n0;
#pragma unroll
      for (int m = 0; m < 2; ++m) {
          f32x4 v[4];
#pragma unroll
          for (int q = 0; q < 4; ++q) v[q] = ok ? *(const f32x4*)(src + m * 512 + 4 * q) : (f32x4){0.f, 0.f, 0.f, 0.f};
          LAS unsigned char* d = (m ? Cs : Bs) + r * 272 + n0 * 2;
          *(LAS v4u*)d = (v4u){pk2(v[0].x, v[0].y), pk2(v[0].z, v[0].w), pk2(v[1].x, v[1].y), pk2(v[1].z, v[1].w)};
          *(LAS v4u*)(d + 16) = (v4u){pk2(v[2].x, v[2].y), pk2(v[2].z, v[2].w), pk2(v[3].x, v[3].y), pk2(v[3].z, v[3].w)}; } }
    __syncthreads();
    const int ib = wave >> 1, tb0 = 2 * (wave & 1);
    f32x4 cb[2] = {{0.f, 0.f, 0.f, 0.f}, {0.f, 0.f, 0.f, 0.f}};
#pragma unroll
    for (int ks = 0; ks < 4; ++ks) { const bf16x8 af = *(const LAS bf16x8*)(Cs + (16 * ib + fr) * 272 + (32 * ks + 8 * fq) * 2);
#pragma unroll
        for (int t = 0; t < 2; ++t) { const bf16x8 wf = *(const LAS bf16x8*)(Bs + (16 * (tb0 + t) + fr) * 272 + (32 * ks + 8 * fq) * 2); cb[t] = __builtin_amdgcn_mfma_f32_16x16x32_bf16(wf, af, cb[t], 0, 0, 0); } }
    const int irow = 16 * ib + fr;
    const int hp_ = F.tid >> 3, hn0 = (F.tid & 7) * 16;
    float dt_n = lane < nq ? DT[(size_t)(row0 + lane) * NH + 8 * g] : 0.f; unsigned xr_n[8]; f32x4 hv_n[4];
#pragma unroll
    for (int jj = 0; jj < 8; ++jj) { const int j0 = 8 * wave + jj; xr_n[jj] = j0 < nq ? (unsigned)XS[(size_t)(row0 + j0) * 2048 + (8 * g) * 64 + lane] : 0u; }
    { const float* hp = S + ((((size_t)b * NCH + c) * NH + 8 * g) * 64 + hp_) * 128 + hn0;
#pragma unroll
      for (int q = 0; q < 4; ++q) hv_n[q] = *(const f32x4*)(hp + 4 * q); }
#pragma unroll 1
    for (int hh = 0; hh < 8; ++hh) {
        const int head = 8 * g + hh; const float Ah = -expf(F.a_log[head]), Dh = F.d_skip[head];
        const float dtj = dt_n; unsigned xr[8]; f32x4 v[4];
#pragma unroll
        for (int jj = 0; jj < 8; ++jj) xr[jj] = xr_n[jj];
#pragma unroll
        for (int q = 0; q < 4; ++q) v[q] = hv_n[q];
        if (hh < 7) { dt_n = lane < nq ? DT[(size_t)(row0 + lane) * NH + head + 1] : 0.f;
#pragma unroll
            for (int jj = 0; jj < 8; ++jj) { const int j0 = 8 * wave + jj; xr_n[jj] = j0 < nq ? (unsigned)XS[(size_t)(row0 + j0) * 2048 + (head + 1) * 64 + lane] : 0u; }
            const float* hp = S + ((((size_t)b * NCH + c) * NH + head + 1) * 64 + hp_) * 128 + hn0;
#pragma unroll
            for (int q = 0; q < 4; ++q) hv_n[q] = *(const f32x4*)(hp + 4 * q); }
        v2u xw[2] = {{0u, 0u}, {0u, 0u}}, zw[2] = {{0u, 0u}, {0u, 0u}};
        if (irow < nq) {
#pragma unroll
            for (int t = 0; t < 2; ++t) { const size_t o = (size_t)(row0 + irow) * 2048 + head * 64 + 16 * (tb0 + t) + 4 * fq; xw[t] = *(const v2u*)(XS + o); zw[t] = *(const v2u*)(PZ + o); } }
        const float acum = wave_scan_incl(dtj * Ah, lane);
        LAS unsigned char* Ms = HB + (hh & 1) * 35840; LAS unsigned char* XT = Ms + 9216; LAS unsigned char* Hs = Ms + 18432;
        const float mi = __shfl(acum, irow);
#pragma unroll
        for (int t = 0; t < 2; ++t) { float mv[4];
#pragma unroll
            for (int e = 0; e < 4; ++e) { const int j = 16 * (tb0 + t) + 4 * fq + e; const float aj = __shfl(acum, j), dj = __shfl(dtj, j);
                mv[e] = (j <= irow) ? cb[t][e] * __expf(fminf(mi - aj, 0.f)) * dj : 0.f; }
            *(LAS v2u*)(Ms + irow * 144 + (16 * (tb0 + t) + 4 * fq) * 2) = (v2u){pk2(mv[0], mv[1]), pk2(mv[2], mv[3])}; }
        *(LAS v4u*)(XT + lane * 144 + wave * 16) = (v4u){xr[0] | (xr[1] << 16), xr[2] | (xr[3] << 16), xr[4] | (xr[5] << 16), xr[6] | (xr[7] << 16)};
        { LAS unsigned char* d = Hs + hp_ * 272 + hn0 * 2;
          *(LAS v4u*)d = (v4u){pk2(v[0].x, v[0].y), pk2(v[0].z, v[0].w), pk2(v[1].x, v[1].y), pk2(v[1].z, v[1].w)};
          *(LAS v4u*)(d + 16) = (v4u){pk2(v[2].x, v[2].y), pk2(v[2].z, v[2].w), pk2(v[3].x, v[3].y), pk2(v[3].z, v[3].w)}; }
        __syncthreads();
        f32x4 acc[2] = {{0.f, 0.f, 0.f, 0.f}, {0.f, 0.f, 0.f, 0.f}};
#pragma unroll
        for (int ks = 0; ks < 4; ++ks) { const bf16x8 af = *(const LAS bf16x8*)(Cs + irow * 272 + (32 * ks + 8 * fq) * 2);
#pragma unroll
            for (int t = 0; t < 2; ++t) { const bf16x8 wf = *(const LAS bf16x8*)(Hs + (16 * (tb0 + t) + fr) * 272 + (32 * ks + 8 * fq) * 2); acc[t] = __builtin_amdgcn_mfma_f32_16x16x32_bf16(wf, af, acc[t], 0, 0, 0); } }
        const float ei = __expf(mi);
#pragma unroll
        for (int t = 0; t < 2; ++t) acc[t] = acc[t] * ei;
#pragma unroll
        for (int ks = 0; ks < 2; ++ks) { const bf16x8 af = *(const LAS bf16x8*)(Ms + irow * 144 + (32 * ks + 8 * fq) * 2);
#pragma unroll
            for (int t = 0; t < 2; ++t) { const bf16x8 wf = *(const LAS bf16x8*)(XT + (16 * (tb0 + t) + fr) * 144 + (32 * ks + 8 * fq) * 2); acc[t] = __builtin_amdgcn_mfma_f32_16x16x32_bf16(wf, af, acc[t], 0, 0, 0); } }
        if (irow < nq) {
#pragma unroll
            for (int t = 0; t < 2; ++t) {
                const float y0 = (acc[t][0] + Dh * bflo(xw[t].x)) * siluf_(bflo(zw[t].x)), y1 = (acc[t][1] + Dh * bfhi(xw[t].x)) * siluf_(bfhi(zw[t].x));
                const float y2 = (acc[t][2] + Dh * bflo(xw[t].y)) * siluf_(bflo(zw[t].y)), y3 = (acc[t][3] + Dh * bfhi(xw[t].y)) * siluf_(bfhi(zw[t].y));
                *(v2u*)(MIX + (size_t)(row0 + irow) * 4096 + 2048 + head * 64 + 16 * (tb0 + t) + 4 * fq) = (v2u){pk2(y0, y1), pk2(y2, y3)}; }
        }
    }
    __syncthreads();
}
__device__ __forceinline__ void phase_ssdC(const Ctx& F) { for (int u = F.blk; u < NB * NCH * 4; u += F.G) { const int g = u & 3, bc = u >> 2; ssdC_unit(F, bc / NCH, bc % NCH, g); } }


#define SEQ_LOAD(cn) do { const int row0n = b * LP + 64 * (cn), nqn = min(64, LP - 64 * (cn)), lastn = nqn - 1;   \
        { const float d_ = DT[(size_t)(row0n + min(lane, lastn)) * NH + head]; pdt = lane < nqn ? d_ : 0.f; } \
        _Pragma("unroll") for (int jj = 0; jj < 8; ++jj) px[jj] = (unsigned)XS[(size_t)(row0n + min(8 * wave + jj, lastn)) * 2048 + head * 64 + lane]; \
        { const bf16* src = BC + (size_t)(row0n + min(sr, lastn)) * 1024 + g * 128 + sn0; \
          pB[0] = *(const v4u*)src; pB[1] = *(const v4u*)(src + 64); pC[0] = *(const v4u*)(src + 512); pC[1] = *(const v4u*)(src + 576); }   \
        _Pragma("unroll") for (int t = 0; t < 2; ++t) { const size_t o = (size_t)(row0n + min(irow, lastn)) * 2048 + head * 64 + 16 * (tb0 + t) + 4 * fq; pxw[t] = *(const v2u*)(XS + o); pzw[t] = *(const v2u*)(PZ + o); } \
    } while (0)
#define SEQ_LOAD_FULL(cn) do { const int row0n = b * LP + 64 * (cn); \
        pdt = DT[(size_t)(row0n + lane) * NH + head]; \
        _Pragma("unroll") for (int jj = 0; jj < 8; ++jj) px[jj] = (unsigned)XS[(size_t)(row0n + 8 * wave + jj) * 2048 + head * 64 + lane]; \
        { const float* src = BC + (size_t)(row0n + sr) * 1024 + g * 128 + sn0; \
          _Pragma("unroll") for (int q = 0; q < 4; ++q) { pB[q] = *(const f32x4*)(src + 4 * q); pC[q] = *(const f32x4*)(src + 512 + 4 * q); } } \
        _Pragma("unroll") for (int t = 0; t < 2; ++t) { const size_t o = (size_t)(row0n + irow) * 2048 + head * 64 + 16 * (tb0 + t) + 4 * fq; pxw[t] = *(const v2u*)(XS + o); pzw[t] = *(const v2u*)(PZ + o); } \
    } while (0)
__device__ __forceinline__ void ssd_seq_unit(const Ctx& F, int b, int head) {
    const float* DT = (const float*)(F.ws + WS_DT); const bf16* XS = (const bf16*)(F.ws + WS_XS); const bf16* BC = (const bf16*)(F.ws + WS_BC); const bf16* PZ = (const bf16*)(F.ws + WS_PZ);
    bf16* MIX = (bf16*)(F.ws + WS_MIX);
    const int g = head >> 3, lane = F.lane, wave = F.wave, fr = lane & 15, fq = lane >> 4, ib = wave >> 1, tb0 = 2 * (wave & 1), irow = 16 * ib + fr;
    const int sr = F.tid >> 3, sn0 = (F.tid & 7) * 8;
    const float Ah = -expf(F.a_log[head]), Dh = F.d_skip[head];
    LAS unsigned char* Hs = F.lds + 106496; LAS unsigned char* Ms = F.lds + 123904;
    LAS float* tabA = (LAS float*)(F.lds + 133120); LAS float* tabD = (LAS float*)(F.lds + 133376);
    f32x4 Hacc[4];
#pragma unroll
    for (int pb = 0; pb < 4; ++pb) Hacc[pb] = (f32x4){0.f, 0.f, 0.f, 0.f};
    v4u pB[2], pC[2]; unsigned px[8]; float pdt; v2u pxw[2], pzw[2];
    SEQ_LOAD(0);
#pragma unroll 1
    for (int c = 0; c < NCH; ++c) {
        const int row0 = b * LP + 64 * c, nq = min(64, LP - 64 * c);
        LAS unsigned char* Cs = F.lds + (c & 1) * 53248; LAS unsigned char* Bs = Cs + 17408; LAS unsigned char* XT1 = Cs + 34816; LAS unsigned char* XT2 = Cs + 44032;
        const float dtj = pdt; const float acum = wave_scan_incl(dtj * Ah, lane), aend = __builtin_bit_cast(float, __builtin_amdgcn_readlane(__builtin_bit_cast(int, acum), 63)), wj = __expf(aend - acum) * dtj;
        if (wave == 0) { tabA[lane] = acum; tabD[lane] = dtj; }
        { LAS unsigned char* d = Bs + sr * 272 + sn0 * 2; *(LAS v4u*)d = pB[0]; *(LAS v4u*)(d + 128) = pB[1];
          d = Cs + sr * 272 + sn0 * 2; *(LAS v4u*)d = pC[0]; *(LAS v4u*)(d + 128) = pC[1]; }
        *(LAS v4u*)(XT1 + lane * 144 + wave * 16) = (v4u){px[0] | (px[1] << 16), px[2] | (px[3] << 16), px[4] | (px[5] << 16), px[6] | (px[7] << 16)};
        { unsigned w[4];
#pragma unroll
          for (int jj = 0; jj < 4; ++jj) { const int j0 = 8 * wave + 2 * jj; w[jj] = pk2(bflo(px[2 * jj]) * __builtin_bit_cast(float, __builtin_amdgcn_readlane(__builtin_bit_cast(int, wj), j0)), bflo(px[2 * jj + 1]) * __builtin_bit_cast(float, __builtin_amdgcn_readlane(__builtin_bit_cast(int, wj), j0 + 1))); }
          *(LAS v4u*)(XT2 + lane * 144 + wave * 16) = (v4u){w[0], w[1], w[2], w[3]}; }
        v2u xw[2], zw[2];
#pragma unroll
        for (int t = 0; t < 2; ++t) { xw[t] = pxw[t]; zw[t] = pzw[t]; }
        SEQ_LOAD(min(c + 1, NCH - 1));
        asm volatile("s_waitcnt lgkmcnt(0)" ::: "memory"); __builtin_amdgcn_s_barrier(); asm volatile("" ::: "memory");
        f32x4 cb[2] = {{0.f, 0.f, 0.f, 0.f}, {0.f, 0.f, 0.f, 0.f}}; bf16x8 afr[4];
#pragma unroll
        for (int ks = 0; ks < 4; ++ks) { afr[ks] = *(const LAS bf16x8*)(Cs + irow * 272 + (32 * ks + 8 * fq) * 2);
#pragma unroll
            for (int t = 0; t < 2; ++t) { const bf16x8 wf = *(const LAS bf16x8*)(Bs + (16 * (tb0 + t) + fr) * 272 + (32 * ks + 8 * fq) * 2); cb[t] = __builtin_amdgcn_mfma_f32_16x16x32_bf16(wf, afr[ks], cb[t], 0, 0, 0); } }
        const float mi = tabA[irow];
#pragma unroll
        for (int t = 0; t < 2; ++t) { float mv[4];
            const f32x4 aj4 = *(const LAS f32x4*)(tabA + 16 * (tb0 + t) + 4 * fq), dj4 = *(const LAS f32x4*)(tabD + 16 * (tb0 + t) + 4 * fq);
#pragma unroll
            for (int e = 0; e < 4; ++e) { const int j = 16 * (tb0 + t) + 4 * fq + e;
                mv[e] = (j <= irow) ? cb[t][e] * __expf(fminf(mi - aj4[e], 0.f)) * dj4[e] : 0.f; }
            *(LAS v2u*)(Ms + irow * 144 + (16 * (tb0 + t) + 4 * fq) * 2) = (v2u){pk2(mv[0], mv[1]), pk2(mv[2], mv[3])}; }
#pragma unroll
        for (int pb = 0; pb < 4; ++pb) *(LAS v2u*)(Hs + (16 * pb + fr) * 272 + (16 * wave + 4 * fq) * 2) = (v2u){pk2(Hacc[pb][0], Hacc[pb][1]), pk2(Hacc[pb][2], Hacc[pb][3])};
        asm volatile("s_waitcnt lgkmcnt(0)" ::: "memory"); __builtin_amdgcn_s_barrier(); asm volatile("" ::: "memory");
        f32x4 acc[2] = {{0.f, 0.f, 0.f, 0.f}, {0.f, 0.f, 0.f, 0.f}};
#pragma unroll
        for (int ks = 0; ks < 4; ++ks) {
#pragma unroll
            for (int t = 0; t < 2; ++t) { const bf16x8 wf = *(const LAS bf16x8*)(Hs + (16 * (tb0 + t) + fr) * 272 + (32 * ks + 8 * fq) * 2); acc[t] = __builtin_amdgcn_mfma_f32_16x16x32_bf16(wf, afr[ks], acc[t], 0, 0, 0); } }
        const float ei = __expf(mi);
#pragma unroll
        for (int t = 0; t < 2; ++t) acc[t] = acc[t] * ei;
#pragma unroll
        for (int ks = 0; ks < 2; ++ks) { const bf16x8 af = *(const LAS bf16x8*)(Ms + irow * 144 + (32 * ks + 8 * fq) * 2);
#pragma unroll
            for (int t = 0; t < 2; ++t) { const bf16x8 wf = *(const LAS bf16x8*)(XT1 + (16 * (tb0 + t) + fr) * 144 + (32 * ks + 8 * fq) * 2); acc[t] = __builtin_amdgcn_mfma_f32_16x16x32_bf16(wf, af, acc[t], 0, 0, 0); } }
        if (irow < nq) {
#pragma unroll
            for (int t = 0; t < 2; ++t) {
                const float y0 = (acc[t][0] + Dh * bflo(xw[t].x)) * siluf_(bflo(zw[t].x)), y1 = (acc[t][1] + Dh * bfhi(xw[t].x)) * siluf_(bfhi(zw[t].x));
                const float y2 = (acc[t][2] + Dh * bflo(xw[t].y)) * siluf_(bflo(zw[t].y)), y3 = (acc[t][3] + Dh * bfhi(xw[t].y)) * siluf_(bfhi(zw[t].y));
                *(v2u*)(MIX + (size_t)(row0 + irow) * 4096 + 2048 + head * 64 + 16 * (tb0 + t) + 4 * fq) = (v2u){pk2(y0, y1), pk2(y2, y3)}; }
        }
        const float dec = __expf(aend);
#pragma unroll
        for (int pb = 0; pb < 4; ++pb) Hacc[pb] = Hacc[pb] * dec;
#pragma unroll
        for (int ks = 0; ks < 2; ++ks) {
            unsigned wv[4];
#pragma unroll
            for (int jj = 0; jj < 4; ++jj) { const LAS unsigned char* q = Bs + (32 * ks + 8 * fq + 2 * jj) * 272 + (16 * wave + fr) * 2;
                wv[jj] = (unsigned)*(const LAS unsigned short*)q | ((unsigned)*(const LAS unsigned short*)(q + 272) << 16); }
            const bf16x8 wf = __builtin_bit_cast(bf16x8, (v4u){wv[0], wv[1], wv[2], wv[3]});
#pragma unroll
            for (int pb = 0; pb < 4; ++pb) { const bf16x8 af = *(const LAS bf16x8*)(XT2 + (16 * pb + fr) * 144 + (32 * ks + 8 * fq) * 2); Hacc[pb] = __builtin_amdgcn_mfma_f32_16x16x32_bf16(wf, af, Hacc[pb], 0, 0, 0); }
        }
    }
    float* op = F.out + O_PSSD + ((size_t)b * NH + head) * 8192;
#pragma unroll
    for (int pb = 0; pb < 4; ++pb) *(f32x4*)(op + (size_t)(16 * pb + fr) * 128 + 16 * wave + 4 * fq) = Hacc[pb];
    __syncthreads();
}

__device__ __forceinline__ void phase_scan1(const Ctx& F) {
    constexpr int NPU = NB * NH;
    if (F.G >= 2 * NPU) {
        if (F.blk < NPU) { const int v_ = (F.blk & 7) * (NPU / 8) + (F.blk >> 3);
            ssd_seq_unit(F, v_ >> 5, v_ & 31);
        } else { ssd_sample_blk(F, F.blk - NPU, F.G - NPU);
#ifdef PROBE_S2
            ssd_sample_blk(F, F.blk - NPU, F.G - NPU);
#endif
            lru_aggregate(F, F.blk - NPU, F.G - NPU); }
    } else {
        for (int u = F.blk; u < NPU; u += F.G) ssd_seq_unit(F, u >> 5, u & 31);
        ssd_sample_blk(F, F.blk, F.G); lru_aggregate(F, F.blk, F.G);
    }
}

__device__ __forceinline__ void phase_scan2(const Ctx& F) {
    const float* Ai = (const float*)(F.ws + WS_A); const float* Bi = (const float*)(F.ws + WS_BT); const float* GA = (const float*)(F.ws + WS_AGGA); const float* GH = (const float*)(F.ws + WS_AGGH);
    const bf16* PG = (const bf16*)(F.ws + WS_PG); bf16* MIX = (bf16*)(F.ws + WS_MIX);
    constexpr int NPI = NB * NSEG * 2048, NSI = DB * 2048;
    for (int idx = F.blk * NTHR + F.tid; idx < NPI + NSI; idx += F.G * NTHR) {
        if (idx < NPI) {
            const int ch = idx & 2047, sg = (idx >> 11) % NSEG, b = idx / (2048 * NSEG);
            float hh = 0.f;
            for (int s2 = 0; s2 < sg; s2 += 8) { float ga[8], gh[8];
#pragma unroll
                for (int k = 0; k < 8; ++k) { const int sk = (s2 + k < sg) ? s2 + k : 0; const int o = (b * NSEG + sk) * 2048 + ch; ga[k] = GA[o]; gh[k] = GH[o]; }
#pragma unroll
                for (int k = 0; k < 8; ++k) if (s2 + k < sg) hh = ga[k] * hh + gh[k]; }
            const int t0 = sg * 64, t1 = min(t0 + 64, LP);
            if (t1 - t0 == 64) {
                for (int t = t0; t < t1; t += 32) { float av[32], bv[32]; bf16 gv[32];
#pragma unroll
                    for (int k = 0; k < 32; ++k) { const size_t o = (size_t)(b * LP + t + k) * 2048 + ch; av[k] = Ai[o]; bv[k] = Bi[o]; gv[k] = PG[o]; }
#pragma unroll
                    for (int k = 0; k < 32; ++k) { hh = av[k] * hh + bv[k]; MIX[(size_t)(b * LP + t + k) * 4096 + ch] = (bf16)f2bf(hh * gelu_tanh(bf1(gv[k]))); } }
            } else {
                for (int t = t0; t < t1; t += 16) { float av[16], bv[16]; bf16 gv[16];
#pragma unroll
                    for (int k = 0; k < 16; ++k) { const size_t o = (size_t)(b * LP + t + k) * 2048 + ch; av[k] = Ai[o]; bv[k] = Bi[o]; gv[k] = PG[o]; }
#pragma unroll
                    for (int k = 0; k < 16; ++k) { hh = av[k] * hh + bv[k]; MIX[(size_t)(b * LP + t + k) * 4096 + ch] = (bf16)f2bf(hh * gelu_tanh(bf1(gv[k]))); } }
            }
            if (sg == NSEG - 1) F.out[O_PLH + (size_t)b * 2048 + ch] = hh;
        } else {
            const int i2 = idx - NPI, ch = i2 & 2047, s = i2 >> 11; float hh = 0.f;
#pragma unroll
            for (int j = 0; j < 4; ++j) { const size_t r = (size_t)(MP + 4 * s + j); const size_t o = r * 2048 + ch; hh = Ai[o] * hh + Bi[o];
                MIX[r * 4096 + ch] = (bf16)f2bf(hh * gelu_tanh(bf1(PG[o]))); }
            F.out[O_SLH + (size_t)s * 2048 + ch] = hh;
        }
    }
}

__device__ __forceinline__ void phase_mixnorm(const Ctx& F, bool dry = false) {
    const int gw = F.blk * NWAVES + F.wave, NGW = F.G * NWAVES; bf16* MIX = (bf16*)(F.ws + WS_MIX); bf16* DST = dry ? (bf16*)(F.ws + WS_PART) : MIX;
    for (int m = gw; m < MR; m += NGW) {
        bf16* rowp = MIX + (size_t)m * 4096 + 8 * F.lane; bf16* dstp = DST + (size_t)m * 4096 + 8 * F.lane; v4u w[8]; float ss[8];
#pragma unroll
        for (int j = 0; j < 8; ++j) { w[j] = *(const v4u*)(rowp + 512 * j);
            const float a0 = bflo(w[j].x), a1 = bfhi(w[j].x), a2 = bflo(w[j].y), a3 = bfhi(w[j].y), a4 = bflo(w[j].z), a5 = bfhi(w[j].z), a6 = bflo(w[j].w), a7 = bfhi(w[j].w);
            ss[j] = (a0 * a0 + a1 * a1) + (a2 * a2 + a3 * a3) + (a4 * a4 + a5 * a5) + (a6 * a6 + a7 * a7); }
        const float sl = wave_sum((ss[0] + ss[1]) + (ss[2] + ss[3])); const float rl = rsqrtf(sl * (1.f / 2048) + EPS);
#pragma unroll
        for (int j = 0; j < 8; ++j) {
            float rs = rl; if (j >= 4) rs = rsqrtf(wave_sum(ss[j]) * (1.f / 512) + EPS);
            const float* gp = (j < 4 ? F.g_lru_out + 512 * j : F.g_ssd_out + 512 * (j - 4)) + 8 * F.lane; const f32x4 g0 = *(const f32x4*)gp, g1 = *(const f32x4*)(gp + 4);
            v4u o; o.x = pk2(bflo(w[j].x) * rs * g0.x, bfhi(w[j].x) * rs * g0.y); o.y = pk2(bflo(w[j].y) * rs * g0.z, bfhi(w[j].y) * rs * g0.w);
            o.z = pk2(bflo(w[j].z) * rs * g1.x, bfhi(w[j].z) * rs * g1.y); o.w = pk2(bflo(w[j].w) * rs * g1.z, bfhi(w[j].w) * rs * g1.w);
            *(v4u*)(dstp + 512 * j) = o; }
    }
}


__device__ __forceinline__ f32x4 gemm_out4(const Ctx& F, int m, int j, int nfull, int P, bool& has_res) {
    const int T = (m >> 8) * 8 + j;
    if (T < nfull || P == 1) { has_res = true; return *(const f32x4*)((const float*)(F.ws + WS_PART) + (size_t)m * DM + 4 * F.lane + 256 * j); }
    has_res = false;
    const float* r = (const float*)(F.ws + WS_R2) + (size_t)(T - nfull) * P * 65536 + (size_t)(m & 255) * 256 + 4 * F.lane;
    f32x4 v = *(const f32x4*)r;
    for (int k = 1; k < P; ++k) v += *(const f32x4*)(r + (size_t)k * 65536);
    return v;
}
__device__ __forceinline__ void phase_resid1(const Ctx& F) {
    const int gw = F.blk * NWAVES + F.wave, NGW = F.G * NWAVES; float* X1 = (float*)(F.ws + WS_PART); bf16* HP = (bf16*)(F.ws + WS_HP);
    int nfull, P; pg8::split_params(35 * 8, F.G, 4096 / 64, nfull, P);
    for (int m = gw; m < MR; m += NGW) {
        const float* xr = xrow_ptr(F, m); f32x4 v[8];
#pragma unroll
        for (int j = 0; j < 8; ++j) { bool hr; v[j] = gemm_out4(F, m, j, nfull, P, hr); if (!hr) { v[j] += *(const f32x4*)(xr + 4 * F.lane + 256 * j); *(f32x4*)(X1 + (size_t)m * DM + 4 * F.lane + 256 * j) = v[j]; } }
        rms_row_store(v, F.g_mlp, HP + (size_t)m * DM, F.lane);
    }
}
__device__ __forceinline__ void phase_final(const Ctx& F) {
    const int gw = F.blk * NWAVES + F.wave, NGW = F.G * NWAVES; const float* X1 = (const float*)(F.ws + WS_PART);
    int nfull, P; pg8::split_params(35 * 8, F.G, DFF / 64, nfull, P);
    for (int m = gw; m < MR; m += NGW) {
        float* orow;
        if (m < MP) { const int b = m / LP, t = m - b * LP; if (t < NMETA) continue; orow = F.out + O_YP + ((size_t)b * SEQ + (t - NMETA)) * DM; } else orow = F.out + O_YS + (size_t)(m - MP) * DM;
        f32x4 v[8]; float ss = 0.f;
#pragma unroll
        for (int j = 0; j < 8; ++j) { bool hr; v[j] = gemm_out4(F, m, j, nfull, P, hr); if (!hr) v[j] += *(const f32x4*)(X1 + (size_t)m * DM + 4 * F.lane + 256 * j); ss += (v[j].x * v[j].x + v[j].y * v[j].y) + (v[j].z * v[j].z + v[j].w * v[j].w); }
        const float rs = rsqrtf(wave_sum(ss) * (1.f / DM) + EPS);
#pragma unroll
        for (int j = 0; j < 8; ++j) { const f32x4 gg = *(const f32x4*)(F.g_final + 4 * F.lane + 256 * j); *(f32x4*)(orow + 4 * F.lane + 256 * j) = v[j] * rs * gg; }
    }
}

#define RLX_AGENT __ATOMIC_RELAXED, __HIP_MEMORY_SCOPE_AGENT
constexpr size_t WS_BAR = 4096 * 4;
#define XB_TMO      128
#define XB_XCNT(j)  (256  + 64 * (j))
#define XB_XSUB(j)  (1280 + 64 * (j))
#define XB_XGEN(j)  (2304 + 64 * (j))
#define XB_TOP      3328
#define XB_TOPGEN   3392
#define XCD_BAR_WORDS 3456
#define XB_SPIN_CAP (1u << 18)

__device__ __forceinline__ unsigned xb_ld(unsigned* p)              { return __hip_atomic_load(p, __ATOMIC_RELAXED, __HIP_MEMORY_SCOPE_AGENT); }
__device__ __forceinline__ unsigned xb_add(unsigned* p, unsigned v) { return __hip_atomic_fetch_add(p, v, __ATOMIC_RELAXED, __HIP_MEMORY_SCOPE_AGENT); }
__device__ __forceinline__ unsigned xb_xcc_id() { return (unsigned)__builtin_amdgcn_s_getreg((3 << 11) | 20) & 0xFu; }
#define XB_SPIN(cond, bar) do { unsigned _sp = 0; while (cond) { __builtin_amdgcn_s_sleep(1); \
    if ((++_sp & 255u) == 0u) { if (xb_ld(&(bar)[XB_TMO])) break; if (_sp > XB_SPIN_CAP) { atomicAdd(&(bar)[XB_TMO], 1u); break; } } } } while (0)

struct XcdBarrier {
    unsigned* bar; unsigned x;
    volatile LAS unsigned* st;
};

__device__ __forceinline__ XcdBarrier xcd_barrier_post(unsigned* bar, volatile LAS unsigned* st) {
    XcdBarrier b; b.bar = bar; b.x = xb_xcc_id(); b.st = st;
    if (threadIdx.x == 0) (void)xb_add(&bar[XB_XCNT(b.x)], 1u);
    return b;
}
__device__ __forceinline__ void xcd_barrier_complete(unsigned* bar, unsigned x, unsigned& nloc, unsigned& nx) {
    const unsigned G = gridDim.x * gridDim.y * gridDim.z;
    unsigned sum, cnt, mine, sp = 0u;
    for (;;) {
        sum = 0u; cnt = 0u; mine = 0u;
#pragma unroll
        for (unsigned j = 0; j < 16; ++j) { const unsigned c = xb_ld(&bar[XB_XCNT(j)]); sum += c; cnt += (c > 0u) ? 1u : 0u; mine = (j == x) ? c : mine; }
        if (sum == G) break;
        __builtin_amdgcn_s_sleep(1);
        if ((++sp & 255u) == 0u) { if (xb_ld(&bar[XB_TMO])) break; if (sp > XB_SPIN_CAP) { atomicAdd(&bar[XB_TMO], 1u); break; } }
    }
    nloc = mine > 0u ? mine : 1u; nx = cnt > 0u ? cnt : 1u;
}

__device__ __forceinline__ void xcd_barrier(const XcdBarrier& b) {
    asm volatile("s_waitcnt vmcnt(0)" ::: "memory");
    __syncthreads();
    if (threadIdx.x == 0) {
        unsigned* bar = b.bar;
        __builtin_amdgcn_s_waitcnt(0);
        unsigned nloc = b.st[0], nx = b.st[1];
        if (nloc == 0u) { xcd_barrier_complete(bar, b.x, nloc, nx); b.st[0] = nloc; b.st[1] = nx; }
        const unsigned old = xb_add(&bar[XB_XSUB(b.x)], 1u);
        const unsigned gen = old / nloc;
        if (old + 1u == (gen + 1u) * nloc) {
            __builtin_amdgcn_fence(__ATOMIC_RELEASE, "agent");
            asm volatile("s_waitcnt vmcnt(0)" ::: "memory");
            const unsigned og = xb_add(&bar[XB_TOP], 1u);
            const unsigned tg = og / nx;
            if (og + 1u == (tg + 1u) * nx) xb_add(&bar[XB_TOPGEN], 1u);
            else XB_SPIN(xb_ld(&bar[XB_TOPGEN]) == tg, bar);
            __builtin_amdgcn_fence(__ATOMIC_ACQUIRE, "agent");
            xb_add(&bar[XB_XGEN(b.x)], 1u);
            asm volatile("s_waitcnt vmcnt(0)" ::: "memory");
        } else {
            XB_SPIN(xb_ld(&bar[XB_XGEN(b.x)]) == gen, bar);
            __builtin_amdgcn_fence(__ATOMIC_ACQUIRE, "agent");
            asm volatile("s_waitcnt vmcnt(0)" ::: "memory");
        }
    }
    __syncthreads();
}

__global__ void __launch_bounds__(NTHR, 2) hymba_fwd(Args args) {
    extern __shared__ __attribute__((aligned(16))) unsigned char lds_raw[];
    cg::grid_group grid = cg::this_grid();
    Ctx F;
    F.xp = args.in[0]; F.xs = args.in[1]; F.st_lru_h = args.in[2]; F.st_lru_conv = args.in[3]; F.st_ssd = args.in[4]; F.st_ssd_conv = args.in[5]; F.meta = args.in[6]; F.g_mix = args.in[7];
    F.w_in = args.in[8]; F.conv_lru_w = args.in[9]; F.conv_lru_b = args.in[10]; F.lru_wa = args.in[11]; F.lru_ba = args.in[12]; F.lru_wx = args.in[13]; F.lru_bx = args.in[14]; F.lru_lam = args.in[15];
    F.g_lru_out = args.in[16]; F.conv_ssd_w = args.in[17]; F.conv_ssd_b = args.in[18]; F.dt_bias = args.in[19]; F.a_log = args.in[20]; F.d_skip = args.in[21]; F.g_ssd_out = args.in[22];
    F.w_out = args.in[23]; F.g_mlp = args.in[24]; F.w_up = args.in[25]; F.w_down = args.in[26]; F.g_final = args.in[27];
    F.out = args.out; F.ws = args.ws; F.lds = (LAS unsigned char*)lds_raw;
    F.tid = threadIdx.x; F.lane = F.tid & 63; F.wave = __builtin_amdgcn_readfirstlane(F.tid >> 6); F.blk = blockIdx.x; F.G = gridDim.x;
    const int lo = args.ph_lo, hi = args.ph_hi;
    volatile LAS unsigned* bst = (volatile LAS unsigned*)(F.lds + LDS_BYTES - 64);
    if (F.tid < 16) bst[F.tid] = 0u;
    __syncthreads();
    XcdBarrier xbar; xbar.bar = (unsigned*)(F.ws + WS_BAR); xbar.x = 0; xbar.st = bst;
    if (hi - lo > 1) xbar = xcd_barrier_post((unsigned*)(F.ws + WS_BAR), bst);
    if (hi - lo > 1) grid.sync();
#define IN(k) (lo <= (k) && (k) < hi)
#ifndef PROBE_PH
#define PROBE_PH -1
#endif
#define REPS(k) for (int rep_ = 0; rep_ < (PROBE_PH == (k) ? 2 : 1); ++rep_)
#ifndef PROBE_SYNC
#define PROBE_SYNC 1
#endif
#define SEAM(k) do { if (IN(k) && IN((k) + 1)) { for (int s_ = 0; s_ < PROBE_SYNC; ++s_) { xcd_barrier(xbar); } } } while (0)
    if (IN(0)) REPS(0) phase_prologue(F);
    SEAM(0);
    if (IN(1)) {
        {
        pg8::Gemm g{(const pg8::bf16_t*)(F.ws + WS_XN), (const pg8::bf16_t*)(F.ws + WS_WIN), MPAD, NMAIN, 2048}; pg8::StaticOrder S; S.init(MPAD, NMAIN, F.G, F.blk, 2048);
        pg8::EpiProj E{(bf16*)(F.ws + WS_PG), (bf16*)(F.ws + WS_PXL), (bf16*)(F.ws + WS_PZ), (bf16*)(F.ws + WS_PXBC)};
        pg8::gemm_phase<pg8::EpiProj, pg8::StaticOrder, PG8_ALIGN, PG8_SP2>(F.lds, g, S, E);
        phase_dt(F);
            }
        if (PROBE_PH == 1) {
        pg8::Gemm g{(const pg8::bf16_t*)(F.ws + WS_XN), (const pg8::bf16_t*)(F.ws + WS_WIN), MPAD, NMAIN, 2048}; pg8::StaticOrder S; S.init(MPAD, NMAIN, F.G, F.blk, 2048);
        pg8::EpiProj E{(bf16*)(F.ws + WS_PG), (bf16*)(F.ws + WS_PXL), (bf16*)(F.ws + WS_PZ), (bf16*)(F.ws + WS_PXBC)};
        pg8::gemm_phase<pg8::EpiProj, pg8::StaticOrder, PG8_ALIGN, PG8_SP2>(F.lds, g, S, E);
        phase_dt(F);
            }
    }
    SEAM(1);
    if (IN(2)) REPS(2) phase_conv(F);
    SEAM(2);
    if (IN(3)) REPS(3) { phase_gates(F); __syncthreads(); }
    SEAM(3);
    if (IN(4)) REPS(4) phase_scan1(F);
    SEAM(4);
    if (IN(5)) REPS(5) phase_scan2(F);
    SEAM(5);
    if (IN(6)) { if (PROBE_PH == 6) phase_mixnorm(F, true); phase_mixnorm(F); }
    SEAM(6);
    if (IN(7)) {
        {
        pg8::Gemm g{(const pg8::bf16_t*)(F.ws + WS_MIX), (const pg8::bf16_t*)(F.ws + WS_WOUT), MPAD, 2048, 4096}; pg8::SplitOrder S; S.init(MPAD, 2048, F.G, F.blk, 4096);
        pg8::EpiF32S E{(float*)(F.ws + WS_PART), 2048, (float*)(F.ws + WS_R2), S.nN, S.nfull, S.P, 2, nullptr, F.xp, F.xs, F.meta};
        pg8::gemm_phase<pg8::EpiF32S, pg8::SplitOrder, PG8_ALIGN, PG8_SP2>(F.lds, g, S, E);
            }
        if (PROBE_PH == 7) {
        pg8::Gemm g{(const pg8::bf16_t*)(F.ws + WS_MIX), (const pg8::bf16_t*)(F.ws + WS_WOUT), MPAD, 2048, 4096}; pg8::SplitOrder S; S.init(MPAD, 2048, F.G, F.blk, 4096);
        pg8::EpiF32S E{(float*)(F.ws + WS_PART), 2048, (float*)(F.ws + WS_R2), S.nN, S.nfull, S.P, 2, nullptr, F.xp, F.xs, F.meta};
        pg8::gemm_phase<pg8::EpiF32S, pg8::SplitOrder, PG8_ALIGN, PG8_SP2>(F.lds, g, S, E);
            }
    }
    SEAM(7);
    if (IN(8)) REPS(8) phase_resid1(F);
    SEAM(8);
    if (IN(9)) {
        {
        pg8::Gemm g{(const pg8::bf16_t*)(F.ws + WS_HP), (const pg8::bf16_t*)(F.ws + WS_WUP), MPAD, DFF, 2048}; pg8::StaticOrder S; S.init(MPAD, DFF, F.G, F.blk, 2048);
        pg8::EpiRelu2 E{(bf16*)(F.ws + WS_H), DFF};
        pg8::gemm_phase<pg8::EpiRelu2, pg8::StaticOrder, PG8_ALIGN, PG8_SP2>(F.lds, g, S, E);
        { int part, nparts; slack_parts(35 * 32, F.G, F.blk, part, nparts); if (part >= 0) convert_range(F, I_IN + I_OUT + I_UP, I_IN + I_OUT + I_UP + I_DN, part, nparts); }
            }
        if (PROBE_PH == 9) { __syncthreads();
        pg8::Gemm g{(const pg8::bf16_t*)(F.ws + WS_HP), (const pg8::bf16_t*)(F.ws + WS_WUP), MPAD, DFF, 2048}; pg8::StaticOrder S; S.init(MPAD, DFF, F.G, F.blk, 2048);
        pg8::EpiRelu2 E{(bf16*)(F.ws + WS_H), DFF};
        pg8::gemm_phase<pg8::EpiRelu2, pg8::StaticOrder, PG8_ALIGN, PG8_SP2>(F.lds, g, S, E);
        { int part, nparts; slack_parts(35 * 32, F.G, F.blk, part, nparts); if (part >= 0) convert_range(F, I_IN + I_OUT + I_UP, I_IN + I_OUT + I_UP + I_DN, part, nparts); }
            }
    }
    SEAM(9);
    if (IN(10)) {
        {
        pg8::Gemm g{(const pg8::bf16_t*)(F.ws + WS_H), (const pg8::bf16_t*)(F.ws + WS_WDN), MPAD, 2048, DFF}; pg8::SplitOrder S; S.init(MPAD, 2048, F.G, F.blk, DFF);
        pg8::EpiF32S E{(float*)(F.ws + WS_PART), 2048, (float*)(F.ws + WS_R2), S.nN, S.nfull, S.P, 1, (const float*)(F.ws + WS_PART), nullptr, nullptr, nullptr};
        pg8::gemm_phase<pg8::EpiF32S, pg8::SplitOrder, PG8_ALIGN, PG8_SP2>(F.lds, g, S, E);
            }
        if (PROBE_PH == 10) {
        pg8::Gemm g{(const pg8::bf16_t*)(F.ws + WS_H), (const pg8::bf16_t*)(F.ws + WS_WDN), MPAD, 2048, DFF}; pg8::SplitOrder S; S.init(MPAD, 2048, F.G, F.blk, DFF);
        pg8::EpiF32S E{(float*)(F.ws + WS_PART), 2048, (float*)(F.ws + WS_R2), S.nN, S.nfull, S.P, 1, (const float*)(F.ws + WS_PART), nullptr, nullptr, nullptr};
        pg8::gemm_phase<pg8::EpiF32S, pg8::SplitOrder, PG8_ALIGN, PG8_SP2>(F.lds, g, S, E);
            }
    }
    SEAM(10);
    if (IN(11)) REPS(11) phase_final(F);
#undef IN
#undef SEAM
}

#ifndef N_LAUNCH_MODE
#define N_LAUNCH_MODE 1
#endif
extern "C" void kernel_launch(void* const* d_in, const int* in_sizes, int n_in, void* d_out, int out_size, void* d_ws, size_t ws_size, hipStream_t stream) {
    static int grid = 0;
    if (grid == 0) {
        if (n_in != 28 || (size_t)out_size != O_END || ws_size < WS_END) { fprintf(stderr, "kernel_launch: unexpected shapes: n_in %d out %d ws %zu\n", n_in, out_size, ws_size); grid = -1; return; }
        int dev = 0, cus = 0, per_cu = 0;
        (void)hipGetDevice(&dev); (void)hipDeviceGetAttribute(&cus, hipDeviceAttributeMultiprocessorCount, dev);
        if (hipFuncSetAttribute((const void*)hymba_fwd, hipFuncAttributeMaxDynamicSharedMemorySize, LDS_BYTES) != hipSuccess) { fprintf(stderr, "kernel_launch: hipFuncSetAttribute failed\n"); grid = -1; return; }
        if (hipOccupancyMaxActiveBlocksPerMultiprocessor(&per_cu, (const void*)hymba_fwd, NTHR, LDS_BYTES) != hipSuccess || per_cu < 1) { fprintf(stderr, "kernel_launch: occupancy query says %d\n", per_cu); per_cu = 1; }
        (void)hipGetLastError();
        grid = cus * 1;
        if (grid <= 0) grid = 256;
    }
    if (grid < 0) return;
    Args a{};
    for (int i = 0; i < 28; ++i) a.in[i] = (const float*)d_in[i];
    a.out = (float*)d_out; a.ws = (unsigned char*)d_ws;
#if N_LAUNCH_MODE == 1
    (void)hipMemsetAsync((char*)d_ws + WS_BAR, 0, XCD_BAR_WORDS * 4, stream);
    a.ph_lo = 0; a.ph_hi = NPHASE;
    void* kargs[] = {&a};
    hipError_t e = hipLaunchCooperativeKernel((const void*)hymba_fwd, dim3(grid), dim3(NTHR), kargs, LDS_BYTES, stream);
    if (e != hipSuccess) fprintf(stderr, "cooperative launch failed: %s (grid %d)\n", hipGetErrorString(e), grid);
#else
    for (int p = 0; p < NPHASE; ++p) { a.ph_lo = p; a.ph_hi = p + 1; hipLaunchKernelGGL(hymba_fwd, dim3(grid), dim3(NTHR), LDS_BYTES, stream, a); }
#endif
}
```

```cpp
#include <hip/hip_runtime.h>
#include <hip/hip_cooperative_groups.h>
#include <cstdio>
#include <cstdint>
namespace cg = cooperative_groups;
namespace pg8 {
#define PG8_LAS __attribute__((address_space(3)))
typedef unsigned short bf16_t;
typedef short bf16x8 __attribute__((ext_vector_type(8)));
typedef float f32x4 __attribute__((ext_vector_type(4)));
typedef unsigned u32x4 __attribute__((ext_vector_type(4)));
constexpr int BM = 256, BK = 64, HALF = 128, HTB = HALF * BK * 2  , STAGE_BYTES = 8 * HTB, NXCD = 8, WGM = 8;

__host__ __device__ __forceinline__ int lds_byte(int r, int c) { const int st = (r >> 4) * 2 + (c >> 5), rr = r & 15, cc = c & 31, ob = rr * 64 + cc * 2; return st * 1024 + (ob ^ (((ob >> 9) & 1) << 5)); }
__host__ __device__ __forceinline__ void stage_rc(int b, int& R, int& C) { const int st = b / 1024, sb = b % 1024, swz = sb ^ (((sb >> 9) & 1) << 5); R = (st >> 1) * 16 + swz / 64; C = (st & 1) * 32 + (swz % 64) / 2; }
__host__ __device__ __forceinline__ int perm32(int rho) { const int n = rho >> 4, i = rho & 15; return 8 * (i >> 2) + 4 * n + (i & 3); }

struct Unit { int pm, pn, kt0, nt, slot; };
struct Gemm { const bf16_t* A; const bf16_t* Bt; int M, N, K; };

struct StaticOrder {
    int nM, nN, nwg, G, c, ntk;
    __host__ __device__ __forceinline__ void init(int M, int N, int G_, int c_, int K_) { nM = M / BM; nN = N / BM; nwg = nM * nN; G = G_; c = c_; ntk = K_ / BK; }
    __host__ __device__ __forceinline__ bool next(int i, Unit& u) const {
        const long L = (long)i * G + c; if (L >= nwg) return false;
        int wgid = (int)L; { const int q = nwg / NXCD, r = nwg % NXCD, xcd = wgid % NXCD, off = wgid / NXCD; wgid = (xcd < r ? xcd * (q + 1) : r * (q + 1) + (xcd - r) * q) + off; }
        const int nig = WGM * nN, gid = wgid / nig, fm = gid * WGM, gsz = (nM - fm) < WGM ? (nM - fm) : WGM;
        u.pm = fm + ((wgid % nig) % gsz); u.pn = (wgid % nig) / gsz; u.kt0 = 0; u.nt = ntk; u.slot = -1; return true;
    }
    __device__ __forceinline__ void a_ready(const Unit&) const {}
    __device__ __forceinline__ void done(const Unit&) const {}
};


__host__ __device__ __forceinline__ void split_params(int nwg, int G, int ntk, int& nfull, int& P) {
    nfull = (nwg / G) * G; const int rem = nwg - nfull; P = 1;
    if (rem > 0) { int p = G / rem; p = p >= 8 ? 8 : (p >= 4 ? 4 : (p >= 2 ? 2 : 1)); while (p > 1 && ((ntk / p) < 4 || (ntk % (2 * p)) != 0)) p >>= 1; P = p; }
}
struct SplitOrder {
    int nN, nwg, G, c, ntk, nfull, P, perm;
    __host__ __device__ __forceinline__ void init(int M, int N, int G_, int c_, int K_) { nN = N / BM; nwg = (M / BM) * nN; G = G_; c = c_; ntk = K_ / BK; split_params(nwg, G, ntk, nfull, P);
        perm = (G % NXCD == 0) ? (c % NXCD) * (G / NXCD) + c / NXCD : c; }
    __host__ __device__ __forceinline__ bool next(int i, Unit& u) const {
        const int rounds = nfull / G;
        if (i < rounds) { const int T = i * G + perm; u.pm = T / nN; u.pn = T % nN; u.kt0 = 0; u.nt = ntk; u.slot = -1; return true; }
        int j = (i - rounds) * G + c; const int rem = nwg - nfull;
        if (j >= rem * P) return false;
        const int T = nfull + j / P, pc = j % P; u.pm = T / nN; u.pn = T % nN; u.nt = ntk / P; u.kt0 = pc * u.nt; u.slot = (P > 1) ? pc : -1; return true;
    }
    __device__ __forceinline__ void a_ready(const Unit&) const {}
    __device__ __forceinline__ void done(const Unit&) const {}
};
__device__ __forceinline__ unsigned cvt_pk_bf16(float lo, float hi) { unsigned r; asm volatile("v_cvt_pk_bf16_f32 %0, %1, %2" : "=v"(r) : "v"(lo), "v"(hi)); return r; }
struct EpiF32 {
    static constexpr bool PERM = false, AFTER_DRAIN = false;
    float* C; int ldc;
    __device__ __forceinline__ void operator()(const f32x4 (&acc)[2][2][4][2], const Unit& u, int wr, int wc, int fr, int fq) const {
        const int row0 = u.pm * BM + wr * 64 + fr, col0 = u.pn * BM + wc * 32 + 4 * fq;
#pragma unroll
        for (int ai = 0; ai < 2; ++ai)
#pragma unroll
            for (int m = 0; m < 4; ++m) { float* rowp = C + (size_t)(row0 + ai * HALF + m * 16) * ldc + col0;
#pragma unroll
                for (int bj = 0; bj < 2; ++bj)
#pragma unroll
                    for (int n = 0; n < 2; ++n) *(f32x4*)(rowp + bj * HALF + n * 16) = acc[ai][bj][m][n]; }
    }
};
struct EpiProj {
    static constexpr bool PERM = true, AFTER_DRAIN = false;
    bf16_t *PG, *PXL, *PZ, *PXBC;
    __device__ __forceinline__ void operator()(const f32x4 (&acc)[2][2][4][2], const Unit& u, int wr, int wc, int fr, int fq) const {
        const int row0 = u.pm * BM + wr * 64 + fr;
        bf16_t* base; int ldc, colt;
        if (u.pn < 8) { base = PG; ldc = 2048; colt = u.pn * 256; }
        else if (u.pn < 16) { base = PXL; ldc = 2048; colt = (u.pn - 8) * 256; }
        else if (u.pn < 24) { base = PZ; ldc = 2048; colt = (u.pn - 16) * 256; }
        else { base = PXBC; ldc = 3072; colt = (u.pn - 24) * 256; }
        const int col0 = colt + wc * 32 + 8 * fq;
#pragma unroll
        for (int ai = 0; ai < 2; ++ai)
#pragma unroll
            for (int m = 0; m < 4; ++m) { bf16_t* rowp = base + (size_t)(row0 + ai * HALF + m * 16) * ldc + col0;
#pragma unroll
                for (int bj = 0; bj < 2; ++bj) { const f32x4 v0 = acc[ai][bj][m][0], v1 = acc[ai][bj][m][1];
                    u32x4 w; w.x = cvt_pk_bf16(v0[0], v0[1]); w.y = cvt_pk_bf16(v0[2], v0[3]); w.z = cvt_pk_bf16(v1[0], v1[1]); w.w = cvt_pk_bf16(v1[2], v1[3]);
                    *(u32x4*)(rowp + bj * HALF) = w; } }
    }
};
struct EpiRelu2 {
    static constexpr bool PERM = true, AFTER_DRAIN = false;
    bf16_t* O; int ldc;
    __device__ __forceinline__ void operator()(const f32x4 (&acc)[2][2][4][2], const Unit& u, int wr, int wc, int fr, int fq) const {
        const int row0 = u.pm * BM + wr * 64 + fr, col0 = u.pn * BM + wc * 32 + 8 * fq;
#pragma unroll
        for (int ai = 0; ai < 2; ++ai)
#pragma unroll
            for (int m = 0; m < 4; ++m) { bf16_t* rowp = O + (size_t)(row0 + ai * HALF + m * 16) * ldc + col0;
#pragma unroll
                for (int bj = 0; bj < 2; ++bj) { f32x4 v0 = acc[ai][bj][m][0], v1 = acc[ai][bj][m][1];
#pragma unroll
                    for (int e = 0; e < 4; ++e) { const float p = fmaxf(v0[e], 0.f), q = fmaxf(v1[e], 0.f); v0[e] = p * p; v1[e] = q * q; }
                    u32x4 w; w.x = cvt_pk_bf16(v0[0], v0[1]); w.y = cvt_pk_bf16(v0[2], v0[3]); w.z = cvt_pk_bf16(v1[0], v1[1]); w.w = cvt_pk_bf16(v1[2], v1[3]);
                    *(u32x4*)(rowp + bj * HALF) = w; } }
    }
};

struct EpiF32S {
    static constexpr bool PERM = false, AFTER_DRAIN = false;
    float* C; int ldc; float* R2; int nN, nfull, P; int mode; const float* res; const float* xp; const float* xs; const float* meta;
    __device__ __forceinline__ const float* rrow(int r) const {
        if (mode == 1) return res + (size_t)r * ldc;
        if (r >= 8768) r = 8767;
        if (r < 8256) { const int b = r / 2064, t = r - b * 2064; return t < 16 ? meta + (size_t)t * 2048 : xp + ((size_t)b * 2048 + (t - 16)) * 2048; }
        return xs + (size_t)(r - 8256) * 2048;
    }
    __device__ __forceinline__ void operator()(const f32x4 (&acc)[2][2][4][2], const Unit& u, int wr, int wc, int fr, int fq) const {
        const int r0 = wr * 64 + fr, c0 = wc * 32 + 4 * fq;
        if (u.slot < 0) {
#pragma unroll
            for (int ai = 0; ai < 2; ++ai)
#pragma unroll
                for (int m = 0; m < 4; ++m) { const int row = u.pm * BM + r0 + ai * HALF + m * 16; float* rowp = C + (size_t)row * ldc + u.pn * BM + c0; const float* rp = rrow(row) + u.pn * BM + c0;
#pragma unroll
                    for (int bj = 0; bj < 2; ++bj)
#pragma unroll
                        for (int n = 0; n < 2; ++n) *(f32x4*)(rowp + bj * HALF + n * 16) = acc[ai][bj][m][n] + *(const f32x4*)(rp + bj * HALF + n * 16);
                    if (m & 1) asm volatile("" ::: "memory"); }
        } else {
            float* base = R2 + ((size_t)((u.pm * nN + u.pn - nfull) * P + u.slot)) * 65536;
#pragma unroll
            for (int ai = 0; ai < 2; ++ai)
#pragma unroll
                for (int m = 0; m < 4; ++m) { float* rowp = base + (size_t)(r0 + ai * HALF + m * 16) * 256 + c0;
#pragma unroll
                    for (int bj = 0; bj < 2; ++bj)
#pragma unroll
                        for (int n = 0; n < 2; ++n) *(f32x4*)(rowp + bj * HALF + n * 16) = acc[ai][bj][m][n]; }
        }
    }
};
template <class Epi, class Sched, bool ALIGN_EPI = false, bool SP2 = false>
__device__ __forceinline__ void gemm_phase(PG8_LAS unsigned char* lds, const Gemm g, const Sched& S, const Epi& E) {
    const int tid = threadIdx.x, wid = __builtin_amdgcn_readfirstlane(tid >> 6), lane = tid & 63, wr = wid >> 2, wc = wid & 3, fr = lane & 15, fq = lane >> 4;
    const int K = g.K;
    unsigned voffA[2], voffB[2];
#pragma unroll
    for (int i = 0; i < 2; ++i) { int R, C; stage_rc(tid * 16 + i * 8192, R, C); const int Rb = Epi::PERM ? ((R & ~31) + perm32(R & 31)) : R;
        voffA[i] = (unsigned)(R * K + C) * 2u; voffB[i] = (unsigned)(Rb * K + C) * 2u; }
    const size_t kstep = (size_t)(BK * 2);
    const size_t hstep = (size_t)HALF * K * 2;
    const size_t tstep = 2 * hstep;
    const unsigned ldsw = (unsigned)wid * 1024u;
    const int aoff = lds_byte(wr * 64 + fr, fq * 8), boff = lds_byte(wc * 32 + fr, fq * 8);
#define PG8_SA(b, h) (((b) * 2 + (h)) * HTB)
#define PG8_SB(b, h) ((4 + (b) * 2 + (h)) * HTB)
#define PG8_STAGE(bufoff, gbase, voff) do { _Pragma("unroll") for (int _i = 0; _i < 2; ++_i) \
        __builtin_amdgcn_global_load_lds((const unsigned*)((const char*)(gbase) + (voff)[_i]), (PG8_LAS unsigned*)(lds + (bufoff) + ldsw + _i * 8192), 16, 0, 0); } while (0)
#define PG8_LDA(dst, b, h) do { _Pragma("unroll") for (int m = 0; m < 4; ++m) _Pragma("unroll") for (int k = 0; k < 2; ++k) dst[m][k] = *(const PG8_LAS bf16x8*)(lds + PG8_SA(b, h) + aoff + m * 2048 + k * 1024); } while (0)
#define PG8_LDB(dst, b, h) do { _Pragma("unroll") for (int n = 0; n < 2; ++n) _Pragma("unroll") for (int k = 0; k < 2; ++k) dst[n][k] = *(const PG8_LAS bf16x8*)(lds + PG8_SB(b, h) + boff + n * 2048 + k * 1024); } while (0)
#define PG8_MMA(ai, bj, At, Bt) do { __builtin_amdgcn_s_setprio(1); _Pragma("unroll") for (int m = 0; m < 4; ++m) _Pragma("unroll") for (int n = 0; n < 2; ++n) _Pragma("unroll") for (int k = 0; k < 2; ++k) \
        acc[ai][bj][m][n] = __builtin_amdgcn_mfma_f32_16x16x32_bf16(Bt[n][k], At[m][k], acc[ai][bj][m][n], 0, 0, 0); __builtin_amdgcn_s_setprio(0); } while (0)
#define PG8_WAIT_V(n) asm volatile("s_waitcnt vmcnt(" #n ")" ::: "memory")
#define PG8_WAIT_L(n) asm volatile("s_waitcnt lgkmcnt(" #n ")" ::: "memory")
#define PG8_BAR __builtin_amdgcn_s_barrier()
#define PG8_SCHED __builtin_amdgcn_sched_barrier(0)
    Unit cur, nxt; int ui = 0;
    if (!S.next(0, cur)) return;
    f32x4 acc[2][2][4][2];
#pragma unroll
    for (int a = 0; a < 2; ++a)
#pragma unroll
        for (int b = 0; b < 2; ++b)
#pragma unroll
            for (int m = 0; m < 4; ++m)
#pragma unroll
                for (int n = 0; n < 2; ++n) acc[a][b][m][n] = (f32x4){0.f, 0.f, 0.f, 0.f};
    bf16x8 At[4][2], B0[2][2], B1[2][2];
    const char* cA = (const char*)g.A + (size_t)cur.pm * tstep + (size_t)cur.kt0 * kstep; const char* cB = (const char*)g.Bt + (size_t)cur.pn * tstep + (size_t)cur.kt0 * kstep;
    S.a_ready(cur);
    if constexpr (SP2) {
        PG8_STAGE(PG8_SB(0, 0), cB, voffB); PG8_STAGE(PG8_SB(0, 1), cB + hstep, voffB); PG8_STAGE(PG8_SA(0, 0), cA, voffA); PG8_STAGE(PG8_SA(0, 1), cA + hstep, voffA);
        if (wr == 1) PG8_BAR;
        PG8_WAIT_V(2); PG8_BAR;
        PG8_STAGE(PG8_SB(1, 0), cB + kstep, voffB); PG8_STAGE(PG8_SA(1, 0), cA + kstep, voffA); PG8_STAGE(PG8_SB(1, 1), cB + hstep + kstep, voffB);
        PG8_WAIT_V(6); PG8_BAR;
    } else {
        PG8_STAGE(PG8_SB(0, 0), cB, voffB); PG8_STAGE(PG8_SA(0, 0), cA, voffA); PG8_STAGE(PG8_SB(0, 1), cB + hstep, voffB); PG8_STAGE(PG8_SA(0, 1), cA + hstep, voffA);
        if (wr == 1) PG8_BAR;
        PG8_WAIT_V(4); PG8_BAR;
        PG8_STAGE(PG8_SB(1, 0), cB + kstep, voffB); PG8_STAGE(PG8_SA(1, 0), cA + kstep, voffA); PG8_STAGE(PG8_SB(1, 1), cB + hstep + kstep, voffB);
        PG8_WAIT_V(6); PG8_BAR;
    }
    for (;;) {
        const bool has_next = S.next(ui + 1, nxt);
        const char* nA = has_next ? (const char*)g.A + (size_t)nxt.pm * tstep + (size_t)nxt.kt0 * kstep : cA; const char* nB = has_next ? (const char*)g.Bt + (size_t)nxt.pn * tstep + (size_t)nxt.kt0 * kstep : cB;
        const int nt = cur.nt;
        for (int t = 0; t < nt; t += 2) {
            const bool last = (t == nt - 2);
            const char* a1 = cA + (size_t)(t + 1) * kstep;
            const char* a2 = last ? nA : cA + (size_t)(t + 2) * kstep; const char* b2 = last ? nB : cB + (size_t)(t + 2) * kstep;
            const char* a3 = a2 + kstep; const char* b3 = b2 + kstep;
            if (last && has_next) S.a_ready(nxt);
            if constexpr (SP2) {
            PG8_LDB(B0, 0, 0); PG8_LDB(B1, 0, 1); PG8_SCHED; PG8_LDA(At, 0, 0); PG8_STAGE(PG8_SA(1, 1), a1 + hstep, voffA);
            PG8_WAIT_V(8); PG8_WAIT_L(0); PG8_BAR; PG8_MMA(0, 0, At, B0); PG8_MMA(0, 1, At, B1); PG8_BAR; PG8_SCHED;
            PG8_LDA(At, 0, 1); PG8_STAGE(PG8_SB(0, 0), b2, voffB); PG8_STAGE(PG8_SB(0, 1), b2 + hstep, voffB); PG8_STAGE(PG8_SA(0, 0), a2, voffA);
            PG8_WAIT_V(8); PG8_WAIT_L(0); PG8_BAR; PG8_MMA(1, 0, At, B0); PG8_MMA(1, 1, At, B1); PG8_BAR; PG8_SCHED;
            PG8_LDB(B0, 1, 0); PG8_LDB(B1, 1, 1); PG8_SCHED; PG8_LDA(At, 1, 0); PG8_STAGE(PG8_SA(0, 1), a2 + hstep, voffA);
            PG8_WAIT_V(8); PG8_WAIT_L(0); PG8_BAR; PG8_MMA(0, 0, At, B0); PG8_MMA(0, 1, At, B1); PG8_BAR; PG8_SCHED;
            PG8_LDA(At, 1, 1); PG8_STAGE(PG8_SB(1, 0), b3, voffB); PG8_STAGE(PG8_SB(1, 1), b3 + hstep, voffB); PG8_STAGE(PG8_SA(1, 0), a3, voffA);
            PG8_WAIT_V(8); PG8_WAIT_L(0); PG8_BAR; PG8_MMA(1, 0, At, B0); PG8_MMA(1, 1, At, B1); PG8_BAR; PG8_SCHED;
            } else {
            PG8_LDB(B0, 0, 0); PG8_SCHED; PG8_LDA(At, 0, 0); PG8_STAGE(PG8_SA(1, 1), a1 + hstep, voffA);
            PG8_WAIT_L(8); PG8_BAR; PG8_WAIT_L(0); PG8_MMA(0, 0, At, B0); PG8_BAR; PG8_SCHED;
            PG8_LDB(B1, 0, 1); PG8_STAGE(PG8_SB(0, 0), b2, voffB);
            PG8_BAR; PG8_WAIT_L(0); PG8_MMA(0, 1, At, B1); PG8_BAR;
            PG8_LDA(At, 0, 1); PG8_STAGE(PG8_SA(0, 0), a2, voffA);
            PG8_BAR; PG8_WAIT_L(0); PG8_MMA(1, 0, At, B0); PG8_BAR; PG8_SCHED;
            PG8_STAGE(PG8_SB(0, 1), b2 + hstep, voffB);
            PG8_WAIT_V(6); PG8_BAR; PG8_MMA(1, 1, At, B1); PG8_BAR;
            PG8_LDB(B0, 1, 0); PG8_SCHED; PG8_LDA(At, 1, 0); PG8_STAGE(PG8_SA(0, 1), a2 + hstep, voffA);
            PG8_WAIT_L(8); PG8_BAR; PG8_WAIT_L(0); PG8_MMA(0, 0, At, B0); PG8_BAR; PG8_SCHED;
            PG8_LDB(B1, 1, 1); PG8_STAGE(PG8_SB(1, 0), b3, voffB);
            PG8_BAR; PG8_WAIT_L(0); PG8_MMA(0, 1, At, B1); PG8_BAR;
            PG8_LDA(At, 1, 1); PG8_STAGE(PG8_SA(1, 0), a3, voffA);
            PG8_BAR; PG8_WAIT_L(0); PG8_MMA(1, 0, At, B0); PG8_BAR; PG8_SCHED;
            PG8_STAGE(PG8_SB(1, 1), b3 + hstep, voffB);
            PG8_WAIT_V(6); PG8_BAR; PG8_MMA(1, 1, At, B1); PG8_BAR;
            }
        }
        if constexpr (ALIGN_EPI) { if (wr == 0) PG8_BAR; }
        if constexpr (!Epi::AFTER_DRAIN) { E(acc, cur, wr, wc, fr, fq); S.done(cur); }
        if (!has_next) break;
#pragma unroll
        for (int a = 0; a < 2; ++a)
#pragma unroll
            for (int b = 0; b < 2; ++b)
#pragma unroll
                for (int m = 0; m < 4; ++m)
#pragma unroll
                    for (int n = 0; n < 2; ++n) acc[a][b][m][n] = (f32x4){0.f, 0.f, 0.f, 0.f};
        cur = nxt; cA = nA; cB = nB; ++ui;
        if constexpr (ALIGN_EPI) { if (wr == 1) PG8_BAR; }
    }
    PG8_WAIT_V(0);
    if constexpr (!ALIGN_EPI) { if (wr == 0) PG8_BAR; }
    PG8_BAR;
    if constexpr (Epi::AFTER_DRAIN) { E.fused(acc, cur, wr, wc, fr, fq, lds, wid, lane); S.done(cur); }
#undef PG8_SA
#undef PG8_SB
#undef PG8_STAGE
#undef PG8_LDA
#undef PG8_LDB
#undef PG8_MMA
#undef PG8_WAIT_V
#undef PG8_WAIT_L
#undef PG8_BAR
#undef PG8_SCHED
}
}
#ifndef PG8_SP2
#define PG8_SP2 true
#endif
#ifndef PG8_ALIGN
#define PG8_ALIGN true
#endif

#define LAS __attribute__((address_space(3)))
typedef unsigned short bf16;
typedef unsigned v4u __attribute__((ext_vector_type(4)));
typedef unsigned v2u __attribute__((ext_vector_type(2)));
typedef float f32x4 __attribute__((ext_vector_type(4)));
typedef short bf16x8 __attribute__((ext_vector_type(8)));
constexpr int NWAVES = 8, NTHR = 512;
constexpr int DM = 2048, NB = 4, SEQ = 2048, NMETA = 16, LP = 2064, DB = 128, DS = 4;
constexpr int MP = NB * LP;
constexpr int MS = DB * DS;
constexpr int MR = MP + MS;
constexpr int MPAD = 8960;
constexpr int NH = 32, NPROJ = 9248, NMAIN = 9216, DFF = 8192, DMIX = 4096, DCONV = 3072;
constexpr int NSEG = 33;
constexpr float EPS = 1e-6f;
constexpr size_t MiB = 1u << 20;
constexpr size_t WS_WIN = 1 * MiB, WS_WOUT = 38 * MiB, WS_WUP = 54 * MiB, WS_WDN = 86 * MiB, WS_WG = 118 * MiB;
constexpr size_t WS_H = 120 * MiB, WS_XN = 120 * MiB, WS_MIX = 120 * MiB, WS_XS = 190 * MiB, WS_BC = 225 * MiB;
constexpr size_t WS_PART = 260 * MiB, WS_A = 260 * MiB, WS_BT = 330 * MiB, WS_PXL = 260 * MiB, WS_PXBC = 295 * MiB;
constexpr size_t WS_PG = 400 * MiB, WS_PZ = 435 * MiB, WS_X1 = 400 * MiB, WS_XL = 470 * MiB, WS_HP = 470 * MiB;
constexpr size_t WS_DT = 505 * MiB, WS_AGGA = 507 * MiB, WS_AGGH = 509 * MiB, WS_END = 512 * MiB;
constexpr size_t WS_R2 = 330 * MiB;
constexpr int LDS_BYTES = 147456;
constexpr int NPHASE = 12;

struct Args { const float* in[28]; float* out; unsigned char* ws; int ph_lo, ph_hi; };
constexpr size_t O_YP = 0, O_YS = 16777216, O_PLH = O_YS + 1048576, O_PLC = O_PLH + 8192, O_PSSD = O_PLC + 24576, O_PSC = O_PSSD + 1048576,
                 O_SLH = O_PSC + 36864, O_SLC = O_SLH + 262144, O_SSSD = O_SLC + 786432, O_SSC = O_SSSD + 33554432, O_END = O_SSC + 1179648;

struct Ctx {
    const float *xp, *xs, *st_lru_h, *st_lru_conv, *st_ssd, *st_ssd_conv, *meta, *g_mix, *w_in, *conv_lru_w, *conv_lru_b, *lru_wa, *lru_ba, *lru_wx, *lru_bx,
                *lru_lam, *g_lru_out, *conv_ssd_w, *conv_ssd_b, *dt_bias, *a_log, *d_skip, *g_ssd_out, *w_out, *g_mlp, *w_up, *w_down, *g_final;
    float* out; unsigned char* ws;
    LAS unsigned char* lds;
    int tid, lane, wave, blk, G;
};

__device__ __forceinline__ unsigned f2bf(float f) { unsigned u = __builtin_bit_cast(unsigned, f); return (u + 0x7fffu + ((u >> 16) & 1u)) >> 16; }
__device__ __forceinline__ unsigned pk2(float lo, float hi) { unsigned r; asm("v_cvt_pk_bf16_f32 %0, %1, %2" : "=v"(r) : "v"(lo), "v"(hi)); return r; }
__device__ __forceinline__ float bflo(unsigned w) { return __builtin_bit_cast(float, w << 16); }
__device__ __forceinline__ float bfhi(unsigned w) { return __builtin_bit_cast(float, w & 0xffff0000u); }
__device__ __forceinline__ float bf1(bf16 h) { return __builtin_bit_cast(float, ((unsigned)h) << 16); }
#define SUM_DPP_STEP(v, ctrl, rmask) do { const int t_ = __builtin_amdgcn_update_dpp(0, __builtin_bit_cast(int, v), ctrl, rmask, 0xf, false); v += __builtin_bit_cast(float, t_); } while (0)
__device__ __forceinline__ float wave_sum(float v) {
    SUM_DPP_STEP(v, 0x111, 0xf); SUM_DPP_STEP(v, 0x112, 0xf); SUM_DPP_STEP(v, 0x114, 0xf); SUM_DPP_STEP(v, 0x118, 0xf);
    SUM_DPP_STEP(v, 0x142, 0xa); SUM_DPP_STEP(v, 0x143, 0xc);
    return __builtin_bit_cast(float, __builtin_amdgcn_readlane(__builtin_bit_cast(int, v), 63));
}
__device__ __forceinline__ float sigmoidf_(float x) { return __builtin_amdgcn_rcpf(1.0f + __expf(-x)); }
__device__ __forceinline__ float siluf_(float x) { return x * __builtin_amdgcn_rcpf(1.0f + __expf(-x)); }
__device__ __forceinline__ float softplusf_(float x) { return x > 20.f ? x : log1pf(expf(x)); }
__device__ __forceinline__ float gelu_tanh(float x) { const float u = 0.7978845608028654f * (x + 0.044715f * x * x * x); const float t = 1.0f - 2.0f * __builtin_amdgcn_rcpf(__expf(2.0f * u) + 1.0f); return 0.5f * x * (1.0f + t); }

__device__ __forceinline__ const float* xrow_ptr(const Ctx& F, int r) {
    if (r < MP) { const int b = r / LP, t = r - b * LP; return t < NMETA ? F.meta + (size_t)t * DM : F.xp + ((size_t)b * SEQ + (t - NMETA)) * DM; }
    return F.xs + (size_t)(r - MP) * DM;
}

__device__ __forceinline__ void transpose_item(const float* W, int ldw, bf16* WT, int K, int k0, int n0, LAS float* scr, int lane) {
#pragma unroll 8
    for (int i = 0; i < 32; ++i) { const int kk = 2 * i + (lane >> 5); scr[kk * 33 + (lane & 31)] = W[(size_t)(k0 + kk) * ldw + n0 + (lane & 31)]; }
    asm volatile("s_waitcnt lgkmcnt(0)" ::: "memory");
    const int c = lane & 7;
#pragma unroll
    for (int j = 0; j < 4; ++j) { const int n = (lane >> 3) + 8 * j; const LAS float* s = scr + (8 * c) * 33 + n;
        v4u o; o.x = pk2(s[0 * 33], s[1 * 33]); o.y = pk2(s[2 * 33], s[3 * 33]); o.z = pk2(s[4 * 33], s[5 * 33]); o.w = pk2(s[6 * 33], s[7 * 33]);
        *(v4u*)(WT + (size_t)(n0 + n) * K + k0 + 8 * c) = o; }
    asm volatile("s_waitcnt lgkmcnt(0)" ::: "memory");
}
__device__ __forceinline__ void rms_row_store(const f32x4 (&v)[8], const float* g, bf16* orow, int lane) {
    float ss = 0.f;
#pragma unroll
    for (int j = 0; j < 8; ++j) ss += (v[j].x * v[j].x + v[j].y * v[j].y) + (v[j].z * v[j].z + v[j].w * v[j].w);
    const float rs = rsqrtf(wave_sum(ss) * (1.f / DM) + EPS);
#pragma unroll
    for (int j = 0; j < 8; ++j) { const f32x4 gg = *(const f32x4*)(g + 4 * lane + 256 * j); const f32x4 o = v[j] * rs * gg;
        v2u w; w.x = pk2(o.x, o.y); w.y = pk2(o.z, o.w); *(v2u*)(orow + 4 * lane + 256 * j) = w; }
}
constexpr int I_IN = 32 * 289, I_OUT = 64 * 64, I_UP = 32 * 256, I_DN = 128 * 64, I_G = 256, NITEMS = I_IN + I_OUT + I_UP + I_DN + I_G;
__device__ __forceinline__ void convert_range(const Ctx& F, int lo, int hi, int part, int nparts) {
    LAS float* scr = (LAS float*)(F.lds + F.wave * 16384);
    bf16* WIN = (bf16*)(F.ws + WS_WIN); bf16* WOUT = (bf16*)(F.ws + WS_WOUT); bf16* WUP = (bf16*)(F.ws + WS_WUP); bf16* WDN = (bf16*)(F.ws + WS_WDN); bf16* WG = (bf16*)(F.ws + WS_WG);
    for (int it = lo + part * NWAVES + F.wave; it < hi; it += nparts * NWAVES) {
        int r = it;
        if (r < I_IN) { transpose_item(F.w_in, NPROJ, WIN, 2048, 64 * (r / 289), 32 * (r % 289), scr, F.lane); continue; } r -= I_IN;
        if (r < I_OUT) { transpose_item(F.w_out, 2048, WOUT, 4096, 64 * (r / 64), 32 * (r % 64), scr, F.lane); continue; } r -= I_OUT;
        if (r < I_UP) { transpose_item(F.w_up, 8192, WUP, 2048, 64 * (r / 256), 32 * (r % 256), scr, F.lane); continue; } r -= I_UP;
        if (r < I_DN) { transpose_item(F.w_down, 2048, WDN, 8192, 64 * (r / 64), 32 * (r % 64), scr, F.lane); continue; } r -= I_DN;
        { const int mat = r >> 7, hd = (r >> 3) & 15, sub = r & 7;
          transpose_item((mat ? F.lru_wx : F.lru_wa) + (size_t)hd * 16384, 128, WG + (size_t)(hd * 256 + mat * 128) * 128, 128, 64 * (sub >> 2), 32 * (sub & 3), scr, F.lane); }
    }
}
__device__ __forceinline__ void slack_parts(int n, int G, int blk, int& part, int& nparts) {
    const int nmax = (n + G - 1) / G, cut = (n % G == 0) ? 0 : n - (nmax - 1) * G;
    part = blk - cut; nparts = G - cut;
}
__device__ __forceinline__ void phase_prologue(const Ctx& F) {
    const int gw = F.blk * NWAVES + F.wave, NGW = F.G * NWAVES;
    convert_range(F, 0, I_IN, F.blk, F.G);
    convert_range(F, I_IN + I_OUT + I_UP + I_DN, NITEMS, F.blk, F.G);
    bf16* XN = (bf16*)(F.ws + WS_XN);
    for (int m = gw; m < MPAD; m += NGW) {
        bf16* orow = XN + (size_t)m * DM;
        if (m >= MR) {
#pragma unroll
            for (int j = 0; j < 8; ++j) *(v2u*)(orow + 4 * F.lane + 256 * j) = (v2u){0u, 0u};
            continue; }
        const float* xr = xrow_ptr(F, m); f32x4 v[8];
#pragma unroll
        for (int j = 0; j < 8; ++j) v[j] = *(const f32x4*)(xr + 4 * F.lane + 256 * j);
        rms_row_store(v, F.g_mix, orow, F.lane);
    }
}

__device__ __forceinline__ void phase_dt(const Ctx& F) {
    const int fr = F.lane & 15, fq = F.lane >> 4;
    const bf16* XN = (const bf16*)(F.ws + WS_XN); const bf16* WD = (const bf16*)(F.ws + WS_WIN) + (size_t)NMAIN * 2048; float* DT = (float*)(F.ws + WS_DT);
    LAS float* red = (LAS float*)F.lds;
    for (int blk = F.blk; blk < MR / 16; blk += F.G) {
        f32x4 c0 = {0.f, 0.f, 0.f, 0.f}, c1 = {0.f, 0.f, 0.f, 0.f};
        const int kb = F.wave * 256;
        const bf16* ap = XN + (size_t)(blk * 16 + fr) * DM + kb + fq * 8; const bf16* b0p = WD + (size_t)fr * DM + kb + fq * 8; const bf16* b1p = WD + (size_t)(16 + fr) * DM + kb + fq * 8;
#pragma unroll
        for (int k0 = 0; k0 < 256; k0 += 32) {
            const bf16x8 a = *(const bf16x8*)(ap + k0), b0 = *(const bf16x8*)(b0p + k0), b1 = *(const bf16x8*)(b1p + k0);
            c0 = __builtin_amdgcn_mfma_f32_16x16x32_bf16(a, b0, c0, 0, 0, 0); c1 = __builtin_amdgcn_mfma_f32_16x16x32_bf16(a, b1, c1, 0, 0, 0);
        }
        *(LAS f32x4*)(red + (F.wave * 64 + F.lane) * 8) = c0; *(LAS f32x4*)(red + (F.wave * 64 + F.lane) * 8 + 4) = c1;
        __syncthreads();
        if (F.wave == 0) {
#pragma unroll
            for (int w = 1; w < 8; ++w) { c0 += *(const LAS f32x4*)(red + (w * 64 + F.lane) * 8); c1 += *(const LAS f32x4*)(red + (w * 64 + F.lane) * 8 + 4); }
            const float bb0 = F.dt_bias[fr], bb1 = F.dt_bias[16 + fr];
#pragma unroll
            for (int e = 0; e < 4; ++e) { const int row = blk * 16 + fq * 4 + e; DT[row * NH + fr] = softplusf_(c0[e] + bb0); DT[row * NH + 16 + fr] = softplusf_(c1[e] + bb1); }
        }
        __syncthreads();
    }
}

__device__ __forceinline__ void phase_conv(const Ctx& F) {
    const bf16* PXL = (const bf16*)(F.ws + WS_PXL); const bf16* PXBC = (const bf16*)(F.ws + WS_PXBC);
    bf16* XL = (bf16*)(F.ws + WS_XL); bf16* XS = (bf16*)(F.ws + WS_XS); bf16* BC = (bf16*)(F.ws + WS_BC);
    constexpr int NRB = MR / 4, NCG = 640;
    const int vblk = (F.G % 8 == 0) ? (F.blk & 7) * (F.G >> 3) + (F.blk >> 3) : F.blk;
    for (int idx = vblk * NTHR + F.tid; idx < NRB * NCG; idx += F.G * NTHR) {
        const int cg_ = idx % NCG, rb = idx / NCG; const bool lru = cg_ < 256;
        const int c0 = lru ? cg_ * 8 : (cg_ - 256) * 8, ld = lru ? 2048 : 3072;
        const bf16* src = lru ? PXL : PXBC; const float* cw = lru ? F.conv_lru_w : F.conv_ssd_w; const float* cb = lru ? F.conv_lru_b : F.conv_ssd_b;
        const int row0 = rb * 4; const bool prompt = row0 < MP;
        int b = 0, t0 = 0, s = 0; if (prompt) { b = row0 / LP; t0 = row0 - b * LP; } else s = (row0 - MP) >> 2;
        float win[7][8];
        if (prompt) {
            if (t0 == 0) {
#pragma unroll
                for (int i = 0; i < 3; ++i)
#pragma unroll
                    for (int e = 0; e < 8; ++e) win[i][e] = 0.f;
            } else {
#pragma unroll
                for (int i = 0; i < 3; ++i) { const v4u w = *(const v4u*)(src + (size_t)(row0 - 3 + i) * ld + c0);
                    win[i][0] = bflo(w.x); win[i][1] = bfhi(w.x); win[i][2] = bflo(w.y); win[i][3] = bfhi(w.y); win[i][4] = bflo(w.z); win[i][5] = bfhi(w.z); win[i][6] = bflo(w.w); win[i][7] = bfhi(w.w); }
            }
        } else {
            const float* st = (lru ? F.st_lru_conv : F.st_ssd_conv) + (size_t)s * 3 * ld + c0;
#pragma unroll
            for (int i = 0; i < 3; ++i) { const f32x4 u0 = *(const f32x4*)(st + (size_t)i * ld), u1 = *(const f32x4*)(st + (size_t)i * ld + 4);
                win[i][0] = u0.x; win[i][1] = u0.y; win[i][2] = u0.z; win[i][3] = u0.w; win[i][4] = u1.x; win[i][5] = u1.y; win[i][6] = u1.z; win[i][7] = u1.w; }
        }
#pragma unroll
        for (int i = 0; i < 4; ++i) { const v4u w = *(const v4u*)(src + (size_t)(row0 + i) * ld + c0);
            win[3 + i][0] = bflo(w.x); win[3 + i][1] = bfhi(w.x); win[3 + i][2] = bflo(w.y); win[3 + i][3] = bfhi(w.y); win[3 + i][4] = bflo(w.z); win[3 + i][5] = bfhi(w.z); win[3 + i][6] = bflo(w.w); win[3 + i][7] = bfhi(w.w); }
        float wk[4][8], bias[8];
#pragma unroll
        for (int k = 0; k < 4; ++k) { const f32x4 u0 = *(const f32x4*)(cw + (size_t)k * ld + c0), u1 = *(const f32x4*)(cw + (size_t)k * ld + c0 + 4);
            wk[k][0] = u0.x; wk[k][1] = u0.y; wk[k][2] = u0.z; wk[k][3] = u0.w; wk[k][4] = u1.x; wk[k][5] = u1.y; wk[k][6] = u1.z; wk[k][7] = u1.w; }
        { const f32x4 u0 = *(const f32x4*)(cb + c0), u1 = *(const f32x4*)(cb + c0 + 4); bias[0] = u0.x; bias[1] = u0.y; bias[2] = u0.z; bias[3] = u0.w; bias[4] = u1.x; bias[5] = u1.y; bias[6] = u1.z; bias[7] = u1.w; }
#pragma unroll
        for (int j = 0; j < 4; ++j) {
            float o[8];
#pragma unroll
            for (int e = 0; e < 8; ++e) { float v = bias[e] + win[j][e] * wk[0][e]; v += win[j + 1][e] * wk[1][e]; v += win[j + 2][e] * wk[2][e]; v += win[j + 3][e] * wk[3][e]; o[e] = v; }
            const size_t row = (size_t)(row0 + j);
            if (lru) { v4u w; w.x = pk2(o[0], o[1]); w.y = pk2(o[2], o[3]); w.z = pk2(o[4], o[5]); w.w = pk2(o[6], o[7]); *(v4u*)(XL + row * 2048 + c0) = w; }
            else {
#pragma unroll
                for (int e = 0; e < 8; ++e) o[e] = siluf_(o[e]);
                if (c0 < 2048) { v4u w; w.x = pk2(o[0], o[1]); w.y = pk2(o[2], o[3]); w.z = pk2(o[4], o[5]); w.w = pk2(o[6], o[7]); *(v4u*)(XS + row * 2048 + c0) = w; }
                else { v4u w; w.x = pk2(o[0], o[1]); w.y = pk2(o[2], o[3]); w.z = pk2(o[4], o[5]); w.w = pk2(o[6], o[7]); *(v4u*)(BC + row * 1024 + (c0 - 2048)) = w; }
            }
        }
        float* cst = nullptr;
        if (prompt) { if (t0 == LP - 4) cst = F.out + (lru ? O_PLC : O_PSC) + (size_t)b * 3 * ld + c0; }
        else cst = F.out + (lru ? O_SLC : O_SSC) + (size_t)s * 3 * ld + c0;
        if (cst) {
#pragma unroll
            for (int i = 0; i < 3; ++i) { *(f32x4*)(cst + (size_t)i * ld) = (f32x4){win[4 + i][0], win[4 + i][1], win[4 + i][2], win[4 + i][3]}; *(f32x4*)(cst + (size_t)i * ld + 4) = (f32x4){win[4 + i][4], win[4 + i][5], win[4 + i][6], win[4 + i][7]}; }
        }
    }
}

__device__ __forceinline__ void gate_unit(const Ctx& F, int pm, int head) {
    constexpr int RS = 272;
    LAS unsigned char* LA = F.lds; LAS unsigned char* LB = F.lds + 256 * RS;
    const bf16* XL = (const bf16*)(F.ws + WS_XL) + (size_t)pm * 256 * 2048 + head * 128; const bf16* WG = (const bf16*)(F.ws + WS_WG) + (size_t)head * 256 * 128;
    float* Ao = (float*)(F.ws + WS_A); float* Bo = (float*)(F.ws + WS_BT);
    { const int row = F.tid >> 4, cp = F.tid & 15;
      const bf16* ga = XL + (size_t)row * 2048 + cp * 8; const bf16* gb = WG + row * 128 + cp * 8; LAS unsigned char* la = LA + row * RS + cp * 16;
#pragma unroll 2
      for (int i = 0; i < 8; ++i) { const v4u va = *(const v4u*)(ga + (size_t)i * 32 * 2048), vb = *(const v4u*)(gb + i * 32 * 128);
          *(LAS v4u*)(la + i * 32 * RS) = va; *(LAS v4u*)(la + 256 * RS + i * 32 * RS) = vb; } }
    __syncthreads();
    const int wr = F.wave >> 2, wc = F.wave & 3, fr = F.lane & 15, fq = F.lane >> 4;
    float cba[2][4], cbx[2][4], csp[2][4];
#pragma unroll
    for (int n = 0; n < 2; ++n)
#pragma unroll
        for (int e = 0; e < 4; ++e) { const int ch = head * 128 + 32 * wc + 16 * n + 4 * fq + e; cba[n][e] = F.lru_ba[ch]; cbx[n][e] = F.lru_bx[ch]; csp[n][e] = 8.0f * softplusf_(-F.lru_lam[ch]); }
#pragma unroll 1
    for (int mh = 0; mh < 2; ++mh) {
        f32x4 accr[4][2], acci[4][2];
#pragma unroll
        for (int m = 0; m < 4; ++m)
#pragma unroll
            for (int n = 0; n < 2; ++n) { accr[m][n] = (f32x4){0.f, 0.f, 0.f, 0.f}; acci[m][n] = (f32x4){0.f, 0.f, 0.f, 0.f}; }
        const int rbase = 128 * wr + 64 * mh;
#pragma unroll
        for (int ks = 0; ks < 4; ++ks) {
            bf16x8 br[2], bi[2];
#pragma unroll
            for (int n = 0; n < 2; ++n) { br[n] = *(const LAS bf16x8*)(LB + (32 * wc + 16 * n + fr) * RS + (32 * ks + 8 * fq) * 2); bi[n] = *(const LAS bf16x8*)(LB + (128 + 32 * wc + 16 * n + fr) * RS + (32 * ks + 8 * fq) * 2); }
#pragma unroll
            for (int m = 0; m < 4; ++m) { const bf16x8 af = *(const LAS bf16x8*)(LA + (rbase + 16 * m + fr) * RS + (32 * ks + 8 * fq) * 2);
#pragma unroll
                for (int n = 0; n < 2; ++n) { accr[m][n] = __builtin_amdgcn_mfma_f32_16x16x32_bf16(br[n], af, accr[m][n], 0, 0, 0); acci[m][n] = __builtin_amdgcn_mfma_f32_16x16x32_bf16(bi[n], af, acci[m][n], 0, 0, 0); } }
        }
#pragma unroll
        for (int m = 0; m < 4; ++m) {
            const int rl = rbase + 16 * m + fr, row = pm * 256 + rl;
            if (row < MR) {
                const bool first = (row < MP) && (row % LP == 0);
                const float* h0p = (row >= MP && ((row - MP) & 3) == 0) ? F.st_lru_h + (size_t)((row - MP) >> 2) * 2048 : nullptr;
#pragma unroll
                for (int n = 0; n < 2; ++n) {
                    const int j0 = 32 * wc + 16 * n + 4 * fq, ch0 = head * 128 + j0;
                    const v2u xw = *(const LAS v2u*)(LA + rl * RS + j0 * 2);
                    const float xl[4] = {bflo(xw.x), bfhi(xw.x), bflo(xw.y), bfhi(xw.y)};
                    f32x4 h0v = {0.f, 0.f, 0.f, 0.f}; if (h0p) h0v = *(const f32x4*)(h0p + ch0);
                    f32x4 av, bv;
#pragma unroll
                    for (int e = 0; e < 4; ++e) {
                        const float r = sigmoidf_(accr[m][n][e] + cba[n][e]), ii = sigmoidf_(acci[m][n][e] + cbx[n][e]);
                        const float a = __expf(-csp[n][e] * r); const float mult = first ? 1.0f : __builtin_amdgcn_sqrtf(fmaxf(1.0f - a * a, 0.f));
                        av[e] = a; bv[e] = mult * ii * xl[e] + a * h0v[e];
                    }
                    *(f32x4*)(Ao + (size_t)row * 2048 + ch0) = av; *(f32x4*)(Bo + (size_t)row * 2048 + ch0) = bv;
                }
            }
        }
    }
    __syncthreads();
}
__device__ __forceinline__ void phase_gates(const Ctx& F) {
    for (int u = F.blk; u < 35 * 16; u += F.G) gate_unit(F, u >> 4, u & 15);
#ifdef PROBE_G2
    for (int u = F.blk; u < 35 * 16; u += F.G) gate_unit(F, u >> 4, u & 15);
#endif
    int part, nparts; slack_parts(35 * 16, F.G, F.blk, part, nparts);
    if (part >= 0) convert_range(F, I_IN, I_IN + I_OUT + I_UP, part, nparts);
#ifdef PROBE_C2
    __syncthreads();
    if (part >= 0) convert_range(F, I_IN, I_IN + I_OUT + I_UP, part, nparts);
#endif
}

__device__ __forceinline__ void ssd_unit(const Ctx& F, int row0, int T, int head, const float* h0, float* hout) {
    const float* DT = (const float*)(F.ws + WS_DT); const bf16* XS = (const bf16*)(F.ws + WS_XS); const float* BC = (const float*)(F.ws + WS_BC); const bf16* PZ = (const bf16*)(F.ws + WS_PZ);
    bf16* MIX = (bf16*)(F.ws + WS_MIX);
    LAS float* xch = (LAS float*)F.lds;
    const int g = head >> 3, wave = F.wave, lane = F.lane;
    const float Ah = -expf(F.a_log[head]), Dh = F.d_skip[head];
    f32x4 h[4];
#pragma unroll
    for (int q = 0; q < 4; ++q) h[q] = h0 ? *(const f32x4*)(h0 + ((size_t)head * 64 + lane) * 128 + 16 * wave + 4 * q) : (f32x4){0.f, 0.f, 0.f, 0.f};
    for (int tb = 0; tb < T; tb += 4) {
        float part[4];
#pragma unroll
        for (int tt = 0; tt < 4; ++tt) {
            const size_t row = (size_t)(row0 + tb + tt);
            const float dt = DT[row * NH + head]; const float dA = __expf(dt * Ah);
            const float dtx = dt * bf1(XS[row * 2048 + head * 64 + lane]);
            const f32x4* Bp = (const f32x4*)(BC + row * 1024 + g * 128 + 16 * wave); const f32x4* Cp = (const f32x4*)(BC + row * 1024 + 512 + g * 128 + 16 * wave);
            float acc = 0.f;
#pragma unroll
            for (int q = 0; q < 4; ++q) { const f32x4 b4 = Bp[q], c4 = Cp[q];
#pragma unroll
                for (int e = 0; e < 4; ++e) { h[q][e] = dA * h[q][e] + dtx * b4[e]; acc += h[q][e] * c4[e]; } }
            part[tt] = acc;
        }
        const int buf = (tb >> 2) & 1;
#pragma unroll
        for (int tt = 0; tt < 4; ++tt) xch[buf * 2048 + (wave * 4 + tt) * 64 + lane] = part[tt];
        __syncthreads();
        if (F.tid < 256) {
            const int tt = F.tid >> 6, p = F.tid & 63; float y = 0.f;
#pragma unroll
            for (int w = 0; w < 8; ++w) y += xch[buf * 2048 + (w * 4 + tt) * 64 + p];
            const size_t row = (size_t)(row0 + tb + tt);
            const float x = bf1(XS[row * 2048 + head * 64 + p]), z = bf1(PZ[row * 2048 + head * 64 + p]);
            MIX[row * 4096 + 2048 + head * 64 + p] = (bf16)f2bf((y + Dh * x) * siluf_(z));
        }
    }
#pragma unroll
    for (int q = 0; q < 4; ++q) *(f32x4*)(hout + ((size_t)head * 64 + lane) * 128 + 16 * wave + 4 * q) = h[q];
    __syncthreads();
}

__device__ __forceinline__ void ssd_sample_wave(const Ctx& F, int part, int nparts) {
    const float* DT = (const float*)(F.ws + WS_DT); const bf16* XS = (const bf16*)(F.ws + WS_XS); const float* BC = (const float*)(F.ws + WS_BC); const bf16* PZ = (const bf16*)(F.ws + WS_PZ);
    bf16* MIX = (bf16*)(F.ws + WS_MIX);
    const int gw = part * NWAVES + F.wave, NGW = nparts * NWAVES, lane = F.lane, pl = lane >> 3, no = lane & 7;
    constexpr int NU = DB * NH * 8;
    f32x4 hn[4];
    if (gw < NU) { const float* hp = F.st_ssd + ((size_t)(gw >> 3) * 64 + (gw & 7) * 8 + pl) * 128 + 16 * no;
#pragma unroll
        for (int q = 0; q < 4; ++q) hn[q] = *(const f32x4*)(hp + 4 * q); }
    for (int u = gw; u < NU; u += NGW) {
        const int po = u & 7, head = (u >> 3) & 31, s_ = u >> 8, g = head >> 3, p = po * 8 + pl;
        f32x4 h[4];
#pragma unroll
        for (int q = 0; q < 4; ++q) h[q] = hn[q];
        const int un = u + NGW;
        if (un < NU) { const float* hp = F.st_ssd + ((size_t)(un >> 3) * 64 + (un & 7) * 8 + pl) * 128 + 16 * no;
#pragma unroll
            for (int q = 0; q < 4; ++q) hn[q] = *(const f32x4*)(hp + 4 * q); }
        const float Ah = -expf(F.a_log[head]), Dh = F.d_skip[head];
        float dtv[4], xv[4], zv[4]; f32x4 bv[4][4], cv[4][4];
#pragma unroll
        for (int j = 0; j < 4; ++j) { const size_t row = (size_t)(MP + 4 * s_ + j);
            dtv[j] = DT[row * NH + head]; xv[j] = bf1(XS[row * 2048 + head * 64 + p]); zv[j] = bf1(PZ[row * 2048 + head * 64 + p]);
            const float* bp = BC + row * 1024 + g * 128 + 16 * no;
#pragma unroll
            for (int q = 0; q < 4; ++q) { bv[j][q] = *(const f32x4*)(bp + 4 * q); cv[j][q] = *(const f32x4*)(bp + 512 + 4 * q); } }
#pragma unroll
        for (int j = 0; j < 4; ++j) {
            const float dA = __expf(dtv[j] * Ah), dtx = dtv[j] * xv[j]; float acc = 0.f;
#pragma unroll
            for (int q = 0; q < 4; ++q)
#pragma unroll
                for (int e = 0; e < 4; ++e) { h[q][e] = dA * h[q][e] + dtx * bv[j][q][e]; acc += h[q][e] * cv[j][q][e]; }
            acc += __shfl_xor(acc, 1); acc += __shfl_xor(acc, 2); acc += __shfl_xor(acc, 4);
            if (no == 0) MIX[(size_t)(MP + 4 * s_ + j) * 4096 + 2048 + head * 64 + p] = (bf16)f2bf((acc + Dh * xv[j]) * siluf_(zv[j]));
        }
        float* op = F.out + O_SSSD + ((size_t)(u >> 3) * 64 + po * 8 + pl) * 128 + 16 * no;
#pragma unroll
        for (int q = 0; q < 4; ++q) *(f32x4*)(op + 4 * q) = h[q];
    }
}

__device__ __forceinline__ void ssd_sample_blk(const Ctx& F, int part, int nparts) {
    const float* DT = (const float*)(F.ws + WS_DT); const bf16* XS = (const bf16*)(F.ws + WS_XS); const bf16* BC = (const bf16*)(F.ws + WS_BC); const bf16* PZ = (const bf16*)(F.ws + WS_PZ);
    bf16* MIX = (bf16*)(F.ws + WS_MIX);
    LAS float* sb = (LAS float*)F.lds;
    LAS bf16* xl = (LAS bf16*)(F.lds + 4096); LAS bf16* zl = (LAS bf16*)(F.lds + 8192);
    LAS float* dl = (LAS float*)(F.lds + 12288);
    const int lane = F.lane, pl = lane >> 3, no = lane & 7, p = F.wave * 8 + pl;
    constexpr int NIT = DB * 4;
    f32x4 hn[4];
#define SMP_LOAD(it_, hh_) do { const float* hp = F.st_ssd + (((size_t)((it_) >> 2) * NH + 8 * ((it_) & 3) + (hh_)) * 64 + p) * 128 + 4 * no;   \
        _Pragma("unroll") for (int q = 0; q < 4; ++q) hn[q] = *(const f32x4*)(hp + 32 * q); } while (0)
    if (part < NIT) SMP_LOAD(part, 0);
#pragma unroll 1
    for (int it = part; it < NIT; it += nparts) {
        const int s_ = it >> 2, g = it & 3;
        if (F.tid < 256) { const int tok = F.tid >> 6, r = F.tid & 63, which = r >> 5, n4 = r & 31;
            const v2u w = *(const v2u*)(BC + (size_t)(MP + 4 * s_ + tok) * 1024 + which * 512 + g * 128 + 4 * n4);
            *(LAS f32x4*)(sb + (tok * 2 + which) * 128 + 4 * n4) = (f32x4){bflo(w.x), bfhi(w.x), bflo(w.y), bfhi(w.y)}; }
        { const int tok = F.tid >> 7, which = (F.tid >> 6) & 1, piece = F.tid & 63;
          const v4u w = *(const v4u*)((which ? PZ : XS) + (size_t)(MP + 4 * s_ + tok) * 2048 + g * 512 + piece * 8);
          *(LAS v4u*)((which ? zl : xl) + tok * 512 + piece * 8) = w; }
        if (F.tid < 32) dl[F.tid] = DT[(size_t)(MP + 4 * s_ + (F.tid >> 3)) * NH + 8 * g + (F.tid & 7)];
        __syncthreads();
#pragma unroll 1
        for (int hh = 0; hh < 8; ++hh) {
            const int head = 8 * g + hh;
            f32x4 h[4];
#pragma unroll
            for (int q = 0; q < 4; ++q) h[q] = hn[q];
            if (hh < 7) SMP_LOAD(it, hh + 1); else if (it + nparts < NIT) SMP_LOAD(it + nparts, 0);
            const float Ah = -expf(F.a_log[head]), Dh = F.d_skip[head];
#pragma unroll
            for (int j = 0; j < 4; ++j) {
                const float xv = bf1(xl[j * 512 + hh * 64 + p]), zv = bf1(zl[j * 512 + hh * 64 + p]), dtv = dl[j * 8 + hh];
                const float dA = __expf(dtv * Ah), dtx = dtv * xv; float acc = 0.f;
#pragma unroll
                for (int q = 0; q < 4; ++q) { const f32x4 b4 = *(const LAS f32x4*)(sb + (j * 2) * 128 + 32 * q + 4 * no), c4 = *(const LAS f32x4*)(sb + (j * 2 + 1) * 128 + 32 * q + 4 * no);
#pragma unroll
                    for (int e = 0; e < 4; ++e) { h[q][e] = dA * h[q][e] + dtx * b4[e]; acc += h[q][e] * c4[e]; } }
                acc += __shfl_xor(acc, 1); acc += __shfl_xor(acc, 2); acc += __shfl_xor(acc, 4);
                if (no == 0) MIX[(size_t)(MP + 4 * s_ + j) * 4096 + 2048 + head * 64 + p] = (bf16)f2bf((acc + Dh * xv) * siluf_(zv));
            }
            float* op = F.out + O_SSSD + (((size_t)s_ * NH + head) * 64 + p) * 128 + 4 * no;
#pragma unroll
            for (int q = 0; q < 4; ++q) *(f32x4*)(op + 32 * q) = h[q];
        }
        __syncthreads();
    }
#undef SMP_LOAD
}
__device__ __forceinline__ void lru_aggregate(const Ctx& F, int part, int nparts, int lo = 0, int hi = NB * NSEG * 2048) {
    const float* Ai = (const float*)(F.ws + WS_A); const float* Bi = (const float*)(F.ws + WS_BT); float* GA = (float*)(F.ws + WS_AGGA); float* GH = (float*)(F.ws + WS_AGGH);
    for (int idx = lo + part * NTHR + F.tid; idx < hi; idx += nparts * NTHR) {
        const int ch = idx & 2047, sg = (idx >> 11) % NSEG, b = idx / (2048 * NSEG);
        const int t0 = sg * 64, t1 = min(t0 + 64, LP);
        float ap = 1.f, hh = 0.f;
        if (t1 - t0 == 64) {
            for (int t = t0; t < t1; t += 32) { float av[32], bv[32];
#pragma unroll
                for (int k = 0; k < 32; ++k) { const size_t o = (size_t)(b * LP + t + k) * 2048 + ch; av[k] = Ai[o]; bv[k] = Bi[o]; }
#pragma unroll
                for (int k = 0; k < 32; ++k) { hh = av[k] * hh + bv[k]; ap *= av[k]; } }
        } else {
            for (int t = t0; t < t1; t += 16) { float av[16], bv[16];
#pragma unroll
                for (int k = 0; k < 16; ++k) { const size_t o = (size_t)(b * LP + t + k) * 2048 + ch; av[k] = Ai[o]; bv[k] = Bi[o]; }
#pragma unroll
                for (int k = 0; k < 16; ++k) { hh = av[k] * hh + bv[k]; ap *= av[k]; } }
        }
        GA[idx] = ap; GH[idx] = hh;
    }
}

constexpr int NCH = 33;
constexpr size_t WS_S = 260 * MiB;
constexpr size_t WS_DC = 506 * MiB + 512 * 1024;
__device__ __forceinline__ float dpp_add_(float v, float src_shifted_default0, int) { return v + src_shifted_default0; }
#define SCAN_DPP_STEP(v, ctrl, rmask) do { const int t_ = __builtin_amdgcn_update_dpp(0, __builtin_bit_cast(int, v), ctrl, rmask, 0xf, false); v += __builtin_bit_cast(float, t_); } while (0)
__device__ __forceinline__ float wave_scan_incl(float v, int lane) {
    (void)lane;
    SCAN_DPP_STEP(v, 0x111, 0xf); SCAN_DPP_STEP(v, 0x112, 0xf); SCAN_DPP_STEP(v, 0x114, 0xf); SCAN_DPP_STEP(v, 0x118, 0xf);
    SCAN_DPP_STEP(v, 0x142, 0xa); SCAN_DPP_STEP(v, 0x143, 0xc);
    return v;
}
__device__ __forceinline__ void ssdA_unit(const Ctx& F, int b, int c, int g) {
    const float* DT = (const float*)(F.ws + WS_DT); const bf16* XS = (const bf16*)(F.ws + WS_XS); const float* BC = (const float*)(F.ws + WS_BC);
    float* S = (float*)(F.ws + WS_S); float* DC = (float*)(F.ws + WS_DC);
    const int row0 = b * LP + 64 * c, nq = min(64, LP - 64 * c), lane = F.lane, wave = F.wave, fr = lane & 15, fq = lane >> 4;
    LAS unsigned char* BT = F.lds; LAS unsigned char* XT = F.lds + 18432;
    { const int n = F.tid & 127, jq = F.tid >> 7; unsigned w[8];
#pragma unroll
      for (int jj = 0; jj < 8; ++jj) { const int j0 = 16 * jq + 2 * jj;
          const float v0 = j0 < nq ? BC[(size_t)(row0 + j0) * 1024 + g * 128 + n] : 0.f, v1 = (j0 + 1) < nq ? BC[(size_t)(row0 + j0 + 1) * 1024 + g * 128 + n] : 0.f; w[jj] = pk2(v0, v1); }
      *(LAS v4u*)(BT + n * 144 + jq * 32) = (v4u){w[0], w[1], w[2], w[3]}; *(LAS v4u*)(BT + n * 144 + jq * 32 + 16) = (v4u){w[4], w[5], w[6], w[7]}; }
    float dt_n = lane < nq ? DT[(size_t)(row0 + lane) * NH + 8 * g] : 0.f; unsigned xr_n[8];
#pragma unroll
    for (int jj = 0; jj < 8; ++jj) { const int j0 = 8 * wave + jj; xr_n[jj] = j0 < nq ? (unsigned)XS[(size_t)(row0 + j0) * 2048 + (8 * g) * 64 + lane] : 0u; }
#pragma unroll 1
    for (int hh = 0; hh < 8; ++hh) {
        const int head = 8 * g + hh; const float Ah = -expf(F.a_log[head]);
        const float dtj = dt_n; unsigned xr[8];
#pragma unroll
        for (int jj = 0; jj < 8; ++jj) xr[jj] = xr_n[jj];
        if (hh < 7) { dt_n = lane < nq ? DT[(size_t)(row0 + lane) * NH + head + 1] : 0.f;
#pragma unroll
            for (int jj = 0; jj < 8; ++jj) { const int j0 = 8 * wave + jj; xr_n[jj] = j0 < nq ? (unsigned)XS[(size_t)(row0 + j0) * 2048 + (head + 1) * 64 + lane] : 0u; } }
        const float acum = wave_scan_incl(dtj * Ah, lane), aend = __shfl(acum, 63), wj = __expf(aend - acum) * dtj;
        LAS unsigned char* XTb = XT + (hh & 1) * 9216;
        { unsigned w[4];
#pragma unroll
          for (int jj = 0; jj < 4; ++jj) { const int j0 = 8 * wave + 2 * jj;
              w[jj] = pk2(bflo(xr[2 * jj]) * __shfl(wj, j0), bflo(xr[2 * jj + 1]) * __shfl(wj, j0 + 1)); }
          *(LAS v4u*)(XTb + lane * 144 + wave * 16) = (v4u){w[0], w[1], w[2], w[3]}; }
        __syncthreads();
        f32x4 acc[4];
#pragma unroll
        for (int pb = 0; pb < 4; ++pb) acc[pb] = (f32x4){0.f, 0.f, 0.f, 0.f};
#pragma unroll
        for (int ks = 0; ks < 2; ++ks) { const bf16x8 wf = *(const LAS bf16x8*)(BT + (16 * wave + fr) * 144 + (32 * ks + 8 * fq) * 2);
#pragma unroll
            for (int pb = 0; pb < 4; ++pb) { const bf16x8 af = *(const LAS bf16x8*)(XTb + (16 * pb + fr) * 144 + (32 * ks + 8 * fq) * 2); acc[pb] = __builtin_amdgcn_mfma_f32_16x16x32_bf16(wf, af, acc[pb], 0, 0, 0); } }
        float* Sp = S + ((((size_t)b * NCH + c) * NH + head) * 64) * 128;
#pragma unroll
        for (int pb = 0; pb < 4; ++pb) *(f32x4*)(Sp + (size_t)(16 * pb + fr) * 128 + 16 * wave + 4 * fq) = acc[pb];
        if (F.tid == 0) DC[(b * NCH + c) * NH + head] = __expf(aend);
    }
    __syncthreads();
}
__device__ __forceinline__ void phase_ssdA(const Ctx& F) { for (int u = F.blk; u < NB * NCH * 4; u += F.G) { const int g = u & 3, bc = u >> 2; ssdA_unit(F, bc / NCH, bc % NCH, g); } }
__device__ __forceinline__ void phase_ssdB(const Ctx& F) {
    float* S = (float*)(F.ws + WS_S); const float* DC = (const float*)(F.ws + WS_DC);
    for (int idx = F.blk * NTHR + F.tid; idx < NB * NH * 64 * 32; idx += F.G * NTHR) {
        const int e4 = idx & 2047, head = (idx >> 11) & 31, b = idx >> 16;
        f32x4 H = {0.f, 0.f, 0.f, 0.f};
        float* sp = S + ((size_t)b * NCH * NH + head) * 8192 + 4 * e4; const float* dp = DC + b * NCH * NH + head;
        f32x4 v0 = *(const f32x4*)sp, v1 = *(const f32x4*)(sp + (size_t)NH * 8192);
        for (int c = 0; c < NCH; ++c) { const f32x4 v2 = (c + 2 < NCH) ? *(const f32x4*)(sp + (size_t)(c + 2) * NH * 8192) : (f32x4){0.f, 0.f, 0.f, 0.f}; const float d = dp[c * NH];
            *(f32x4*)(sp + (size_t)c * NH * 8192) = H; H = H * d + v0; v0 = v1; v1 = v2; }
        *(f32x4*)(F.out + O_PSSD + ((size_t)b * NH + head) * 8192 + 4 * e4) = H;
    }
}
__device__ __forceinline__ void ssdC_unit(const Ctx& F, int b, int c, int g) {
    const float* DT = (const float*)(F.ws + WS_DT); const bf16* XS = (const bf16*)(F.ws + WS_XS); const float* BC = (const float*)(F.ws + WS_BC); const bf16* PZ = (const bf16*)(F.ws + WS_PZ);
    const float* S = (const float*)(F.ws + WS_S); bf16* MIX = (bf16*)(F.ws + WS_MIX);
    const int row0 = b * LP + 64 * c, nq = min(64, LP - 64 * c), lane = F.lane, wave = F.wave, fr = lane & 15, fq = lane >> 4;
    LAS unsigned char* Cs = F.lds; LAS unsigned char* Bs = F.lds + 17408; LAS unsigned char* HB = F.lds + 34816;
    { const int r = F.tid >> 3, n0 = (F.tid & 7) * 16; const bool ok = r < nq; const float* src = BC + (size_t)(row0 + r) * 1024 + g * 128 + n0;
#pragma unroll
      for (int m = 0; m < 2; ++m) {
          f32x4 v[4];
#pragma unroll
          for (int q = 0; q < 4; ++q) v[q] = ok ? *(const f32x4*)(src + m * 512 + 4 * q) : (f32x4){0.f, 0.f, 0.f, 0.f};
          LAS unsigned char* d = (m ? Cs : Bs) + r * 272 + n0 * 2;
          *(LAS v4u*)d = (v4u){pk2(v[0].x, v[0].y), pk2(v[0].z, v[0].w), pk2(v[1].x, v[1].y), pk2(v[1].z, v[1].w)};
          *(LAS v4u*)(d + 16) = (v4u){pk2(v[2].x, v[2].y), pk2(v[2].z, v[2].w), pk2(v[3].x, v[3].y), pk2(v[3].z, v[3].w)}; } }
    __syncthreads();
    const int ib = wave >> 1, tb0 = 2 * (wave & 1);
    f32x4 cb[2] = {{0.f, 0.f, 0.f, 0.f}, {0.f, 0.f, 0.f, 0.f}};
#pragma unroll
    for (int ks = 0; ks < 4; ++ks) { const bf16x8 af = *(const LAS bf16x8*)(Cs + (16 * ib + fr) * 272 + (32 * ks + 8 * fq) * 2);
#pragma unroll
        for (int t = 0; t < 2; ++t) { const bf16x8 wf = *(const LAS bf16x8*)(Bs + (16 * (tb0 + t) + fr) * 272 + (32 * ks + 8 * fq) * 2); cb[t] = __builtin_amdgcn_mfma_f32_16x16x32_bf16(wf, af, cb[t], 0, 0, 0); } }
    const int irow = 16 * ib + fr;
    const int hp_ = F.tid >> 3, hn0 = (F.tid & 7) * 16;
    float dt_n = lane < nq ? DT[(size_t)(row0 + lane) * NH + 8 * g] : 0.f; unsigned xr_n[8]; f32x4 hv_n[4];
#pragma unroll
    for (int jj = 0; jj < 8; ++jj) { const int j0 = 8 * wave + jj; xr_n[jj] = j0 < nq ? (unsigned)XS[(size_t)(row0 + j0) * 2048 + (8 * g) * 64 + lane] : 0u; }
    { const float* hp = S + ((((size_t)b * NCH + c) * NH + 8 * g) * 64 + hp_) * 128 + hn0;
#pragma unroll
      for (int q = 0; q < 4; ++q) hv_n[q] = *(const f32x4*)(hp + 4 * q); }
#pragma unroll 1
    for (int hh = 0; hh < 8; ++hh) {
        const int head = 8 * g + hh; const float Ah = -expf(F.a_log[head]), Dh = F.d_skip[head];
        const float dtj = dt_n; unsigned xr[8]; f32x4 v[4];
#pragma unroll
        for (int jj = 0; jj < 8; ++jj) xr[jj] = xr_n[jj];
#pragma unroll
        for (int q = 0; q < 4; ++q) v[q] = hv_n[q];
        if (hh < 7) { dt_n = lane < nq ? DT[(size_t)(row0 + lane) * NH + head + 1] : 0.f;
#pragma unroll
            for (int jj = 0; jj < 8; ++jj) { const int j0 = 8 * wave + jj; xr_n[jj] = j0 < nq ? (unsigned)XS[(size_t)(row0 + j0) * 2048 + (head + 1) * 64 + lane] : 0u; }
            const float* hp = S + ((((size_t)b * NCH + c) * NH + head + 1) * 64 + hp_) * 128 + hn0;
#pragma unroll
            for (int q = 0; q < 4; ++q) hv_n[q] = *(const f32x4*)(hp + 4 * q); }
        v2u xw[2] = {{0u, 0u}, {0u, 0u}}, zw[2] = {{0u, 0u}, {0u, 0u}};
        if (irow < nq) {
#pragma unroll
            for (int t = 0; t < 2; ++t) { const size_t o = (size_t)(row0 + irow) * 2048 + head * 64 + 16 * (tb0 + t) + 4 * fq; xw[t] = *(const v2u*)(XS + o); zw[t] = *(const v2u*)(PZ + o); } }
        const float acum = wave_scan_incl(dtj * Ah, lane);
        LAS unsigned char* Ms = HB + (hh & 1) * 35840; LAS unsigned char* XT = Ms + 9216; LAS unsigned char* Hs = Ms + 18432;
        const float mi = __shfl(acum, irow);
#pragma unroll
        for (int t = 0; t < 2; ++t) { float mv[4];
#pragma unroll
            for (int e = 0; e < 4; ++e) { const int j = 16 * (tb0 + t) + 4 * fq + e; const float aj = __shfl(acum, j), dj = __shfl(dtj, j);
                mv[e] = (j <= irow) ? cb[t][e] * __expf(fminf(mi - aj, 0.f)) * dj : 0.f; }
            *(LAS v2u*)(Ms + irow * 144 + (16 * (tb0 + t) + 4 * fq) * 2) = (v2u){pk2(mv[0], mv[1]), pk2(mv[2], mv[3])}; }
        *(LAS v4u*)(XT + lane * 144 + wave * 16) = (v4u){xr[0] | (xr[1] << 16), xr[2] | (xr[3] << 16), xr[4] | (xr[5] << 16), xr[6] | (xr[7] << 16)};
        { LAS unsigned char* d = Hs + hp_ * 272 + hn0 * 2;
          *(LAS v4u*)d = (v4u){pk2(v[0].x, v[0].y), pk2(v[0].z, v[0].w), pk2(v[1].x, v[1].y), pk2(v[1].z, v[1].w)};
          *(LAS v4u*)(d + 16) = (v4u){pk2(v[2].x, v[2].y), pk2(v[2].z, v[2].w), pk2(v[3].x, v[3].y), pk2(v[3].z, v[3].w)}; }
        __syncthreads();
        f32x4 acc[2] = {{0.f, 0.f, 0.f, 0.f}, {0.f, 0.f, 0.f, 0.f}};
#pragma unroll
        for (int ks = 0; ks < 4; ++ks) { const bf16x8 af = *(const LAS bf16x8*)(Cs + irow * 272 + (32 * ks + 8 * fq) * 2);
#pragma unroll
            for (int t = 0; t < 2; ++t) { const bf16x8 wf = *(const LAS bf16x8*)(Hs + (16 * (tb0 + t) + fr) * 272 + (32 * ks + 8 * fq) * 2); acc[t] = __builtin_amdgcn_mfma_f32_16x16x32_bf16(wf, af, acc[t], 0, 0, 0); } }
        const float ei = __expf(mi);
#pragma unroll
        for (int t = 0; t < 2; ++t) acc[t] = acc[t] * ei;
#pragma unroll
        for (int ks = 0; ks < 2; ++ks) { const bf16x8 af = *(const LAS bf16x8*)(Ms + irow * 144 + (32 * ks + 8 * fq) * 2);
#pragma unroll
            for (int t = 0; t < 2; ++t) { const bf16x8 wf = *(const LAS bf16x8*)(XT + (16 * (tb0 + t) + fr) * 144 + (32 * ks + 8 * fq) * 2); acc[t] = __builtin_amdgcn_mfma_f32_16x16x32_bf16(wf, af, acc[t], 0, 0, 0); } }
        if (irow < nq) {
#pragma unroll
            for (int t = 0; t < 2; ++t) {
                const float y0 = (acc[t][0] + Dh * bflo(xw[t].x)) * siluf_(bflo(zw[t].x)), y1 = (acc[t][1] + Dh * bfhi(xw[t].x)) * siluf_(bfhi(zw[t].x));
                const float y2 = (acc[t][2] + Dh * bflo(xw[t].y)) * siluf_(bflo(zw[t].y)), y3 = (acc[t][3] + Dh * bfhi(xw[t].y)) * siluf_(bfhi(zw[t].y));
                *(v2u*)(MIX + (size_t)(row0 + irow) * 4096 + 2048 + head * 64 + 16 * (tb0 + t) + 4 * fq) = (v2u){pk2(y0, y1), pk2(y2, y3)}; }
        }
    }
    __syncthreads();
}
__device__ __forceinline__ void phase_ssdC(const Ctx& F) { for (int u = F.blk; u < NB * NCH * 4; u += F.G) { const int g = u & 3, bc = u >> 2; ssdC_unit(F, bc / NCH, bc % NCH, g); } }


#define SEQ_LOAD(cn) do { const int row0n = b * LP + 64 * (cn), nqn = min(64, LP - 64 * (cn)), lastn = nqn - 1;   \
        { const float d_ = DT[(size_t)(row0n + min(lane, lastn)) * NH + head]; pdt = lane < nqn ? d_ : 0.f; } \
        _Pragma("unroll") for (int jj = 0; jj < 8; ++jj) px[jj] = (unsigned)XS[(size_t)(row0n + min(8 * wave + jj, lastn)) * 2048 + head * 64 + lane]; \
        { const bf16* src = BC + (size_t)(row0n + min(sr, lastn)) * 1024 + g * 128 + sn0; \
          pB[0] = *(const v4u*)src; pB[1] = *(const v4u*)(src + 64); pC[0] = *(const v4u*)(src + 512); pC[1] = *(const v4u*)(src + 576); }   \
        _Pragma("unroll") for (int t = 0; t < 2; ++t) { const size_t o = (size_t)(row0n + min(irow, lastn)) * 2048 + head * 64 + 16 * (tb0 + t) + 4 * fq; pxw[t] = *(const v2u*)(XS + o); pzw[t] = *(const v2u*)(PZ + o); } \
    } while (0)
#define SEQ_LOAD_FULL(cn) do { const int row0n = b * LP + 64 * (cn); \
        pdt = DT[(size_t)(row0n + lane) * NH + head]; \
        _Pragma("unroll") for (int jj = 0; jj < 8; ++jj) px[jj] = (unsigned)XS[(size_t)(row0n + 8 * wave + jj) * 2048 + head * 64 + lane]; \
        { const float* src = BC + (size_t)(row0n + sr) * 1024 + g * 128 + sn0; \
          _Pragma("unroll") for (int q = 0; q < 4; ++q) { pB[q] = *(const f32x4*)(src + 4 * q); pC[q] = *(const f32x4*)(src + 512 + 4 * q); } } \
        _Pragma("unroll") for (int t = 0; t < 2; ++t) { const size_t o = (size_t)(row0n + irow) * 2048 + head * 64 + 16 * (tb0 + t) + 4 * fq; pxw[t] = *(const v2u*)(XS + o); pzw[t] = *(const v2u*)(PZ + o); } \
    } while (0)
__device__ __forceinline__ void ssd_seq_unit(const Ctx& F, int b, int head) {
    const float* DT = (const float*)(F.ws + WS_DT); const bf16* XS = (const bf16*)(F.ws + WS_XS); const bf16* BC = (const bf16*)(F.ws + WS_BC); const bf16* PZ = (const bf16*)(F.ws + WS_PZ);
    bf16* MIX = (bf16*)(F.ws + WS_MIX);
    const int g = head >> 3, lane = F.lane, wave = F.wave, fr = lane & 15, fq = lane >> 4, ib = wave >> 1, tb0 = 2 * (wave & 1), irow = 16 * ib + fr;
    const int sr = F.tid >> 3, sn0 = (F.tid & 7) * 8;
    const float Ah = -expf(F.a_log[head]), Dh = F.d_skip[head];
    LAS unsigned char* Hs = F.lds + 106496; LAS unsigned char* Ms = F.lds + 123904;
    LAS float* tabA = (LAS float*)(F.lds + 133120); LAS float* tabD = (LAS float*)(F.lds + 133376);
    f32x4 Hacc[4];
#pragma unroll
    for (int pb = 0; pb < 4; ++pb) Hacc[pb] = (f32x4){0.f, 0.f, 0.f, 0.f};
    v4u pB[2], pC[2]; unsigned px[8]; float pdt; v2u pxw[2], pzw[2];
    SEQ_LOAD(0);
#pragma unroll 1
    for (int c = 0; c < NCH; ++c) {
        const int row0 = b * LP + 64 * c, nq = min(64, LP - 64 * c);
        LAS unsigned char* Cs = F.lds + (c & 1) * 53248; LAS unsigned char* Bs = Cs + 17408; LAS unsigned char* XT1 = Cs + 34816; LAS unsigned char* XT2 = Cs + 44032;
        const float dtj = pdt; const float acum = wave_scan_incl(dtj * Ah, lane), aend = __builtin_bit_cast(float, __builtin_amdgcn_readlane(__builtin_bit_cast(int, acum), 63)), wj = __expf(aend - acum) * dtj;
        if (wave == 0) { tabA[lane] = acum; tabD[lane] = dtj; }
        { LAS unsigned char* d = Bs + sr * 272 + sn0 * 2; *(LAS v4u*)d = pB[0]; *(LAS v4u*)(d + 128) = pB[1];
          d = Cs + sr * 272 + sn0 * 2; *(LAS v4u*)d = pC[0]; *(LAS v4u*)(d + 128) = pC[1]; }
        *(LAS v4u*)(XT1 + lane * 144 + wave * 16) = (v4u){px[0] | (px[1] << 16), px[2] | (px[3] << 16), px[4] | (px[5] << 16), px[6] | (px[7] << 16)};
        { unsigned w[4];
#pragma unroll
          for (int jj = 0; jj < 4; ++jj) { const int j0 = 8 * wave + 2 * jj; w[jj] = pk2(bflo(px[2 * jj]) * __builtin_bit_cast(float, __builtin_amdgcn_readlane(__builtin_bit_cast(int, wj), j0)), bflo(px[2 * jj + 1]) * __builtin_bit_cast(float, __builtin_amdgcn_readlane(__builtin_bit_cast(int, wj), j0 + 1))); }
          *(LAS v4u*)(XT2 + lane * 144 + wave * 16) = (v4u){w[0], w[1], w[2], w[3]}; }
        v2u xw[2], zw[2];
#pragma unroll
        for (int t = 0; t < 2; ++t) { xw[t] = pxw[t]; zw[t] = pzw[t]; }
        SEQ_LOAD(min(c + 1, NCH - 1));
        asm volatile("s_waitcnt lgkmcnt(0)" ::: "memory"); __builtin_amdgcn_s_barrier(); asm volatile("" ::: "memory");
        f32x4 cb[2] = {{0.f, 0.f, 0.f, 0.f}, {0.f, 0.f, 0.f, 0.f}}; bf16x8 afr[4];
#pragma unroll
        for (int ks = 0; ks < 4; ++ks) { afr[ks] = *(const LAS bf16x8*)(Cs + irow * 272 + (32 * ks + 8 * fq) * 2);
#pragma unroll
            for (int t = 0; t < 2; ++t) { const bf16x8 wf = *(const LAS bf16x8*)(Bs + (16 * (tb0 + t) + fr) * 272 + (32 * ks + 8 * fq) * 2); cb[t] = __builtin_amdgcn_mfma_f32_16x16x32_bf16(wf, afr[ks], cb[t], 0, 0, 0); } }
        const float mi = tabA[irow];
#pragma unroll
        for (int t = 0; t < 2; ++t) { float mv[4];
            const f32x4 aj4 = *(const LAS f32x4*)(tabA + 16 * (tb0 + t) + 4 * fq), dj4 = *(const LAS f32x4*)(tabD + 16 * (tb0 + t) + 4 * fq);
#pragma unroll
            for (int e = 0; e < 4; ++e) { const int j = 16 * (tb0 + t) + 4 * fq + e;
                mv[e] = (j <= irow) ? cb[t][e] * __expf(fminf(mi - aj4[e], 0.f)) * dj4[e] : 0.f; }
            *(LAS v2u*)(Ms + irow * 144 + (16 * (tb0 + t) + 4 * fq) * 2) = (v2u){pk2(mv[0], mv[1]), pk2(mv[2], mv[3])}; }
#pragma unroll
        for (int pb = 0; pb < 4; ++pb) *(LAS v2u*)(Hs + (16 * pb + fr) * 272 + (16 * wave + 4 * fq) * 2) = (v2u){pk2(Hacc[pb][0], Hacc[pb][1]), pk2(Hacc[pb][2], Hacc[pb][3])};
        asm volatile("s_waitcnt lgkmcnt(0)" ::: "memory"); __builtin_amdgcn_s_barrier(); asm volatile("" ::: "memory");
        f32x4 acc[2] = {{0.f, 0.f, 0.f, 0.f}, {0.f, 0.f, 0.f, 0.f}};
#pragma unroll
        for (int ks = 0; ks < 4; ++ks) {
#pragma unroll
            for (int t = 0; t < 2; ++t) { const bf16x8 wf = *(const LAS bf16x8*)(Hs + (16 * (tb0 + t) + fr) * 272 + (32 * ks + 8 * fq) * 2); acc[t] = __builtin_amdgcn_mfma_f32_16x16x32_bf16(wf, afr[ks], acc[t], 0, 0, 0); } }
        const float ei = __expf(mi);
#pragma unroll
        for (int t = 0; t < 2; ++t) acc[t] = acc[t] * ei;
#pragma unroll
        for (int ks = 0; ks < 2; ++ks) { const bf16x8 af = *(const LAS bf16x8*)(Ms + irow * 144 + (32 * ks + 8 * fq) * 2);
#pragma unroll
            for (int t = 0; t < 2; ++t) { const bf16x8 wf = *(const LAS bf16x8*)(XT1 + (16 * (tb0 + t) + fr) * 144 + (32 * ks + 8 * fq) * 2); acc[t] = __builtin_amdgcn_mfma_f32_16x16x32_bf16(wf, af, acc[t], 0, 0, 0); } }
        if (irow < nq) {
#pragma unroll
            for (int t = 0; t < 2; ++t) {
                const float y0 = (acc[t][0] + Dh * bflo(xw[t].x)) * siluf_(bflo(zw[t].x)), y1 = (acc[t][1] + Dh * bfhi(xw[t].x)) * siluf_(bfhi(zw[t].x));
                const float y2 = (acc[t][2] + Dh * bflo(xw[t].y)) * siluf_(bflo(zw[t].y)), y3 = (acc[t][3] + Dh * bfhi(xw[t].y)) * siluf_(bfhi(zw[t].y));
                *(v2u*)(MIX + (size_t)(row0 + irow) * 4096 + 2048 + head * 64 + 16 * (tb0 + t) + 4 * fq) = (v2u){pk2(y0, y1), pk2(y2, y3)}; }
        }
        const float dec = __expf(aend);
#pragma unroll
        for (int pb = 0; pb < 4; ++pb) Hacc[pb] = Hacc[pb] * dec;
#pragma unroll
        for (int ks = 0; ks < 2; ++ks) {
            unsigned wv[4];
#pragma unroll
            for (int jj = 0; jj < 4; ++jj) { const LAS unsigned char* q = Bs + (32 * ks + 8 * fq + 2 * jj) * 272 + (16 * wave + fr) * 2;
                wv[jj] = (unsigned)*(const LAS unsigned short*)q | ((unsigned)*(const LAS unsigned short*)(q + 272) << 16); }
            const bf16x8 wf = __builtin_bit_cast(bf16x8, (v4u){wv[0], wv[1], wv[2], wv[3]});
#pragma unroll
            for (int pb = 0; pb < 4; ++pb) { const bf16x8 af = *(const LAS bf16x8*)(XT2 + (16 * pb + fr) * 144 + (32 * ks + 8 * fq) * 2); Hacc[pb] = __builtin_amdgcn_mfma_f32_16x16x32_bf16(wf, af, Hacc[pb], 0, 0, 0); }
        }
    }
    float* op = F.out + O_PSSD + ((size_t)b * NH + head) * 8192;
#pragma unroll
    for (int pb = 0; pb < 4; ++pb) *(f32x4*)(op + (size_t)(16 * pb + fr) * 128 + 16 * wave + 4 * fq) = Hacc[pb];
    __syncthreads();
}

constexpr int AGG_SPLIT = 24 * 2048;
__device__ __forceinline__ void phase_scan1(const Ctx& F) {
    constexpr int NPU = NB * NH;
    if (F.G >= 2 * NPU) {
        if (F.blk < NPU) { const int v_ = (F.blk & 7) * (NPU / 8) + (F.blk >> 3);
            ssd_seq_unit(F, v_ >> 5, v_ & 31);
            lru_aggregate(F, F.blk, NPU, 0, AGG_SPLIT);
        } else { ssd_sample_blk(F, F.blk - NPU, F.G - NPU);
#ifdef PROBE_S2
            ssd_sample_blk(F, F.blk - NPU, F.G - NPU);
#endif
            lru_aggregate(F, F.blk - NPU, F.G - NPU, AGG_SPLIT, NB * NSEG * 2048); }
    } else {
        for (int u = F.blk; u < NPU; u += F.G) ssd_seq_unit(F, u >> 5, u & 31);
        ssd_sample_blk(F, F.blk, F.G); lru_aggregate(F, F.blk, F.G);
    }
}

__device__ __forceinline__ void phase_scan2(const Ctx& F) {
    const float* Ai = (const float*)(F.ws + WS_A); const float* Bi = (const float*)(F.ws + WS_BT); const float* GA = (const float*)(F.ws + WS_AGGA); const float* GH = (const float*)(F.ws + WS_AGGH);
    const bf16* PG = (const bf16*)(F.ws + WS_PG); bf16* MIX = (bf16*)(F.ws + WS_MIX);
    constexpr int NPI = NB * NSEG * 2048, NSI = DB * 2048;
    for (int idx = F.blk * NTHR + F.tid; idx < NPI + NSI; idx += F.G * NTHR) {
        if (idx < NPI) {
            const int ch = idx & 2047, sg = (idx >> 11) % NSEG, b = idx / (2048 * NSEG);
            float hh = 0.f;
            for (int s2 = 0; s2 < sg; s2 += 8) { float ga[8], gh[8];
#pragma unroll
                for (int k = 0; k < 8; ++k) { const int sk = (s2 + k < sg) ? s2 + k : 0; const int o = (b * NSEG + sk) * 2048 + ch; ga[k] = GA[o]; gh[k] = GH[o]; }
#pragma unroll
                for (int k = 0; k < 8; ++k) if (s2 + k < sg) hh = ga[k] * hh + gh[k]; }
            const int t0 = sg * 64, t1 = min(t0 + 64, LP);
            if (t1 - t0 == 64) {
                for (int t = t0; t < t1; t += 32) { float av[32], bv[32]; bf16 gv[32];
#pragma unroll
                    for (int k = 0; k < 32; ++k) { const size_t o = (size_t)(b * LP + t + k) * 2048 + ch; av[k] = Ai[o]; bv[k] = Bi[o]; gv[k] = PG[o]; }
#pragma unroll
                    for (int k = 0; k < 32; ++k) { hh = av[k] * hh + bv[k]; MIX[(size_t)(b * LP + t + k) * 4096 + ch] = (bf16)f2bf(hh * gelu_tanh(bf1(gv[k]))); } }
            } else {
                for (int t = t0; t < t1; t += 16) { float av[16], bv[16]; bf16 gv[16];
#pragma unroll
                    for (int k = 0; k < 16; ++k) { const size_t o = (size_t)(b * LP + t + k) * 2048 + ch; av[k] = Ai[o]; bv[k] = Bi[o]; gv[k] = PG[o]; }
#pragma unroll
                    for (int k = 0; k < 16; ++k) { hh = av[k] * hh + bv[k]; MIX[(size_t)(b * LP + t + k) * 4096 + ch] = (bf16)f2bf(hh * gelu_tanh(bf1(gv[k]))); } }
            }
            if (sg == NSEG - 1) F.out[O_PLH + (size_t)b * 2048 + ch] = hh;
        } else {
            const int i2 = idx - NPI, ch = i2 & 2047, s = i2 >> 11; float hh = 0.f;
#pragma unroll
            for (int j = 0; j < 4; ++j) { const size_t r = (size_t)(MP + 4 * s + j); const size_t o = r * 2048 + ch; hh = Ai[o] * hh + Bi[o];
                MIX[r * 4096 + ch] = (bf16)f2bf(hh * gelu_tanh(bf1(PG[o]))); }
            F.out[O_SLH + (size_t)s * 2048 + ch] = hh;
        }
    }
}

__device__ __forceinline__ void phase_mixnorm(const Ctx& F, bool dry = false) {
    const int gw = F.blk * NWAVES + F.wave, NGW = F.G * NWAVES; bf16* MIX = (bf16*)(F.ws + WS_MIX); bf16* DST = dry ? (bf16*)(F.ws + WS_PART) : MIX;
    for (int m = gw; m < MR; m += NGW) {
        bf16* rowp = MIX + (size_t)m * 4096 + 8 * F.lane; bf16* dstp = DST + (size_t)m * 4096 + 8 * F.lane; v4u w[8]; float ss[8];
#pragma unroll
        for (int j = 0; j < 8; ++j) { w[j] = *(const v4u*)(rowp + 512 * j);
            const float a0 = bflo(w[j].x), a1 = bfhi(w[j].x), a2 = bflo(w[j].y), a3 = bfhi(w[j].y), a4 = bflo(w[j].z), a5 = bfhi(w[j].z), a6 = bflo(w[j].w), a7 = bfhi(w[j].w);
            ss[j] = (a0 * a0 + a1 * a1) + (a2 * a2 + a3 * a3) + (a4 * a4 + a5 * a5) + (a6 * a6 + a7 * a7); }
        const float sl = wave_sum((ss[0] + ss[1]) + (ss[2] + ss[3])); const float rl = rsqrtf(sl * (1.f / 2048) + EPS);
#pragma unroll
        for (int j = 0; j < 8; ++j) {
            float rs = rl; if (j >= 4) rs = rsqrtf(wave_sum(ss[j]) * (1.f / 512) + EPS);
            const float* gp = (j < 4 ? F.g_lru_out + 512 * j : F.g_ssd_out + 512 * (j - 4)) + 8 * F.lane; const f32x4 g0 = *(const f32x4*)gp, g1 = *(const f32x4*)(gp + 4);
            v4u o; o.x = pk2(bflo(w[j].x) * rs * g0.x, bfhi(w[j].x) * rs * g0.y); o.y = pk2(bflo(w[j].y) * rs * g0.z, bfhi(w[j].y) * rs * g0.w);
            o.z = pk2(bflo(w[j].z) * rs * g1.x, bfhi(w[j].z) * rs * g1.y); o.w = pk2(bflo(w[j].w) * rs * g1.z, bfhi(w[j].w) * rs * g1.w);
            *(v4u*)(dstp + 512 * j) = o; }
    }
}


__device__ __forceinline__ f32x4 gemm_out4(const Ctx& F, int m, int j, int nfull, int P, bool& has_res) {
    const int T = (m >> 8) * 8 + j;
    if (T < nfull || P == 1) { has_res = true; return *(const f32x4*)((const float*)(F.ws + WS_PART) + (size_t)m * DM + 4 * F.lane + 256 * j); }
    has_res = false;
    const float* r = (const float*)(F.ws + WS_R2) + (size_t)(T - nfull) * P * 65536 + (size_t)(m & 255) * 256 + 4 * F.lane;
    f32x4 v = *(const f32x4*)r;
    for (int k = 1; k < P; ++k) v += *(const f32x4*)(r + (size_t)k * 65536);
    return v;
}
__device__ __forceinline__ void phase_resid1(const Ctx& F) {
    const int gw = F.blk * NWAVES + F.wave, NGW = F.G * NWAVES; float* X1 = (float*)(F.ws + WS_PART); bf16* HP = (bf16*)(F.ws + WS_HP);
    int nfull, P; pg8::split_params(35 * 8, F.G, 4096 / 64, nfull, P);
    for (int m = gw; m < MR; m += NGW) {
        const float* xr = xrow_ptr(F, m); f32x4 v[8];
#pragma unroll
        for (int j = 0; j < 8; ++j) { bool hr; v[j] = gemm_out4(F, m, j, nfull, P, hr); if (!hr) { v[j] += *(const f32x4*)(xr + 4 * F.lane + 256 * j); *(f32x4*)(X1 + (size_t)m * DM + 4 * F.lane + 256 * j) = v[j]; } }
        rms_row_store(v, F.g_mlp, HP + (size_t)m * DM, F.lane);
    }
}
__device__ __forceinline__ void phase_final(const Ctx& F) {
    const int gw = F.blk * NWAVES + F.wave, NGW = F.G * NWAVES; const float* X1 = (const float*)(F.ws + WS_PART);
    int nfull, P; pg8::split_params(35 * 8, F.G, DFF / 64, nfull, P);
    for (int m = gw; m < MR; m += NGW) {
        float* orow;
        if (m < MP) { const int b = m / LP, t = m - b * LP; if (t < NMETA) continue; orow = F.out + O_YP + ((size_t)b * SEQ + (t - NMETA)) * DM; } else orow = F.out + O_YS + (size_t)(m - MP) * DM;
        f32x4 v[8]; float ss = 0.f;
#pragma unroll
        for (int j = 0; j < 8; ++j) { bool hr; v[j] = gemm_out4(F, m, j, nfull, P, hr); if (!hr) v[j] += *(const f32x4*)(X1 + (size_t)m * DM + 4 * F.lane + 256 * j); ss += (v[j].x * v[j].x + v[j].y * v[j].y) + (v[j].z * v[j].z + v[j].w * v[j].w); }
        const float rs = rsqrtf(wave_sum(ss) * (1.f / DM) + EPS);
#pragma unroll
        for (int j = 0; j < 8; ++j) { const f32x4 gg = *(const f32x4*)(F.g_final + 4 * F.lane + 256 * j); *(f32x4*)(orow + 4 * F.lane + 256 * j) = v[j] * rs * gg; }
    }
}

#define RLX_AGENT __ATOMIC_RELAXED, __HIP_MEMORY_SCOPE_AGENT
constexpr size_t WS_BAR = 4096 * 4;
#define XB_TMO      128
#define XB_XCNT(j)  (256  + 64 * (j))
#define XB_XSUB(j)  (1280 + 64 * (j))
#define XB_XGEN(j)  (2304 + 64 * (j))
#define XB_TOP      3328
#define XB_TOPGEN   3392
#define XCD_BAR_WORDS 3456
#define XB_SPIN_CAP (1u << 18)

__device__ __forceinline__ unsigned xb_ld(unsigned* p)              { return __hip_atomic_load(p, __ATOMIC_RELAXED, __HIP_MEMORY_SCOPE_AGENT); }
__device__ __forceinline__ unsigned xb_add(unsigned* p, unsigned v) { return __hip_atomic_fetch_add(p, v, __ATOMIC_RELAXED, __HIP_MEMORY_SCOPE_AGENT); }
__device__ __forceinline__ unsigned xb_xcc_id() { return (unsigned)__builtin_amdgcn_s_getreg((3 << 11) | 20) & 0xFu; }
#define XB_SPIN(cond, bar) do { unsigned _sp = 0; while (cond) { __builtin_amdgcn_s_sleep(1); \
    if ((++_sp & 255u) == 0u) { if (xb_ld(&(bar)[XB_TMO])) break; if (_sp > XB_SPIN_CAP) { atomicAdd(&(bar)[XB_TMO], 1u); break; } } } } while (0)

struct XcdBarrier {
    unsigned* bar; unsigned x;
    volatile LAS unsigned* st;
};

__device__ __forceinline__ XcdBarrier xcd_barrier_post(unsigned* bar, volatile LAS unsigned* st) {
    XcdBarrier b; b.bar = bar; b.x = xb_xcc_id(); b.st = st;
    if (threadIdx.x == 0) (void)xb_add(&bar[XB_XCNT(b.x)], 1u);
    return b;
}
__device__ __forceinline__ void xcd_barrier_complete(unsigned* bar, unsigned x, unsigned& nloc, unsigned& nx) {
    const unsigned G = gridDim.x * gridDim.y * gridDim.z;
    unsigned sum, cnt, mine, sp = 0u;
    for (;;) {
        sum = 0u; cnt = 0u; mine = 0u;
#pragma unroll
        for (unsigned j = 0; j < 16; ++j) { const unsigned c = xb_ld(&bar[XB_XCNT(j)]); sum += c; cnt += (c > 0u) ? 1u : 0u; mine = (j == x) ? c : mine; }
        if (sum == G) break;
        __builtin_amdgcn_s_sleep(1);
        if ((++sp & 255u) == 0u) { if (xb_ld(&bar[XB_TMO])) break; if (sp > XB_SPIN_CAP) { atomicAdd(&bar[XB_TMO], 1u); break; } }
    }
    nloc = mine > 0u ? mine : 1u; nx = cnt > 0u ? cnt : 1u;
}

__device__ __forceinline__ void xcd_barrier(const XcdBarrier& b) {
    asm volatile("s_waitcnt vmcnt(0)" ::: "memory");
    __syncthreads();
    if (threadIdx.x == 0) {
        unsigned* bar = b.bar;
        __builtin_amdgcn_s_waitcnt(0);
        unsigned nloc = b.st[0], nx = b.st[1];
        if (nloc == 0u) { xcd_barrier_complete(bar, b.x, nloc, nx); b.st[0] = nloc; b.st[1] = nx; }
        const unsigned old = xb_add(&bar[XB_XSUB(b.x)], 1u);
        const unsigned gen = old / nloc;
        if (old + 1u == (gen + 1u) * nloc) {
            __builtin_amdgcn_fence(__ATOMIC_RELEASE, "agent");
            asm volatile("s_waitcnt vmcnt(0)" ::: "memory");
            const unsigned og = xb_add(&bar[XB_TOP], 1u);
            const unsigned tg = og / nx;
            if (og + 1u == (tg + 1u) * nx) xb_add(&bar[XB_TOPGEN], 1u);
            else XB_SPIN(xb_ld(&bar[XB_TOPGEN]) == tg, bar);
            __builtin_amdgcn_fence(__ATOMIC_ACQUIRE, "agent");
            xb_add(&bar[XB_XGEN(b.x)], 1u);
            asm volatile("s_waitcnt vmcnt(0)" ::: "memory");
        } else {
            XB_SPIN(xb_ld(&bar[XB_XGEN(b.x)]) == gen, bar);
            __builtin_amdgcn_fence(__ATOMIC_ACQUIRE, "agent");
            asm volatile("s_waitcnt vmcnt(0)" ::: "memory");
        }
    }
    __syncthreads();
}

__global__ void __launch_bounds__(NTHR, 2) hymba_fwd(Args args) {
    extern __shared__ __attribute__((aligned(16))) unsigned char lds_raw[];
    cg::grid_group grid = cg::this_grid();
    Ctx F;
    F.xp = args.in[0]; F.xs = args.in[1]; F.st_lru_h = args.in[2]; F.st_lru_conv = args.in[3]; F.st_ssd = args.in[4]; F.st_ssd_conv = args.in[5]; F.meta = args.in[6]; F.g_mix = args.in[7];
    F.w_in = args.in[8]; F.conv_lru_w = args.in[9]; F.conv_lru_b = args.in[10]; F.lru_wa = args.in[11]; F.lru_ba = args.in[12]; F.lru_wx = args.in[13]; F.lru_bx = args.in[14]; F.lru_lam = args.in[15];
    F.g_lru_out = args.in[16]; F.conv_ssd_w = args.in[17]; F.conv_ssd_b = args.in[18]; F.dt_bias = args.in[19]; F.a_log = args.in[20]; F.d_skip = args.in[21]; F.g_ssd_out = args.in[22];
    F.w_out = args.in[23]; F.g_mlp = args.in[24]; F.w_up = args.in[25]; F.w_down = args.in[26]; F.g_final = args.in[27];
    F.out = args.out; F.ws = args.ws; F.lds = (LAS unsigned char*)lds_raw;
    F.tid = threadIdx.x; F.lane = F.tid & 63; F.wave = __builtin_amdgcn_readfirstlane(F.tid >> 6); F.blk = blockIdx.x; F.G = gridDim.x;
    const int lo = args.ph_lo, hi = args.ph_hi;
    volatile LAS unsigned* bst = (volatile LAS unsigned*)(F.lds + LDS_BYTES - 64);
    if (F.tid < 16) bst[F.tid] = 0u;
    __syncthreads();
    XcdBarrier xbar; xbar.bar = (unsigned*)(F.ws + WS_BAR); xbar.x = 0; xbar.st = bst;
    if (hi - lo > 1) xbar = xcd_barrier_post((unsigned*)(F.ws + WS_BAR), bst);
    if (hi - lo > 1) grid.sync();
#define IN(k) (lo <= (k) && (k) < hi)
#ifndef PROBE_PH
#define PROBE_PH -1
#endif
#define REPS(k) for (int rep_ = 0; rep_ < (PROBE_PH == (k) ? 2 : 1); ++rep_)
#ifndef PROBE_SYNC
#define PROBE_SYNC 1
#endif
#define SEAM(k) do { if (IN(k) && IN((k) + 1)) { for (int s_ = 0; s_ < PROBE_SYNC; ++s_) { xcd_barrier(xbar); } } } while (0)
    if (IN(0)) REPS(0) phase_prologue(F);
    SEAM(0);
    if (IN(1)) {
        {
        pg8::Gemm g{(const pg8::bf16_t*)(F.ws + WS_XN), (const pg8::bf16_t*)(F.ws + WS_WIN), MPAD, NMAIN, 2048}; pg8::StaticOrder S; S.init(MPAD, NMAIN, F.G, F.blk, 2048);
        pg8::EpiProj E{(bf16*)(F.ws + WS_PG), (bf16*)(F.ws + WS_PXL), (bf16*)(F.ws + WS_PZ), (bf16*)(F.ws + WS_PXBC)};
        pg8::gemm_phase<pg8::EpiProj, pg8::StaticOrder, PG8_ALIGN, PG8_SP2>(F.lds, g, S, E);
        phase_dt(F);
            }
        if (PROBE_PH == 1) {
        pg8::Gemm g{(const pg8::bf16_t*)(F.ws + WS_XN), (const pg8::bf16_t*)(F.ws + WS_WIN), MPAD, NMAIN, 2048}; pg8::StaticOrder S; S.init(MPAD, NMAIN, F.G, F.blk, 2048);
        pg8::EpiProj E{(bf16*)(F.ws + WS_PG), (bf16*)(F.ws + WS_PXL), (bf16*)(F.ws + WS_PZ), (bf16*)(F.ws + WS_PXBC)};
        pg8::gemm_phase<pg8::EpiProj, pg8::StaticOrder, PG8_ALIGN, PG8_SP2>(F.lds, g, S, E);
        phase_dt(F);
            }
    }
    SEAM(1);
    if (IN(2)) REPS(2) phase_conv(F);
    SEAM(2);
    if (IN(3)) REPS(3) { phase_gates(F); __syncthreads(); }
    SEAM(3);
    if (IN(4)) REPS(4) phase_scan1(F);
    SEAM(4);
    if (IN(5)) REPS(5) phase_scan2(F);
    SEAM(5);
    if (IN(6)) { if (PROBE_PH == 6) phase_mixnorm(F, true); phase_mixnorm(F); }
    SEAM(6);
    if (IN(7)) {
        {
        pg8::Gemm g{(const pg8::bf16_t*)(F.ws + WS_MIX), (const pg8::bf16_t*)(F.ws + WS_WOUT), MPAD, 2048, 4096}; pg8::SplitOrder S; S.init(MPAD, 2048, F.G, F.blk, 4096);
        pg8::EpiF32S E{(float*)(F.ws + WS_PART), 2048, (float*)(F.ws + WS_R2), S.nN, S.nfull, S.P, 2, nullptr, F.xp, F.xs, F.meta};
        pg8::gemm_phase<pg8::EpiF32S, pg8::SplitOrder, PG8_ALIGN, PG8_SP2>(F.lds, g, S, E);
            }
        if (PROBE_PH == 7) {
        pg8::Gemm g{(const pg8::bf16_t*)(F.ws + WS_MIX), (const pg8::bf16_t*)(F.ws + WS_WOUT), MPAD, 2048, 4096}; pg8::SplitOrder S; S.init(MPAD, 2048, F.G, F.blk, 4096);
        pg8::EpiF32S E{(float*)(F.ws + WS_PART), 2048, (float*)(F.ws + WS_R2), S.nN, S.nfull, S.P, 2, nullptr, F.xp, F.xs, F.meta};
        pg8::gemm_phase<pg8::EpiF32S, pg8::SplitOrder, PG8_ALIGN, PG8_SP2>(F.lds, g, S, E);
            }
    }
    SEAM(7);
    if (IN(8)) REPS(8) phase_resid1(F);
    SEAM(8);
    if (IN(9)) {
        {
        pg8::Gemm g{(const pg8::bf16_t*)(F.ws + WS_HP), (const pg8::bf16_t*)(F.ws + WS_WUP), MPAD, DFF, 2048}; pg8::StaticOrder S; S.init(MPAD, DFF, F.G, F.blk, 2048);
        pg8::EpiRelu2 E{(bf16*)(F.ws + WS_H), DFF};
        pg8::gemm_phase<pg8::EpiRelu2, pg8::StaticOrder, PG8_ALIGN, PG8_SP2>(F.lds, g, S, E);
        { int part, nparts; slack_parts(35 * 32, F.G, F.blk, part, nparts); if (part >= 0) convert_range(F, I_IN + I_OUT + I_UP, I_IN + I_OUT + I_UP + I_DN, part, nparts); }
            }
        if (PROBE_PH == 9) { __syncthreads();
        pg8::Gemm g{(const pg8::bf16_t*)(F.ws + WS_HP), (const pg8::bf16_t*)(F.ws + WS_WUP), MPAD, DFF, 2048}; pg8::StaticOrder S; S.init(MPAD, DFF, F.G, F.blk, 2048);
        pg8::EpiRelu2 E{(bf16*)(F.ws + WS_H), DFF};
        pg8::gemm_phase<pg8::EpiRelu2, pg8::StaticOrder, PG8_ALIGN, PG8_SP2>(F.lds, g, S, E);
        { int part, nparts; slack_parts(35 * 32, F.G, F.blk, part, nparts); if (part >= 0) convert_range(F, I_IN + I_OUT + I_UP, I_IN + I_OUT + I_UP + I_DN, part, nparts); }
            }
    }
    SEAM(9);
    if (IN(10)) {
        {
        pg8::Gemm g{(const pg8::bf16_t*)(F.ws + WS_H), (const pg8::bf16_t*)(F.ws + WS_WDN), MPAD, 2048, DFF}; pg8::SplitOrder S; S.init(MPAD, 2048, F.G, F.blk, DFF);
        pg8::EpiF32S E{(float*)(F.ws + WS_PART), 2048, (float*)(F.ws + WS_R2), S.nN, S.nfull, S.P, 1, (const float*)(F.ws + WS_PART), nullptr, nullptr, nullptr};
        pg8::gemm_phase<pg8::EpiF32S, pg8::SplitOrder, PG8_ALIGN, PG8_SP2>(F.lds, g, S, E);
            }
        if (PROBE_PH == 10) {
        pg8::Gemm g{(const pg8::bf16_t*)(F.ws + WS_H), (const pg8::bf16_t*)(F.ws + WS_WDN), MPAD, 2048, DFF}; pg8::SplitOrder S; S.init(MPAD, 2048, F.G, F.blk, DFF);
        pg8::EpiF32S E{(float*)(F.ws + WS_PART), 2048, (float*)(F.ws + WS_R2), S.nN, S.nfull, S.P, 1, (const float*)(F.ws + WS_PART), nullptr, nullptr, nullptr};
        pg8::gemm_phase<pg8::EpiF32S, pg8::SplitOrder, PG8_ALIGN, PG8_SP2>(F.lds, g, S, E);
            }
    }
    SEAM(10);
    if (IN(11)) REPS(11) phase_final(F);
#undef IN
#undef SEAM
}

#ifndef N_LAUNCH_MODE
#define N_LAUNCH_MODE 1
#endif
extern "C" void kernel_launch(void* const* d_in, const int* in_sizes, int n_in, void* d_out, int out_size, void* d_ws, size_t ws_size, hipStream_t stream) {
    static int grid = 0;
    if (grid == 0) {
        if (n_in != 28 || (size_t)out_size != O_END || ws_size < WS_END) { fprintf(stderr, "kernel_launch: unexpected shapes: n_in %d out %d ws %zu\n", n_in, out_size, ws_size); grid = -1; return; }
        int dev = 0, cus = 0, per_cu = 0;
        (void)hipGetDevice(&dev); (void)hipDeviceGetAttribute(&cus, hipDeviceAttributeMultiprocessorCount, dev);
        if (hipFuncSetAttribute((const void*)hymba_fwd, hipFuncAttributeMaxDynamicSharedMemorySize, LDS_BYTES) != hipSuccess) { fprintf(stderr, "kernel_launch: hipFuncSetAttribute failed\n"); grid = -1; return; }
        if (hipOccupancyMaxActiveBlocksPerMultiprocessor(&per_cu, (const void*)hymba_fwd, NTHR, LDS_BYTES) != hipSuccess || per_cu < 1) { fprintf(stderr, "kernel_launch: occupancy query says %d\n", per_cu); per_cu = 1; }
        (void)hipGetLastError();
        grid = cus * 1;
        if (grid <= 0) grid = 256;
    }
    if (grid < 0) return;
    Args a{};
    for (int i = 0; i < 28; ++i) a.in[i] = (const float*)d_in[i];
    a.out = (float*)d_out; a.ws = (unsigned char*)d_ws;
#if N_LAUNCH_MODE == 1
    (void)hipMemsetAsync((char*)d_ws + WS_BAR, 0, XCD_BAR_WORDS * 4, stream);
    a.ph_lo = 0; a.ph_hi = NPHASE;
    void* kargs[] = {&a};
    hipError_t e = hipLaunchCooperativeKernel((const void*)hymba_fwd, dim3(grid), dim3(NTHR), kargs, LDS_BYTES, stream);
    if (e != hipSuccess) fprintf(stderr, "cooperative launch failed: %s (grid %d)\n", hipGetErrorString(e), grid);
#else
    for (int p = 0; p < NPHASE; ++p) { a.ph_lo = p; a.ph_hi = p + 1; hipLaunchKernelGGL(hymba_fwd, dim3(grid), dim3(NTHR), LDS_BYTES, stream, a); }
#endif
}
```
